# Optimizing an MI355X kernel written in HIP

```python
import jax, jax.numpy as jnp
from jax import lax
import numpy as np

D_MODEL = 1024
BATCH = 2
SEQ = 8192
DEPTH = 1

A_HEADS = 8
A_HEAD_DIM = 64
A_WIDTH = A_HEADS * A_HEAD_DIM
Q_LORA_RANK = 256
IDX_HEADS = 4
IDX_DIM = 64
TOPK_MAX = 256
Q_BLOCK = 128
B_WIDTH = 512
B_EXPAND = 128
B_HEADS = B_WIDTH // B_EXPAND
B_HEAD_V = B_WIDTH // B_HEADS
CHUNK = 16
D_FF = 4 * D_MODEL
EPS = 1e-6

COL_SIZES = (Q_LORA_RANK, A_WIDTH, A_WIDTH, IDX_DIM, IDX_HEADS,
             B_WIDTH, B_WIDTH, B_WIDTH, B_WIDTH, D_MODEL, D_MODEL)
D_IN = sum(COL_SIZES)

kernel_name = 'hybrid_dsa_hgrn2_gated_block'


def rms_norm(x, g):
    xf = x.astype(jnp.float32)
    y = xf * lax.rsqrt(jnp.mean(xf * xf, axis=-1, keepdims=True) + EPS)
    return (y * g.astype(jnp.float32)).astype(x.dtype)


def split_cols(t, sizes):
    points, acc = [], 0
    for s in sizes[:-1]:
        acc += s
        points.append(acc)
    return jnp.split(t, points, axis=-1)


def dsa_attention(q, k, v, q_idx, k_idx, w_idx):
    B, L = q.shape[0], q.shape[1]
    topk = min(TOPK_MAX, L // 4)
    nblk = L // Q_BLOCK
    key_pos = jnp.arange(L)
    scale = A_HEAD_DIM ** -0.5
    idx_scale = (IDX_DIM ** -0.5) * (IDX_HEADS ** -0.5)
    k_idx_f = k_idx.astype(jnp.float32)

    def to_blocks(t):
        return t.reshape((B, nblk, Q_BLOCK) + t.shape[2:]).swapaxes(0, 1)

    def block(args):
        qb, qib, wb, start = args
        q_pos = start + jnp.arange(Q_BLOCK)
        causal = key_pos[None, :] <= q_pos[:, None]
        rel = jax.nn.relu(jnp.einsum('bthd,bsd->bths', qib.astype(jnp.float32), k_idx_f))
        score = jnp.einsum('bth,bths->bts', wb.astype(jnp.float32) * idx_scale, rel)
        score = jnp.where(causal[None], score, -jnp.inf)
        top_val, top_idx = lax.top_k(score, topk)
        valid = top_val > -jnp.inf
        kg = jax.vmap(lambda kb, ib: kb[ib])(k, top_idx)
        vg = jax.vmap(lambda vb, ib: vb[ib])(v, top_idx)
        logits = jnp.einsum('bthd,btkhd->bhtk', qb.astype(jnp.float32), kg.astype(jnp.float32)) * scale
        logits = jnp.where(valid[:, None], logits, -jnp.inf)
        p = jax.nn.softmax(logits, axis=-1)
        o = jnp.einsum('bhtk,btkhd->bthd', p, vg.astype(jnp.float32))
        return o.astype(q.dtype)

    starts = jnp.arange(nblk) * Q_BLOCK
    out = lax.map(block, (to_blocks(q), to_blocks(q_idx), to_blocks(w_idx), starts))
    return out.swapaxes(0, 1).reshape(B, L, A_WIDTH)


def hgrn2_chunkwise(q, f_logit, i, lb):
    B, L, H, dk = q.shape
    dv = i.shape[-1]
    n = L // CHUNK
    lbh = lb.reshape(H, dk).astype(jnp.float32)
    f = lbh + (1.0 - lbh) * jax.nn.sigmoid(f_logit.astype(jnp.float32))
    k = 1.0 - f
    log_f = jnp.log(f)

    def chunks(t):
        return t.reshape(B, n, CHUNK, H, t.shape[-1])

    qc, kc, vc, gc = chunks(q.astype(jnp.float32)), chunks(k), chunks(i.astype(jnp.float32)), chunks(log_f)
    b = jnp.cumsum(gc, axis=2)
    b_end = b[:, :, -1]
    causal = jnp.tril(jnp.ones((CHUNK, CHUNK), dtype=bool))
    diff = b[:, :, :, None] - b[:, :, None, :]
    decay = jnp.exp(jnp.where(causal[None, None, :, :, None, None], diff, -jnp.inf))
    attn = jnp.einsum('bnthd,bnshd,bntshd->bnhts', qc, kc, decay)
    o_intra = jnp.einsum('bnhts,bnshv->bnthv', attn, vc)
    kv = jnp.einsum('bnshd,bnshv->bnhdv', kc * jnp.exp(b_end[:, :, None] - b), vc)

    def step(S, inp):
        dec, upd = inp
        return dec[..., None] * S + upd, S

    S0 = jnp.zeros((B, H, dk, dv), jnp.float32)
    _, S_prev = lax.scan(step, S0, (jnp.exp(b_end).swapaxes(0, 1), kv.swapaxes(0, 1)))
    S_prev = S_prev.swapaxes(0, 1)
    o_inter = jnp.einsum('bnthd,bnhdv->bnthv', qc * jnp.exp(b), S_prev)
    return (o_intra + o_inter).reshape(B, L, H, dv)


def setup_inputs(seed: int = 0) -> dict:
    key = jax.random.key(seed)
    ks = jax.random.split(key, 24)
    f32 = jnp.float32

    def nrm(k, shape, fan_in):
        return jax.random.normal(k, shape, f32) * (fan_in ** -0.5)

    def gain(k, shape):
        return 1.0 + 0.05 * jax.random.normal(k, shape, f32)

    def bias(k, shape, s=0.01):
        return s * jax.random.normal(k, shape, f32)

    return {
        'x': jax.random.normal(ks[0], (BATCH, SEQ, D_MODEL), f32),
        'c': jax.random.normal(ks[1], (BATCH, D_MODEL), f32),
        'w_ada': nrm(ks[2], (DEPTH, D_MODEL, 6 * D_MODEL), D_MODEL),
        'b_ada': bias(ks[3], (DEPTH, 6 * D_MODEL), 0.02),
        'norm1_g': gain(ks[4], (DEPTH, D_MODEL)),
        'w_in': nrm(ks[5], (DEPTH, D_MODEL, D_IN), D_MODEL),
        'q_lat_norm_g': gain(ks[6], (DEPTH, Q_LORA_RANK)),
        'w_uq': nrm(ks[7], (DEPTH, Q_LORA_RANK, A_WIDTH), Q_LORA_RANK),
        'w_uq_idx': nrm(ks[8], (DEPTH, Q_LORA_RANK, IDX_HEADS * IDX_DIM), Q_LORA_RANK),
        'q_norm_g': gain(ks[9], (DEPTH, A_HEAD_DIM)),
        'k_norm_g': gain(ks[10], (DEPTH, A_HEAD_DIM)),
        'k_idx_norm_g': gain(ks[11], (DEPTH, IDX_DIM)),
        'hgrn_lb': 0.5 * jax.random.normal(ks[12], (DEPTH + 1, B_WIDTH), f32),
        'hgrn_o_norm_g': gain(ks[13], (DEPTH, B_WIDTH)),
        'w_proj_a': nrm(ks[14], (DEPTH, A_WIDTH, D_MODEL), A_WIDTH),
        'w_proj_b': nrm(ks[15], (DEPTH, B_WIDTH, D_MODEL), B_WIDTH),
        'w_out': nrm(ks[16], (DEPTH, D_MODEL, D_MODEL), D_MODEL),
        'norm2_g': gain(ks[17], (DEPTH, D_MODEL)),
        'w_mlp1': nrm(ks[18], (DEPTH, D_MODEL, D_FF), D_MODEL),
        'b_mlp1': bias(ks[19], (DEPTH, D_FF)),
        'w_mlp2': nrm(ks[20], (DEPTH, D_FF, D_MODEL), D_FF),
        'b_mlp2': bias(ks[21], (DEPTH, D_MODEL)),
    }


def reference(x, c, w_ada, b_ada, norm1_g, w_in, q_lat_norm_g, w_uq, w_uq_idx, q_norm_g, k_norm_g,
              k_idx_norm_g, hgrn_lb, hgrn_o_norm_g, w_proj_a, w_proj_b, w_out, norm2_g,
              w_mlp1, b_mlp1, w_mlp2, b_mlp2):
    B, L = x.shape[0], x.shape[1]
    lb_all = jnp.cumsum(jax.nn.softmax(hgrn_lb.astype(jnp.float32), axis=0), axis=0)
    c_act = jax.nn.silu(c)
    for l in range(DEPTH):
        mod = c_act @ w_ada[l] + b_ada[l]
        shift1, scale1, gate1, shift2, scale2, gate2 = jnp.split(mod, 6, axis=-1)

        h = rms_norm(x, norm1_g[l]) * (1.0 + scale1[:, None]) + shift1[:, None]
        proj = h @ w_in[l]
        (q_lat, a_k, a_v, k_idx, w_idx, b_q, b_f, b_i, b_g, gate_a, gate_b) = split_cols(proj, COL_SIZES)

        q_lat = rms_norm(q_lat, q_lat_norm_g[l])
        a_q = rms_norm((q_lat @ w_uq[l]).reshape(B, L, A_HEADS, A_HEAD_DIM), q_norm_g[l])
        a_k = rms_norm(a_k.reshape(B, L, A_HEADS, A_HEAD_DIM), k_norm_g[l])
        a_v = a_v.reshape(B, L, A_HEADS, A_HEAD_DIM)
        q_idx = (q_lat @ w_uq_idx[l]).reshape(B, L, IDX_HEADS, IDX_DIM)
        k_idx = rms_norm(k_idx, k_idx_norm_g[l])
        out_a = dsa_attention(a_q, a_k, a_v, q_idx, k_idx, w_idx)

        hq = jax.nn.silu(b_q).reshape(B, L, B_HEADS, B_EXPAND)
        hf = b_f.reshape(B, L, B_HEADS, B_EXPAND)
        hi = b_i.reshape(B, L, B_HEADS, B_HEAD_V)
        o_b = hgrn2_chunkwise(hq, hf, hi, lb_all[l]).astype(x.dtype)
        o_b = rms_norm(o_b, hgrn_o_norm_g[l].reshape(B_HEADS, B_HEAD_V)).reshape(B, L, B_WIDTH)
        out_b = o_b * jax.nn.silu(b_g)

        merged = jax.nn.sigmoid(gate_a) * (out_a @ w_proj_a[l]) + jax.nn.sigmoid(gate_b) * (out_b @ w_proj_b[l])
        x = x + gate1[:, None] * (merged @ w_out[l])

        h2 = rms_norm(x, norm2_g[l]) * (1.0 + scale2[:, None]) + shift2[:, None]
        y = jnp.square(jax.nn.relu(h2 @ w_mlp1[l] + b_mlp1[l])) @ w_mlp2[l] + b_mlp2[l]
        x = x + gate2[:, None] * y
    return x
```

```cpp
#include <hip/hip_runtime.h>
#include <hip/hip_bf16.h>
#include <cstdio>
#include <cstdint>
#include <cmath>
namespace pg8 {
#define PG8_LAS __attribute__((address_space(3)))
typedef unsigned short bf16_t;
typedef short bf16x8 __attribute__((ext_vector_type(8)));
typedef float f32x4 __attribute__((ext_vector_type(4)));
typedef unsigned u32x4 __attribute__((ext_vector_type(4)));
constexpr int BM = 256, BK = 64, HALF = 128, HTB = HALF * BK * 2  , STAGE_BYTES = 8 * HTB, NXCD = 8, WGM = 8;

__host__ __device__ __forceinline__ int lds_byte(int r, int c) { const int st = (r >> 4) * 2 + (c >> 5), rr = r & 15, cc = c & 31, ob = rr * 64 + cc * 2; return st * 1024 + (ob ^ (((ob >> 9) & 1) << 5)); }
__host__ __device__ __forceinline__ void stage_rc(int b, int& R, int& C) { const int st = b / 1024, sb = b % 1024, swz = sb ^ (((sb >> 9) & 1) << 5); R = (st >> 1) * 16 + swz / 64; C = (st & 1) * 32 + (swz % 64) / 2; }
__host__ __device__ __forceinline__ int perm32(int rho) { const int n = rho >> 4, i = rho & 15; return 8 * (i >> 2) + 4 * n + (i & 3); }

struct Unit { int pm, pn; };
struct Gemm { const bf16_t* A; const bf16_t* Bt; int M, N, K; };

struct StaticOrder {
    int nM, nN, nwg, G, c;
    __host__ __device__ void init(int M, int N, int G_, int c_) { nM = M / BM; nN = N / BM; nwg = nM * nN; G = G_; c = c_; }
    __host__ __device__ bool next(int i, Unit& u) const {
        const long L = (long)i * G + c; if (L >= nwg) return false;
        int wgid = (int)L; { const int q = nwg / NXCD, r = nwg % NXCD, xcd = wgid % NXCD, off = wgid / NXCD; wgid = (xcd < r ? xcd * (q + 1) : r * (q + 1) + (xcd - r) * q) + off; }
        const int nig = WGM * nN, gid = wgid / nig, fm = gid * WGM, gsz = (nM - fm) < WGM ? (nM - fm) : WGM;
        u.pm = fm + ((wgid % nig) % gsz); u.pn = (wgid % nig) / gsz; return true;
    }
    __device__ __forceinline__ void a_ready(const Unit&) const {}
    __device__ __forceinline__ void done(const Unit&) const {}
};

__device__ __forceinline__ unsigned cvt_pk_bf16(float lo, float hi) { unsigned r; asm volatile("v_cvt_pk_bf16_f32 %0, %1, %2" : "=v"(r) : "v"(lo), "v"(hi)); return r; }
__device__ __forceinline__ float bf2f(bf16_t b) { return __builtin_bit_cast(float, (unsigned)b << 16); }
__device__ __forceinline__ float sigm(float x) { return __builtin_amdgcn_rcpf(1.0f + __expf(-x)); }
__device__ __forceinline__ void st8(bf16_t* p, const float* v) { u32x4 w; w.x = cvt_pk_bf16(v[0], v[1]); w.y = cvt_pk_bf16(v[2], v[3]); w.z = cvt_pk_bf16(v[4], v[5]); w.w = cvt_pk_bf16(v[6], v[7]); *(u32x4*)p = w; }
__device__ __forceinline__ void ld8(const bf16_t* p, float* v) { const u32x4 w = *(const u32x4*)p; v[0] = __builtin_bit_cast(float, w.x << 16); v[1] = __builtin_bit_cast(float, w.x & 0xffff0000u);
    v[2] = __builtin_bit_cast(float, w.y << 16); v[3] = __builtin_bit_cast(float, w.y & 0xffff0000u); v[4] = __builtin_bit_cast(float, w.z << 16); v[5] = __builtin_bit_cast(float, w.z & 0xffff0000u);
    v[6] = __builtin_bit_cast(float, w.w << 16); v[7] = __builtin_bit_cast(float, w.w & 0xffff0000u); }
#define EPI_ROWS(ai, m) _Pragma("unroll") for (int ai = 0; ai < 2; ++ai) _Pragma("unroll") for (int m = 0; m < 4; ++m)
#define EPI_GET(v, ai, m) asm volatile("" ::: "memory"); float v[2][8]; _Pragma("unroll") for (int bj = 0; bj < 2; ++bj) _Pragma("unroll") for (int n = 0; n < 2; ++n) _Pragma("unroll") for (int j = 0; j < 4; ++j) v[bj][4 * n + j] = acc[ai][bj][m][n][j];
constexpr float EPSN = 1e-6f;
constexpr float C2ATT = 0.125f * 1.4426950408889634f;
constexpr float IDXSC = 0.0625f;

struct EpiProj {
    static constexpr bool PERM = true, AFTER_DRAIN = false;
    bf16_t *QLAT, *AK, *AV, *KI, *BQ, *GA; float *QLSS, *WIDX; const float *gk, *gki;
    __device__ __forceinline__ void operator()(const f32x4 (&acc)[2][2][4][2], const Unit& u, int wr, int wc, int fr_, int fq_) const { int fr = fr_, fq = fq_; asm volatile("" : "+v"(fr), "+v"(fq));
        const int pn = u.pn, rowb = u.pm * BM + wr * 64 + fr, cw = 64 * wc + 8 * fq;
        if (pn == 0) {
            EPI_ROWS(ai, m) { EPI_GET(v, ai, m) const int row = rowb + ai * HALF + m * 16; float ss = 0.f;
#pragma unroll
                for (int bj = 0; bj < 2; ++bj) { _Pragma("unroll") for (int j = 0; j < 8; ++j) ss += v[bj][j] * v[bj][j]; st8(QLAT + (size_t)row * 256 + cw + 32 * bj, v[bj]); }
                ss += __shfl_xor(ss, 16); ss += __shfl_xor(ss, 32); if (fq == 0) QLSS[row * 4 + wc] = ss; }
        } else if (pn <= 2 || pn == 5) {
            if (pn == 5 && wc != 0) { if (wc == 1 && fq == 0) { EPI_ROWS(ai, m) { const int row = rowb + ai * HALF + m * 16; *(f32x4*)(WIDX + row * 4) = acc[ai][0][m][0]; } } return; }
            const float* g = (pn == 5) ? gki : gk; float gv[2][8];
#pragma unroll
            for (int bj = 0; bj < 2; ++bj) { _Pragma("unroll") for (int j = 0; j < 8; ++j) gv[bj][j] = g[32 * bj + 8 * fq + j]; }
            bf16_t* O = (pn == 5) ? KI : AK; const int ld = (pn == 5) ? 64 : 512, c0 = (pn == 5) ? 8 * fq : (pn - 1) * 256 + cw;
            EPI_ROWS(ai, m) { EPI_GET(v, ai, m) const int row = rowb + ai * HALF + m * 16; float ss = 0.f;
#pragma unroll
                for (int bj = 0; bj < 2; ++bj) { _Pragma("unroll") for (int j = 0; j < 8; ++j) ss += v[bj][j] * v[bj][j]; }
                ss += __shfl_xor(ss, 16); ss += __shfl_xor(ss, 32); const float r = __builtin_amdgcn_rsqf(ss * (1.0f / 64.0f) + EPSN);
#pragma unroll
                for (int bj = 0; bj < 2; ++bj) { _Pragma("unroll") for (int j = 0; j < 8; ++j) v[bj][j] *= r * gv[bj][j]; st8(O + (size_t)row * ld + c0 + 32 * bj, v[bj]); } }
        } else {
            bf16_t* O; int ld, c0, act;
            if (pn <= 4) { O = AV; ld = 512; c0 = (pn - 3) * 256; act = 0; }
            else if (pn <= 13) { const int k = (pn - 6) >> 1; O = BQ + (size_t)k * ((size_t)16384 * 512); ld = 512; c0 = ((pn - 6) & 1) * 256; act = (k == 0 || k == 3) ? 1 : 0; }
            else { const int k = (pn - 14) >> 2; O = GA + (size_t)k * ((size_t)16384 * 1024); ld = 1024; c0 = ((pn - 14) & 3) * 256; act = 2; }
            EPI_ROWS(ai, m) { EPI_GET(v, ai, m) const int row = rowb + ai * HALF + m * 16;
#pragma unroll
                for (int bj = 0; bj < 2; ++bj) { if (act) { _Pragma("unroll") for (int j = 0; j < 8; ++j) { const float s = sigm(v[bj][j]); v[bj][j] = (act == 1) ? v[bj][j] * s : s; } }
                    st8(O + (size_t)row * ld + c0 + cw + 32 * bj, v[bj]); } }
        }
    }
};
struct EpiQ {
    static constexpr bool PERM = true, AFTER_DRAIN = false;
    bf16_t *AQ, *QI; float* QN; const float *QLSS, *WIDX, *gq;
    __device__ __forceinline__ void operator()(const f32x4 (&acc)[2][2][4][2], const Unit& u, int wr, int wc, int fr_, int fq_) const { int fr = fr_, fq = fq_; asm volatile("" : "+v"(fr), "+v"(fq));
        const int pn = u.pn, rowb = u.pm * BM + wr * 64 + fr, cw = 64 * wc + 8 * fq;
        float gv[2][8];
#pragma unroll
        for (int bj = 0; bj < 2; ++bj) { _Pragma("unroll") for (int j = 0; j < 8; ++j) gv[bj][j] = gq[32 * bj + 8 * fq + j]; }
        EPI_ROWS(ai, m) { EPI_GET(v, ai, m) const int row = rowb + ai * HALF + m * 16;
            const f32x4 q4 = *(const f32x4*)(QLSS + row * 4); const float s = __builtin_amdgcn_rsqf(((q4[0] + q4[1]) + (q4[2] + q4[3])) * (1.0f / 256.0f) + EPSN);
            float ss = 0.f;
#pragma unroll
            for (int bj = 0; bj < 2; ++bj) { _Pragma("unroll") for (int j = 0; j < 8; ++j) ss += v[bj][j] * v[bj][j]; }
            ss += __shfl_xor(ss, 16); ss += __shfl_xor(ss, 32);
            if (pn < 2) { const float f = s * __builtin_amdgcn_rsqf(s * s * ss * (1.0f / 64.0f) + EPSN) * C2ATT;
#pragma unroll
                for (int bj = 0; bj < 2; ++bj) { _Pragma("unroll") for (int j = 0; j < 8; ++j) v[bj][j] *= f * gv[bj][j]; st8(AQ + (size_t)row * 512 + pn * 256 + cw + 32 * bj, v[bj]); }
            } else { const float f = s * WIDX[row * 4 + wc] * IDXSC;
#pragma unroll
                for (int bj = 0; bj < 2; ++bj) { _Pragma("unroll") for (int j = 0; j < 8; ++j) v[bj][j] *= f; st8(QI + (size_t)row * 256 + cw + 32 * bj, v[bj]); }
                if (fq == 0) QN[row * 4 + wc] = sqrtf(ss) * fabsf(f); }
        }
    }
};
template <int MODE> struct EpiMerge {
    static constexpr bool PERM = true, AFTER_DRAIN = false;
    const bf16_t* G; bf16_t* T;
    __device__ __forceinline__ void operator()(const f32x4 (&acc)[2][2][4][2], const Unit& u, int wr, int wc, int fr_, int fq_) const { int fr = fr_, fq = fq_; asm volatile("" : "+v"(fr), "+v"(fq));
        const int rowb = u.pm * BM + wr * 64 + fr, c0 = u.pn * BM + 64 * wc + 8 * fq;
        EPI_ROWS(ai, m) { EPI_GET(v, ai, m) const int row = rowb + ai * HALF + m * 16;
#pragma unroll
            for (int bj = 0; bj < 2; ++bj) { const size_t off = (size_t)row * 1024 + c0 + 32 * bj; float g[8]; ld8(G + off, g);
                if (MODE == 1) { float t[8]; ld8(T + off, t); _Pragma("unroll") for (int j = 0; j < 8; ++j) v[bj][j] = t[j] + g[j] * v[bj][j]; }
                else { _Pragma("unroll") for (int j = 0; j < 8; ++j) v[bj][j] *= g[j]; }
                st8(T + off, v[bj]); } }
    }
};
struct EpiRes {
    static constexpr bool PERM = true, AFTER_DRAIN = false;
    const float* base; float* out; const float* gate; const float* bias;
    __device__ __forceinline__ void operator()(const f32x4 (&acc)[2][2][4][2], const Unit& u, int wr, int wc, int fr_, int fq_) const { int fr = fr_, fq = fq_; asm volatile("" : "+v"(fr), "+v"(fq));
        const int rowb = u.pm * BM + wr * 64 + fr, c0 = u.pn * BM + 64 * wc + 8 * fq; const float* gp = gate + (u.pm >= 32 ? 6144 : 0);
        float gv[2][8], bv[2][8];
#pragma unroll
        for (int bj = 0; bj < 2; ++bj) { _Pragma("unroll") for (int j = 0; j < 8; ++j) { gv[bj][j] = gp[c0 + 32 * bj + j]; bv[bj][j] = bias ? bias[c0 + 32 * bj + j] : 0.f; } }
        EPI_ROWS(ai, m) { EPI_GET(v, ai, m) const int row = rowb + ai * HALF + m * 16;
#pragma unroll
            for (int bj = 0; bj < 2; ++bj) { const size_t off = (size_t)row * 1024 + c0 + 32 * bj; const f32x4 x0 = *(const f32x4*)(base + off), x1 = *(const f32x4*)(base + off + 4);
                f32x4 o0, o1;
#pragma unroll
                for (int j = 0; j < 4; ++j) { o0[j] = x0[j] + gv[bj][j] * (v[bj][j] + bv[bj][j]); o1[j] = x1[j] + gv[bj][4 + j] * (v[bj][4 + j] + bv[bj][4 + j]); }
                *(f32x4*)(out + off) = o0; *(f32x4*)(out + off + 4) = o1; } }
    }
};
struct EpiUp {
    static constexpr bool PERM = true, AFTER_DRAIN = false;
    bf16_t* O; const float* bias;
    __device__ __forceinline__ void operator()(const f32x4 (&acc)[2][2][4][2], const Unit& u, int wr, int wc, int fr_, int fq_) const { int fr = fr_, fq = fq_; asm volatile("" : "+v"(fr), "+v"(fq));
        const int rowb = u.pm * BM + wr * 64 + fr, c0 = u.pn * BM + 64 * wc + 8 * fq;
        float bv[2][8];
#pragma unroll
        for (int bj = 0; bj < 2; ++bj) { _Pragma("unroll") for (int j = 0; j < 8; ++j) bv[bj][j] = bias[c0 + 32 * bj + j]; }
        EPI_ROWS(ai, m) { EPI_GET(v, ai, m) const int row = rowb + ai * HALF + m * 16;
#pragma unroll
            for (int bj = 0; bj < 2; ++bj) { _Pragma("unroll") for (int j = 0; j < 8; ++j) { const float t = fmaxf(v[bj][j] + bv[bj][j], 0.f); v[bj][j] = t * t; }
                st8(O + (size_t)row * 4096 + c0 + 32 * bj, v[bj]); } }
    }
};
template <class Epi, class Sched, bool ALIGN_EPI = false, bool SP2 = false>
__device__ __forceinline__ void gemm_phase(PG8_LAS unsigned char* lds, const Gemm g, const Sched& S, const Epi& E) {
    const int tid = threadIdx.x, wid = __builtin_amdgcn_readfirstlane(tid >> 6), lane = tid & 63, wr = wid >> 2, wc = wid & 3, fr = lane & 15, fq = lane >> 4;
    const int K = g.K, nt = K / BK;
    unsigned voffA[2], voffB[2];
#pragma unroll
    for (int i = 0; i < 2; ++i) { int R, C; stage_rc(tid * 16 + i * 8192, R, C); const int Rb = Epi::PERM ? ((R & ~31) + perm32(R & 31)) : R;
        voffA[i] = (unsigned)(R * K + C) * 2u; voffB[i] = (unsigned)(Rb * K + C) * 2u; }
    const size_t kstep = (size_t)(BK * 2);
    const size_t hstep = (size_t)HALF * K * 2;
    const size_t tstep = 2 * hstep;
    const unsigned ldsw = (unsigned)wid * 1024u;
    const int aoff = lds_byte(wr * 64 + fr, fq * 8), boff = lds_byte(wc * 32 + fr, fq * 8);
#define PG8_SA(b, h) (((b) * 2 + (h)) * HTB)
#define PG8_SB(b, h) ((4 + (b) * 2 + (h)) * HTB)
#define PG8_STAGE(bufoff, gbase, voff) do { _Pragma("unroll") for (int _i = 0; _i < 2; ++_i) \
        __builtin_amdgcn_global_load_lds((const unsigned*)((const char*)(gbase) + (voff)[_i]), (PG8_LAS unsigned*)(lds + (bufoff) + ldsw + _i * 8192), 16, 0, 0); } while (0)
#define PG8_LDA(dst, b, h) do { _Pragma("unroll") for (int m = 0; m < 4; ++m) _Pragma("unroll") for (int k = 0; k < 2; ++k) dst[m][k] = *(const PG8_LAS bf16x8*)(lds + PG8_SA(b, h) + aoff + m * 2048 + k * 1024); } while (0)
#define PG8_LDB(dst, b, h) do { _Pragma("unroll") for (int n = 0; n < 2; ++n) _Pragma("unroll") for (int k = 0; k < 2; ++k) dst[n][k] = *(const PG8_LAS bf16x8*)(lds + PG8_SB(b, h) + boff + n * 2048 + k * 1024); } while (0)
#define PG8_MMA(ai, bj, At, Bt) do { __builtin_amdgcn_s_setprio(1); _Pragma("unroll") for (int m = 0; m < 4; ++m) _Pragma("unroll") for (int n = 0; n < 2; ++n) _Pragma("unroll") for (int k = 0; k < 2; ++k) \
        acc[ai][bj][m][n] = __builtin_amdgcn_mfma_f32_16x16x32_bf16(Bt[n][k], At[m][k], acc[ai][bj][m][n], 0, 0, 0); __builtin_amdgcn_s_setprio(0); } while (0)
#define PG8_WAIT_V(n) asm volatile("s_waitcnt vmcnt(" #n ")" ::: "memory")
#define PG8_WAIT_L(n) asm volatile("s_waitcnt lgkmcnt(" #n ")" ::: "memory")
#define PG8_BAR __builtin_amdgcn_s_barrier()
#define PG8_SCHED __builtin_amdgcn_sched_barrier(0)
    Unit cur, nxt; int ui = 0;
    if (!S.next(0, cur)) return;
    f32x4 acc[2][2][4][2];
#pragma unroll
    for (int a = 0; a < 2; ++a)
#pragma unroll
        for (int b = 0; b < 2; ++b)
#pragma unroll
            for (int m = 0; m < 4; ++m)
#pragma unroll
                for (int n = 0; n < 2; ++n) acc[a][b][m][n] = (f32x4){0.f, 0.f, 0.f, 0.f};
    bf16x8 At[4][2], B0[2][2], B1[2][2];
    const char* cA = (const char*)g.A + (size_t)cur.pm * tstep; const char* cB = (const char*)g.Bt + (size_t)cur.pn * tstep;
    S.a_ready(cur);
    if constexpr (SP2) {
        PG8_STAGE(PG8_SB(0, 0), cB, voffB); PG8_STAGE(PG8_SB(0, 1), cB + hstep, voffB); PG8_STAGE(PG8_SA(0, 0), cA, voffA); PG8_STAGE(PG8_SA(0, 1), cA + hstep, voffA);
        if (wr == 1) PG8_BAR;
        PG8_WAIT_V(2); PG8_BAR;
        PG8_STAGE(PG8_SB(1, 0), cB + kstep, voffB); PG8_STAGE(PG8_SA(1, 0), cA + kstep, voffA); PG8_STAGE(PG8_SB(1, 1), cB + hstep + kstep, voffB);
        PG8_WAIT_V(6); PG8_BAR;
    } else {
        PG8_STAGE(PG8_SB(0, 0), cB, voffB); PG8_STAGE(PG8_SA(0, 0), cA, voffA); PG8_STAGE(PG8_SB(0, 1), cB + hstep, voffB); PG8_STAGE(PG8_SA(0, 1), cA + hstep, voffA);
        if (wr == 1) PG8_BAR;
        PG8_WAIT_V(4); PG8_BAR;
        PG8_STAGE(PG8_SB(1, 0), cB + kstep, voffB); PG8_STAGE(PG8_SA(1, 0), cA + kstep, voffA); PG8_STAGE(PG8_SB(1, 1), cB + hstep + kstep, voffB);
        PG8_WAIT_V(6); PG8_BAR;
    }
    for (;;) {
        const bool has_next = S.next(ui + 1, nxt);
        const char* nA = has_next ? (const char*)g.A + (size_t)nxt.pm * tstep : cA; const char* nB = has_next ? (const char*)g.Bt + (size_t)nxt.pn * tstep : cB;
        for (int t = 0; t < nt; t += 2) {
            const bool last = (t == nt - 2);
            const char* a1 = cA + (size_t)(t + 1) * kstep;
            const char* a2 = last ? nA : cA + (size_t)(t + 2) * kstep; const char* b2 = last ? nB : cB + (size_t)(t + 2) * kstep;
            const char* a3 = a2 + kstep; const char* b3 = b2 + kstep;
            if (last && has_next) S.a_ready(nxt);
            if constexpr (SP2) {
            PG8_LDB(B0, 0, 0); PG8_LDB(B1, 0, 1); PG8_SCHED; PG8_LDA(At, 0, 0); PG8_STAGE(PG8_SA(1, 1), a1 + hstep, voffA);
            PG8_WAIT_V(8); PG8_WAIT_L(0); PG8_BAR; PG8_MMA(0, 0, At, B0); PG8_MMA(0, 1, At, B1); PG8_BAR; PG8_SCHED;
            PG8_LDA(At, 0, 1); PG8_STAGE(PG8_SB(0, 0), b2, voffB); PG8_STAGE(PG8_SB(0, 1), b2 + hstep, voffB); PG8_STAGE(PG8_SA(0, 0), a2, voffA);
            PG8_WAIT_V(8); PG8_WAIT_L(0); PG8_BAR; PG8_MMA(1, 0, At, B0); PG8_MMA(1, 1, At, B1); PG8_BAR; PG8_SCHED;
            PG8_LDB(B0, 1, 0); PG8_LDB(B1, 1, 1); PG8_SCHED; PG8_LDA(At, 1, 0); PG8_STAGE(PG8_SA(0, 1), a2 + hstep, voffA);
            PG8_WAIT_V(8); PG8_WAIT_L(0); PG8_BAR; PG8_MMA(0, 0, At, B0); PG8_MMA(0, 1, At, B1); PG8_BAR; PG8_SCHED;
            PG8_LDA(At, 1, 1); PG8_STAGE(PG8_SB(1, 0), b3, voffB); PG8_STAGE(PG8_SB(1, 1), b3 + hstep, voffB); PG8_STAGE(PG8_SA(1, 0), a3, voffA);
            PG8_WAIT_V(8); PG8_WAIT_L(0); PG8_BAR; PG8_MMA(1, 0, At, B0); PG8_MMA(1, 1, At, B1); PG8_BAR; PG8_SCHED;
            } else {
            PG8_LDB(B0, 0, 0); PG8_SCHED; PG8_LDA(At, 0, 0); PG8_STAGE(PG8_SA(1, 1), a1 + hstep, voffA);
            PG8_WAIT_L(8); PG8_BAR; PG8_WAIT_L(0); PG8_MMA(0, 0, At, B0); PG8_BAR; PG8_SCHED;
            PG8_LDB(B1, 0, 1); PG8_STAGE(PG8_SB(0, 0), b2, voffB);
            PG8_BAR; PG8_WAIT_L(0); PG8_MMA(0, 1, At, B1); PG8_BAR;
            PG8_LDA(At, 0, 1); PG8_STAGE(PG8_SA(0, 0), a2, voffA);
            PG8_BAR; PG8_WAIT_L(0); PG8_MMA(1, 0, At, B0); PG8_BAR; PG8_SCHED;
            PG8_STAGE(PG8_SB(0, 1), b2 + hstep, voffB);
            PG8_WAIT_V(6); PG8_BAR; PG8_MMA(1, 1, At, B1); PG8_BAR;
            PG8_LDB(B0, 1, 0); PG8_SCHED; PG8_LDA(At, 1, 0); PG8_STAGE(PG8_SA(0, 1), a2 + hstep, voffA);
            PG8_WAIT_L(8); PG8_BAR; PG8_WAIT_L(0); PG8_MMA(0, 0, At, B0); PG8_BAR; PG8_SCHED;
            PG8_LDB(B1, 1, 1); PG8_STAGE(PG8_SB(1, 0), b3, voffB);
            PG8_BAR; PG8_WAIT_L(0); PG8_MMA(0, 1, At, B1); PG8_BAR;
            PG8_LDA(At, 1, 1); PG8_STAGE(PG8_SA(1, 0), a3, voffA);
            PG8_BAR; PG8_WAIT_L(0); PG8_MMA(1, 0, At, B0); PG8_BAR; PG8_SCHED;
            PG8_STAGE(PG8_SB(1, 1), b3 + hstep, voffB);
            PG8_WAIT_V(6); PG8_BAR; PG8_MMA(1, 1, At, B1); PG8_BAR;
            }
        }
        if constexpr (ALIGN_EPI) { if (wr == 0) PG8_BAR; }
        if constexpr (!Epi::AFTER_DRAIN) { E(acc, cur, wr, wc, fr, fq); S.done(cur); }
        if (!has_next) break;
#pragma unroll
        for (int a = 0; a < 2; ++a)
#pragma unroll
            for (int b = 0; b < 2; ++b)
#pragma unroll
                for (int m = 0; m < 4; ++m)
#pragma unroll
                    for (int n = 0; n < 2; ++n) acc[a][b][m][n] = (f32x4){0.f, 0.f, 0.f, 0.f};
        cur = nxt; cA = nA; cB = nB; ++ui;
        if constexpr (ALIGN_EPI) { if (wr == 1) PG8_BAR; }
    }
    PG8_WAIT_V(0);
    if constexpr (!ALIGN_EPI) { if (wr == 0) PG8_BAR; }
    PG8_BAR;
    if constexpr (Epi::AFTER_DRAIN) { E.fused(acc, cur, wr, wc, fr, fq, lds, wid, lane); S.done(cur); }
#undef PG8_SA
#undef PG8_SB
#undef PG8_STAGE
#undef PG8_LDA
#undef PG8_LDB
#undef PG8_MMA
#undef PG8_WAIT_V
#undef PG8_WAIT_L
#undef PG8_BAR
#undef PG8_SCHED
}
}
namespace attn_body {
using bf16=__hip_bfloat16;
using bf16x8=__attribute__((ext_vector_type(8)))short;
using s16x4=__attribute__((ext_vector_type(4)))short;
using f32x16=__attribute__((ext_vector_type(16)))float;
using u32x4=__attribute__((ext_vector_type(4)))unsigned;
constexpr int BATCH=2,NHEAD=8,SEQ=8192,D=64,DM=NHEAD*D;
constexpr int NW=8,QBLK=32,QB=QBLK*NW,KVBLK=64,NQB=SEQ/QB;
__device__ __forceinline__ int crow(int r,int hi){return (r&3)+8*(r>>2)+4*hi;}
#define SBAR() __builtin_amdgcn_sched_barrier(0)
constexpr int NSLOT=3, SLOTB=8192;
constexpr int LDS_K=0, LDS_V=NSLOT*SLOTB, LDS_WS=2*NSLOT*SLOTB, LDS_OST=LDS_WS+NW*64*4, LDS_MR=LDS_OST+NW*4096, LDS_BYTES=LDS_MR+NW*1024;
__device__ __forceinline__ void glds16(const void*gsrc,unsigned lds_dst){unsigned keep;
  asm volatile("s_mov_b32 %0, m0\n\ts_mov_b32 m0, %2\n\ts_nop 0\n\tglobal_load_lds_dwordx4 %1, off\n\ts_mov_b32 m0, %0":"=&s"(keep):"v"(gsrc),"s"(lds_dst):"memory");}
__device__ __forceinline__ void glds4(const void*gsrc,unsigned lds_dst){unsigned keep;
  asm volatile("s_mov_b32 %0, m0\n\ts_mov_b32 m0, %2\n\ts_nop 0\n\tglobal_load_lds_dword %1, off\n\ts_mov_b32 m0, %0":"=&s"(keep):"v"(gsrc),"s"(lds_dst):"memory");}
typedef float f32x2_t __attribute__((ext_vector_type(2))); typedef __bf16 bf16x2_t __attribute__((ext_vector_type(2)));
__device__ __forceinline__ unsigned cvtpk_s(float lo,float hi){f32x2_t v={lo,hi};bf16x2_t b=__builtin_convertvector(v,bf16x2_t);return __builtin_bit_cast(unsigned,b);}
#define WAIT_BAR(N) asm volatile("s_waitcnt vmcnt(" #N ") lgkmcnt(0)\n\ts_barrier":::"memory")
__device__ __forceinline__ float mexp(float v,unsigned W,int e){const float p=__builtin_amdgcn_exp2f(v);return __builtin_bit_cast(float,__builtin_bit_cast(unsigned,p)&(unsigned)(((int)(W<<e))>>31));}
__device__ __forceinline__ void qkt(f32x16&p0,f32x16&p1,const char*Kslot,const bf16x8*qr,const f32x16&negm,int r32,int hi){
  const char*kb=Kslot+hi*1024+r32*16;
  #pragma unroll
  for(int d0=0;d0<4;++d0){
    const bf16x8 b0=*reinterpret_cast<const bf16x8*>(kb+d0*2048);
    const bf16x8 b1=*reinterpret_cast<const bf16x8*>(kb+d0*2048+512);
    if(d0==0){p0=__builtin_amdgcn_mfma_f32_32x32x16_bf16(b0,qr[0],negm,0,0,0);p1=__builtin_amdgcn_mfma_f32_32x32x16_bf16(b1,qr[0],negm,0,0,0);}
    else{p0=__builtin_amdgcn_mfma_f32_32x32x16_bf16(b0,qr[d0],p0,0,0,0);p1=__builtin_amdgcn_mfma_f32_32x32x16_bf16(b1,qr[d0],p1,0,0,0);}}
}
typedef __attribute__((address_space(3))) const char* lds_cptr;
typedef short v4i16_t __attribute__((ext_vector_type(4)));
__device__ __forceinline__ void kload8(bf16x8*kf,lds_cptr kp){
  kf[0]=*(const __attribute__((address_space(3))) bf16x8*)(kp);      kf[1]=*(const __attribute__((address_space(3))) bf16x8*)(kp+512);
  kf[2]=*(const __attribute__((address_space(3))) bf16x8*)(kp+2048); kf[3]=*(const __attribute__((address_space(3))) bf16x8*)(kp+2560);
  kf[4]=*(const __attribute__((address_space(3))) bf16x8*)(kp+4096); kf[5]=*(const __attribute__((address_space(3))) bf16x8*)(kp+4608);
  kf[6]=*(const __attribute__((address_space(3))) bf16x8*)(kp+6144); kf[7]=*(const __attribute__((address_space(3))) bf16x8*)(kp+6656);
}
__device__ __forceinline__ void kload2(bf16x8*kf,lds_cptr kp,int j){ kf[2*j]=*(const __attribute__((address_space(3))) bf16x8*)(kp+j*2048); kf[2*j+1]=*(const __attribute__((address_space(3))) bf16x8*)(kp+j*2048+512); }
__device__ __forceinline__ s16x4 vtr(lds_cptr p){ return __builtin_bit_cast(s16x4,__builtin_amdgcn_ds_read_tr16_b64_v4i16((__attribute__((address_space(3))) v4i16_t*)p)); }
__device__ __forceinline__ void pv(f32x16*o,int vb,bf16x8 pa0,bf16x8 pa1,bf16x8 pa2,bf16x8 pa3){
  #pragma unroll
  for(int d0=0;d0<2;++d0){s16x4 lo[4],hi[4];
    #pragma unroll
    for(int ks=0;ks<4;++ks){
      asm volatile("ds_read_b64_tr_b16 %0,%1 offset:%c2":"=&v"(lo[ks]):"v"(vb),"i"(d0*4096+ks*1024):"memory");
      asm volatile("ds_read_b64_tr_b16 %0,%1 offset:%c2":"=&v"(hi[ks]):"v"(vb),"i"(d0*4096+ks*1024+512):"memory");}
    asm volatile("s_waitcnt lgkmcnt(0)":::"memory");SBAR();
    #define PK(k) (bf16x8){lo[k][0],lo[k][1],lo[k][2],lo[k][3],hi[k][0],hi[k][1],hi[k][2],hi[k][3]}
    o[d0]=__builtin_amdgcn_mfma_f32_32x32x16_bf16(pa0,PK(0),o[d0],0,0,0);
    o[d0]=__builtin_amdgcn_mfma_f32_32x32x16_bf16(pa1,PK(1),o[d0],0,0,0);
    o[d0]=__builtin_amdgcn_mfma_f32_32x32x16_bf16(pa2,PK(2),o[d0],0,0,0);
    o[d0]=__builtin_amdgcn_mfma_f32_32x32x16_bf16(pa3,PK(3),o[d0],0,0,0);
    #undef PK
  }
}
#ifndef ATTN_STORE16
#define ATTN_STORE16(p,v) (*(u32x4*)(p)=(v))
#endif
__device__ __forceinline__ void attn_unit(int b,int h,int qb,const bf16*Q,const bf16*__restrict__ K,const bf16*__restrict__ V,bf16*O,const unsigned*MW,char*shm){
  const int tid=threadIdx.x,lane=tid&63,r32=lane&31,hi=lane>>5; const int wid=__builtin_amdgcn_readfirstlane(tid>>6);
  const long rowbase=(long)b*SEQ; const int q0=qb*QB;
  const bf16*Qw=Q+(rowbase+q0+wid*QBLK)*DM+h*D;
  const bf16*Kh=K+rowbase*DM+h*D,*Vh=V+rowbase*DM+h*D;
  const unsigned lds0=(unsigned)(uintptr_t)shm;
  float*wsf=(float*)(shm+LDS_WS)+wid*64;
  const bf16*ksrc=Kh+(long)lane*DM+wid*8;
  const bf16*vsrc=Vh+(long)(16*(wid&3)+(lane>>2))*DM+(wid>>2)*32+(lane&3)*8;
  const unsigned kdst=lds0+LDS_K+wid*1024, vdst=lds0+LDS_V+wid*1024, mdst=lds0+LDS_MR+wid*1024;
  const unsigned*msrc=MW+((size_t)(b*256+(q0>>5)+wid)*128)*64+lane;
  #define DMA_K(t,slot) glds16(ksrc+(long)(t)*KVBLK*DM,(unsigned)__builtin_amdgcn_readfirstlane(kdst+(slot)))
  #define DMA_V(t,slot) glds16(vsrc+(long)(t)*KVBLK*DM,(unsigned)__builtin_amdgcn_readfirstlane(vdst+(slot)))
  #define DMA_M(t) glds4(msrc+(long)(t)*64,(unsigned)__builtin_amdgcn_readfirstlane(mdst+(((t)&3)<<8)))
  const int vb0=(int)(lds0+LDS_V)+((lane>>4)&1)*32+(lane&3)*8+(4*hi+((lane&15)>>2))*64;
  const char*Kbase=shm+LDS_K; bf16x8 kf[8];
  const lds_cptr shm3=(lds_cptr)shm; const lds_cptr kp0=shm3+LDS_K+hi*1024+r32*16; const lds_cptr vp0=shm3+LDS_V+((lane>>4)&1)*32+(lane&3)*8+(4*hi+((lane&15)>>2))*64;
  const __attribute__((address_space(3))) unsigned* mrd=(const __attribute__((address_space(3))) unsigned*)(shm3+LDS_MR+wid*1024)+lane;
  const int NT=(q0+QB)/KVBLK;
  DMA_M(0);DMA_K(0,0);DMA_V(0,0);DMA_K(1,SLOTB);
  bf16x8 qr[4];
  #pragma unroll
  for(int d0=0;d0<4;++d0)qr[d0]=*reinterpret_cast<const bf16x8*>(&Qw[(long)r32*DM+d0*16+hi*8]);
  float l_reg=0.f;f32x16 o[2];o[0]=f32x16{};o[1]=f32x16{};const f32x16 negm=f32x16{};
  f32x16 pA0,pA1,pB0,pB1;
  int sl_prev=0,sl_cur=0,sl_next=SLOTB;
  #define ROT() do{sl_prev=sl_cur;sl_cur=sl_next;sl_next=(sl_next==(NSLOT-1)*SLOTB)?0:sl_next+SLOTB;}while(0)
  DMA_K(2,2*SLOTB);DMA_M(1);
  WAIT_BAR(4);
  { const unsigned W0=mrd[0];
    qkt(pA0,pA1,Kbase,qr,negm,r32,hi);
    _Pragma("unroll") for(int r=0;r<16;++r){pA0[r]=mexp(pA0[r],W0,r);pA1[r]=mexp(pA1[r],W0,16+r);} }
  WAIT_BAR(0);
  DMA_K(3,0);DMA_V(1,SLOTB);DMA_M(2);
  ROT();
  kload8(kf,kp0+sl_cur);
  WAIT_BAR(3);
  s16x4 vlo[8],vhi[8]; u32x4 pw0,pw1,pw2,pw3;
  #define PKW(P,B) cvtpk_s(P[B],P[B+1])
  #define PAF(k) __builtin_bit_cast(bf16x8,pw##k)
  #define VFR(i) (bf16x8){vlo[i][0],vlo[i][1],vlo[i][2],vlo[i][3],vhi[i][0],vhi[i][1],vhi[i][2],vhi[i][3]}
  #define PIN(x) asm volatile("":"+v"(x))
  #define GAPA(MF,A0,A1,A2,A3,W0,W1,PW) do{ MF; sacc+=A0; sacc+=A1; sacc+=A2; sacc+=A3; PIN(sacc); W0; W1; PIN(PW); SBAR(); }while(0)
  #define GAPB(MF,X,B,E0) do{ MF; X[B]=mexp(X[B],Wm,E0+B); X[B+1]=mexp(X[B+1],Wm,E0+B+1); X[B+2]=mexp(X[B+2],Wm,E0+B+2); X[B+3]=mexp(X[B+3],Wm,E0+B+3); PIN(X); SBAR(); }while(0)
  #define VRD(i) do{ vlo[i]=vtr(vp_+(((i)>>2)*4096+((i)&3)*1024)); vhi[i]=vtr(vp_+(((i)>>2)*4096+((i)&3)*1024+512)); }while(0)
  #define KRD(G,j) do{ if(G){ kload2(kf,kp0+sl_next,j); SBAR(); } }while(0)
  #define STEP(C0,C1,P0,P1,t,GK,GV,GM,GL) do{ SBAR(); \
    const lds_cptr vp_=vp0+sl_prev; const unsigned Wm=mrd[((t)&3)<<6]; \
    VRD(0); SBAR(); float sacc=(P0[0]+P0[1]); \
    GAPA(C0=__builtin_amdgcn_mfma_f32_32x32x16_bf16(kf[0],qr[0],negm,0,0,0), P0[2],P0[3],P0[4],P0[5],     pw0[0]=PKW(P0,0), pw0[1]=PKW(P0,2), pw0); \
    VRD(4); SBAR(); GAPA(C1=__builtin_amdgcn_mfma_f32_32x32x16_bf16(kf[1],qr[0],negm,0,0,0), P0[6],P0[7],P0[8],P0[9],     pw0[2]=PKW(P0,4), pw0[3]=PKW(P0,6), pw0); \
    VRD(1); SBAR(); GAPA(C0=__builtin_amdgcn_mfma_f32_32x32x16_bf16(kf[2],qr[1],C0,0,0,0),   P0[10],P0[11],P0[12],P0[13], pw1[0]=PKW(P0,8), pw1[1]=PKW(P0,10), pw1); \
    VRD(5); SBAR(); GAPA(C1=__builtin_amdgcn_mfma_f32_32x32x16_bf16(kf[3],qr[1],C1,0,0,0),   P0[14],P0[15],P1[0],P1[1],   pw1[2]=PKW(P0,12),pw1[3]=PKW(P0,14), pw1); \
    VRD(2); SBAR(); GAPA(C0=__builtin_amdgcn_mfma_f32_32x32x16_bf16(kf[4],qr[2],C0,0,0,0),   P1[2],P1[3],P1[4],P1[5],     pw2[0]=PKW(P1,0), pw2[1]=PKW(P1,2), pw2); \
    VRD(6); SBAR(); GAPA(C1=__builtin_amdgcn_mfma_f32_32x32x16_bf16(kf[5],qr[2],C1,0,0,0),   P1[6],P1[7],P1[8],P1[9],     pw2[2]=PKW(P1,4), pw2[3]=PKW(P1,6), pw2); \
    VRD(3); SBAR(); GAPA(C0=__builtin_amdgcn_mfma_f32_32x32x16_bf16(kf[6],qr[3],C0,0,0,0),   P1[10],P1[11],P1[12],P1[13], pw3[0]=PKW(P1,8), pw3[1]=PKW(P1,10), pw3); \
    VRD(7); SBAR(); GAPA(C1=__builtin_amdgcn_mfma_f32_32x32x16_bf16(kf[7],qr[3],C1,0,0,0),   P1[14],P1[15],0.f,0.f,       pw3[2]=PKW(P1,12),pw3[3]=PKW(P1,14), pw3); \
    l_reg+=sacc; \
    if(GK){DMA_K((t)+3,sl_cur);} if(GV){DMA_V((t)+1,sl_next);} if(GM){DMA_M((t)+2);} \
    SBAR(); \
    GAPB(o[0]=__builtin_amdgcn_mfma_f32_32x32x16_bf16(PAF(0),VFR(0),o[0],0,0,0), C0,0,0); \
    GAPB(o[1]=__builtin_amdgcn_mfma_f32_32x32x16_bf16(PAF(0),VFR(4),o[1],0,0,0), C0,4,0); \
    KRD(GL,0); GAPB(o[0]=__builtin_amdgcn_mfma_f32_32x32x16_bf16(PAF(1),VFR(1),o[0],0,0,0), C0,8,0); \
    KRD(GL,1); GAPB(o[1]=__builtin_amdgcn_mfma_f32_32x32x16_bf16(PAF(1),VFR(5),o[1],0,0,0), C0,12,0); \
    KRD(GL,2); GAPB(o[0]=__builtin_amdgcn_mfma_f32_32x32x16_bf16(PAF(2),VFR(2),o[0],0,0,0), C1,0,16); \
    KRD(GL,3); GAPB(o[1]=__builtin_amdgcn_mfma_f32_32x32x16_bf16(PAF(2),VFR(6),o[1],0,0,0), C1,4,16); \
    GAPB(o[0]=__builtin_amdgcn_mfma_f32_32x32x16_bf16(PAF(3),VFR(3),o[0],0,0,0), C1,8,16); \
    GAPB(o[1]=__builtin_amdgcn_mfma_f32_32x32x16_bf16(PAF(3),VFR(7),o[1],0,0,0), C1,12,16); \
    }while(0)
  int t=1;
  for(;t+5<NT;t+=2){
    STEP(pB0,pB1,pA0,pA1,t,true,true,true,true);     WAIT_BAR(3); ROT();
    STEP(pA0,pA1,pB0,pB1,t+1,true,true,true,true);   WAIT_BAR(3); ROT();
  }
  #define ENDW(tt) do{ if((tt)+3<NT){WAIT_BAR(3);} else if((tt)+2<NT){WAIT_BAR(2);} else {WAIT_BAR(0);} }while(0)
  for(;t+1<NT;t+=2){
    STEP(pB0,pB1,pA0,pA1,t,(t+3<NT),(t+1<NT),(t+2<NT),(t+1<NT));       ENDW(t);   ROT();
    STEP(pA0,pA1,pB0,pB1,t+1,(t+4<NT),(t+2<NT),(t+3<NT),(t+2<NT));     ENDW(t+1); ROT();
  }
  STEP(pB0,pB1,pA0,pA1,NT-1,false,false,false,false);
  { float sacc=pB0[0]+pB0[1]; _Pragma("unroll") for(int r=2;r<16;++r)sacc+=pB0[r]; _Pragma("unroll") for(int r=0;r<16;++r)sacc+=pB1[r]; l_reg+=sacc;
    pw0=(u32x4){PKW(pB0,0),PKW(pB0,2),PKW(pB0,4),PKW(pB0,6)};pw1=(u32x4){PKW(pB0,8),PKW(pB0,10),PKW(pB0,12),PKW(pB0,14)};pw2=(u32x4){PKW(pB1,0),PKW(pB1,2),PKW(pB1,4),PKW(pB1,6)};pw3=(u32x4){PKW(pB1,8),PKW(pB1,10),PKW(pB1,12),PKW(pB1,14)};
    SBAR(); pv(o,vb0+sl_cur,PAF(0),PAF(1),PAF(2),PAF(3)); }
  #undef PKW
  #undef PAF
  #undef VFR
  #undef PIN
  #undef GAPA
  #undef GAPB
  #undef VRD
  #undef KRD
  #undef STEP
  #undef ENDW
  {auto rr=__builtin_amdgcn_permlane32_swap(__float_as_uint(l_reg),__float_as_uint(l_reg),false,false);l_reg=__uint_as_float(rr[0])+__uint_as_float(rr[1]);}
  if(hi==0)wsf[32+r32]=l_reg;asm volatile("s_waitcnt lgkmcnt(0)":::"memory");
  float rli[16];
  #pragma unroll
  for(int r=0;r<16;++r)rli[r]=__builtin_amdgcn_rcpf(wsf[32+crow(r,hi)]);
  bf16*Ow=O+(rowbase+q0+wid*QBLK)*DM+h*D;
  { bf16*stg=(bf16*)(shm+LDS_OST)+wid*2048;
    #pragma unroll
    for(int r=0;r<16;++r){const int orow=crow(r,hi);
      #pragma unroll
      for(int d0=0;d0<2;++d0)stg[orow*64+d0*32+r32]=__float2bfloat16(o[d0][r]*rli[r]);}
    asm volatile("s_waitcnt lgkmcnt(0)":::"memory");
    #pragma unroll
    for(int i=0;i<4;++i){const int row=i*8+(lane>>3),ch=lane&7; const u32x4 v=*(const u32x4*)(stg+row*64+ch*8); ATTN_STORE16(Ow+(long)row*DM+ch*8,v);} }
  asm volatile("s_waitcnt lgkmcnt(0)\n\ts_barrier":::"memory");
  #undef DMA_K
  #undef DMA_V
  #undef DMA_M
  #undef ROT
}
constexpr int ATTN_LDS_BYTES=LDS_BYTES;
#undef SBAR
#undef WAIT_BAR
}
constexpr int NWAVES = 8;
#ifndef MK_N_LAUNCHES
#define MK_N_LAUNCHES 1
#endif
constexpr int NPHASE = 13;
constexpr int N_LAUNCHES = MK_N_LAUNCHES;
constexpr int BATCH = 2, SEQL = 8192, DMOD = 1024, M = BATCH * SEQL, DFF = 4096, NPROJ = 5632, DIN = 5444;
constexpr size_t MiB = 1u << 20;
constexpr size_t WS_CTL = 0, CTL_ZERO_BYTES = 1 * MiB;
constexpr size_t WS_MODP = 1 * MiB;
constexpr size_t WS_MODV = 2 * MiB;
constexpr size_t WS_QLSS = 2 * MiB + 64 * 1024;
constexpr size_t WS_WIDX = WS_QLSS + 256 * 1024;
constexpr size_t WS_QN   = WS_WIDX + 256 * 1024;
constexpr size_t WS_HDEC = 3 * MiB;
constexpr size_t WS_WIN = 4 * MiB, WS_WQ = 15 * MiB, WS_WPA = 16 * MiB, WS_WPB = 17 * MiB, WS_WOUT = 18 * MiB;
constexpr size_t WS_H = 20 * MiB;
constexpr size_t WS_MASK = 20 * MiB, WS_OB = 36 * MiB;
constexpr size_t WS_QLAT = 52 * MiB, WS_AK = 60 * MiB, WS_AV = 76 * MiB, WS_KI = 92 * MiB, WS_QI = 94 * MiB, WS_AQ = 102 * MiB;
constexpr size_t WS_BQ = 118 * MiB, WS_BF = 134 * MiB, WS_BI = 150 * MiB, WS_BG = 166 * MiB;
constexpr size_t WS_KV = 182 * MiB, WS_SP = 214 * MiB;
constexpr size_t WS_T = 182 * MiB;
constexpr size_t WS_W1 = 60 * MiB, WS_W2 = 68 * MiB;
constexpr size_t WS_HID = 76 * MiB;
constexpr size_t WS_END = 256 * MiB;
static_assert(WS_SP + 32 * MiB <= WS_END && WS_HID + 128 * MiB <= WS_END, "d_ws map");
constexpr int CW_BAR = 4096;
constexpr int RING_BYTES = 131072, LDSCTL_OFF = RING_BYTES, MISC_OFF = LDSCTL_OFF + 320, PAR_OFF = LDSCTL_OFF + 1024;
constexpr int LDS_BYTES = 147456;

#define GAS __attribute__((address_space(1)))
#define LAS __attribute__((address_space(3)))
typedef unsigned short bf16;
typedef unsigned v4u __attribute__((ext_vector_type(4)));
typedef float f32x4 __attribute__((ext_vector_type(4)));
typedef float f32x16 __attribute__((ext_vector_type(16)));
typedef short bf16x8 __attribute__((ext_vector_type(8)));
typedef GAS unsigned gu32;
#define RLX_AGENT __ATOMIC_RELAXED, __HIP_MEMORY_SCOPE_AGENT
#define LDS_WAIT() asm volatile("s_waitcnt lgkmcnt(0)" ::: "memory")
__device__ __forceinline__ unsigned f2bf(float f) { unsigned u = __builtin_bit_cast(unsigned, f); return (u + 0x7fffu + ((u >> 16) & 1u)) >> 16; }
__device__ __forceinline__ unsigned pk2(float lo, float hi) { return f2bf(lo) | (f2bf(hi) << 16); }
__device__ __forceinline__ float bf2f(bf16 b) { return __builtin_bit_cast(float, (unsigned)b << 16); }
__device__ __forceinline__ float sigmf(float x) { return 1.0f / (1.0f + __expf(-x)); }
#define XB_TMO      128
#define XB_XCNT(j)  (256  + 64 * (j))
#define XB_XSUB(j)  (1280 + 64 * (j))
#define XB_XGEN(j)  (2304 + 64 * (j))
#define XB_TOP      3328
#define XB_TOPGEN   3392
#define XCD_BAR_WORDS 3456
#define XB_SPIN_CAP (1u << 18)

__device__ __forceinline__ unsigned xb_ld(unsigned* p)              { return __hip_atomic_load(p, __ATOMIC_RELAXED, __HIP_MEMORY_SCOPE_AGENT); }
__device__ __forceinline__ unsigned xb_add(unsigned* p, unsigned v) { return __hip_atomic_fetch_add(p, v, __ATOMIC_RELAXED, __HIP_MEMORY_SCOPE_AGENT); }
__device__ __forceinline__ unsigned xb_xcc_id() { return (unsigned)__builtin_amdgcn_s_getreg((3 << 11) | 20) & 0xFu; }
#define XB_SPIN(cond, bar) do { unsigned _sp = 0; while (cond) { __builtin_amdgcn_s_sleep(1); \
    if ((++_sp & 255u) == 0u) { if (xb_ld(&(bar)[XB_TMO])) break; if (_sp > XB_SPIN_CAP) { atomicAdd(&(bar)[XB_TMO], 1u); break; } } } } while (0)

struct XcdBarrier {
    unsigned* bar; unsigned x;
    volatile LAS unsigned* st;
};

__device__ __forceinline__ XcdBarrier xcd_barrier_post(unsigned* bar, volatile LAS unsigned* st) {
    XcdBarrier b; b.bar = bar; b.x = xb_xcc_id(); b.st = st;
    if (threadIdx.x == 0) (void)xb_add(&bar[XB_XCNT(b.x)], 1u);
    return b;
}
__device__ __forceinline__ void xcd_barrier_complete(unsigned* bar, unsigned x, unsigned& nloc, unsigned& nx) {
    const unsigned G = gridDim.x * gridDim.y * gridDim.z;
    unsigned sum, cnt, mine, sp = 0u;
    for (;;) {
        sum = 0u; cnt = 0u; mine = 0u;
#pragma unroll
        for (unsigned j = 0; j < 16; ++j) { const unsigned c = xb_ld(&bar[XB_XCNT(j)]); sum += c; cnt += (c > 0u) ? 1u : 0u; mine = (j == x) ? c : mine; }
        if (sum == G) break;
        __builtin_amdgcn_s_sleep(1);
        if ((++sp & 255u) == 0u) { if (xb_ld(&bar[XB_TMO])) break; if (sp > XB_SPIN_CAP) { atomicAdd(&bar[XB_TMO], 1u); break; } }
    }
    nloc = mine > 0u ? mine : 1u; nx = cnt > 0u ? cnt : 1u;
}

__device__ __forceinline__ void xcd_barrier(const XcdBarrier& b) {
    asm volatile("s_waitcnt vmcnt(0)" ::: "memory");
    __syncthreads();
    if (threadIdx.x == 0) {
        unsigned* bar = b.bar;
        __builtin_amdgcn_s_waitcnt(0);
        unsigned nloc = b.st[0], nx = b.st[1];
        if (nloc == 0u) { xcd_barrier_complete(bar, b.x, nloc, nx); b.st[0] = nloc; b.st[1] = nx; }
        const unsigned old = xb_add(&bar[XB_XSUB(b.x)], 1u);
        const unsigned gen = old / nloc;
        if (old + 1u == (gen + 1u) * nloc) {
            __builtin_amdgcn_fence(__ATOMIC_RELEASE, "agent");
            asm volatile("s_waitcnt vmcnt(0)" ::: "memory");
            const unsigned og = xb_add(&bar[XB_TOP], 1u);
            const unsigned tg = og / nx;
            if (og + 1u == (tg + 1u) * nx) xb_add(&bar[XB_TOPGEN], 1u);
            else XB_SPIN(xb_ld(&bar[XB_TOPGEN]) == tg, bar);
            __builtin_amdgcn_fence(__ATOMIC_ACQUIRE, "agent");
            xb_add(&bar[XB_XGEN(b.x)], 1u);
            asm volatile("s_waitcnt vmcnt(0)" ::: "memory");
        } else {
            XB_SPIN(xb_ld(&bar[XB_XGEN(b.x)]) == gen, bar);
            __builtin_amdgcn_fence(__ATOMIC_ACQUIRE, "agent");
            asm volatile("s_waitcnt vmcnt(0)" ::: "memory");
        }
    }
    __syncthreads();
}

struct Frame {
    LAS unsigned char* lds; volatile LAS unsigned* MISC; gu32* ctl;
    int tid, lane, wave, vcu, G;
    const float* in[22]; float* out; unsigned char* ws;
};
enum { I_X = 0, I_C, I_WADA, I_BADA, I_N1G, I_WIN, I_QLG, I_WUQ, I_WUQI, I_QNG, I_KNG, I_KIG, I_LB, I_HOG, I_WPA, I_WPB, I_WOUT, I_N2G, I_W1, I_B1, I_W2, I_B2 };
__device__ __forceinline__ float wave_sum(float v) {
#pragma unroll
    for (int o = 1; o < 64; o <<= 1) v += __shfl_xor(v, o);
    return v;
}
__device__ __forceinline__ int prow(int n) { const int cl = n & 255; return (n & ~255) + 128 * ((cl >> 5) & 1) + 32 * (cl >> 6) + (cl & 31); }
__device__ __forceinline__ void tr_item(const float* W, int ldn, int sc0, int nvalid, int k0, const float* gsc, bf16* WT, int K, int drow0, LAS float* scr, int lane) {
#pragma unroll 8
    for (int i = 0; i < 32; ++i) { const int kk = 2 * i + (lane >> 5), col = lane & 31; float v = (col < nvalid) ? W[(size_t)(k0 + kk) * ldn + sc0 + col] : 0.f; if (gsc) v *= gsc[k0 + kk]; scr[kk * 33 + col] = v; }
    LDS_WAIT(); asm volatile("" ::: "memory");
    const int c = lane & 7;
#pragma unroll
    for (int j = 0; j < 4; ++j) { const int n = (lane >> 3) + 8 * j; const LAS float* s = scr + (8 * c) * 33 + n;
        v4u o; o.x = pk2(s[0 * 33], s[1 * 33]); o.y = pk2(s[2 * 33], s[3 * 33]); o.z = pk2(s[4 * 33], s[5 * 33]); o.w = pk2(s[6 * 33], s[7 * 33]);
        *(GAS v4u*)(WT + (size_t)(drow0 + n) * K + k0 + 8 * c) = o; }
    LDS_WAIT(); asm volatile("" ::: "memory");
}
__device__ __forceinline__ void tr_plain(const float* W, int K, int N, bf16* WT, int r, LAS float* scr, int lane) {
    const int nblk = N / 32, kb = r / nblk, nb = r % nblk; tr_item(W, N, 32 * nb, 32, 64 * kb, nullptr, WT, K, prow(32 * nb), scr, lane);
}
__device__ __forceinline__ void p0_prologue(Frame& F) {
    LAS float* scr = (LAS float*)(F.lds + F.wave * 16384);
    const int gw = F.vcu * NWAVES + F.wave, NGW = F.G * NWAVES, lane = F.lane;
    constexpr int I_IN = 16 * (NPROJ / 32), I_Q = 4 * 24, I_PA = 8 * 32, I_PB = 8 * 32, I_OUT = 16 * 32, I_GV = 96 * 16;
    constexpr int NITEMS = I_IN + I_Q + I_PA + I_PB + I_OUT + I_GV;
    bf16* WIN = (bf16*)(F.ws + WS_WIN); bf16* WQ = (bf16*)(F.ws + WS_WQ);
    for (int it = gw; it < NITEMS; it += NGW) {
        int r = it;
        if (r < I_IN) { const int nblk = NPROJ / 32, kb = r / nblk, nb = r % nblk, n0 = 32 * nb; int sc0, nv;
            if (n0 < 1280) { sc0 = n0; nv = 32; } else if (n0 < 1536) { sc0 = n0; nv = 1348 - n0; nv = nv < 0 ? 0 : (nv > 32 ? 32 : nv); if (nv == 0) sc0 = 0; } else { sc0 = n0 - 188; nv = 32; }
            tr_item(F.in[I_WIN], DIN, sc0, nv, 64 * kb, nullptr, WIN, 1024, prow(n0), scr, lane); continue; } r -= I_IN;
        if (r < I_Q) { const int kb = r / 24, nb = r % 24, n0 = 32 * nb;
            if (n0 < 512) tr_item(F.in[I_WUQ], 512, n0, 32, 64 * kb, F.in[I_QLG], WQ, 256, prow(n0), scr, lane);
            else tr_item(F.in[I_WUQI], 256, n0 - 512, 32, 64 * kb, F.in[I_QLG], WQ, 256, prow(n0), scr, lane);
            continue; } r -= I_Q;
        if (r < I_PA) { tr_plain(F.in[I_WPA], 512, 1024, (bf16*)(F.ws + WS_WPA), r, scr, lane); continue; } r -= I_PA;
        if (r < I_PB) { tr_plain(F.in[I_WPB], 512, 1024, (bf16*)(F.ws + WS_WPB), r, scr, lane); continue; } r -= I_PB;
        if (r < I_OUT) { tr_plain(F.in[I_WOUT], 1024, 1024, (bf16*)(F.ws + WS_WOUT), r, scr, lane); continue; } r -= I_OUT;
        {
            const int ng = r % 96, ks = r / 96, n = ng * 64 + lane; const float* c = F.in[I_C]; const float* w = F.in[I_WADA] + (size_t)(ks * 64) * 6144 + n;
            float a0 = 0.f, a1 = 0.f;
#pragma unroll 16
            for (int k = 0; k < 64; ++k) { const float wv = w[(size_t)k * 6144]; const float c0 = c[ks * 64 + k], c1 = c[1024 + ks * 64 + k];
                a0 += (c0 * sigmf(c0)) * wv; a1 += (c1 * sigmf(c1)) * wv; }
            float* mp = (float*)(F.ws + WS_MODP); mp[(size_t)(ks * 2 + 0) * 6144 + n] = a0; mp[(size_t)(ks * 2 + 1) * 6144 + n] = a1;
        }
    }
}
__device__ __forceinline__ float mod_val(Frame& F, int b, int j) {
    const float* mp = (const float*)(F.ws + WS_MODP); float s = F.in[I_BADA][j];
#pragma unroll
    for (int ks = 0; ks < 16; ++ks) s += mp[(size_t)(ks * 2 + b) * 6144 + j];
    return s;
}
template <int WHICH> __device__ __forceinline__ void norm_rows(Frame& F, const float* X, bf16* H) {
    LAS float* tab = (LAS float*)F.lds;
    const float* g = F.in[WHICH == 0 ? I_N1G : I_N2G]; const int shift_off = WHICH == 0 ? 0 : 3072, scale_off = WHICH == 0 ? 1024 : 4096;
    for (int i = F.tid; i < 2048; i += NWAVES * 64) { const int b = i >> 10, k = i & 1023; float sc, sh;
        if (WHICH == 0) { sc = mod_val(F, b, scale_off + k); sh = mod_val(F, b, shift_off + k); }
        else { const float* mv = (const float*)(F.ws + WS_MODV); sc = mv[b * 6144 + scale_off + k]; sh = mv[b * 6144 + shift_off + k]; }
        tab[i] = g[k] * (1.0f + sc); tab[2048 + i] = sh; }
    if (WHICH == 0) { float* mv = (float*)(F.ws + WS_MODV); for (int i = F.tid; i < 48; i += NWAVES * 64) { const int j = F.vcu * 48 + i; if (j < 12288) mv[j] = mod_val(F, j / 6144, j % 6144); } }
    __syncthreads();
    const int gw = F.vcu * NWAVES + F.wave, NGW = F.G * NWAVES;
    for (int m = gw; m < M; m += NGW) {
        const GAS f32x4* xr = (const GAS f32x4*)(X + (size_t)m * DMOD) + F.lane; const int b = m >> 13;
        f32x4 v[4]; float s = 0.f;
#pragma unroll
        for (int j = 0; j < 4; ++j) { v[j] = xr[64 * j]; s += (v[j].x * v[j].x + v[j].y * v[j].y) + (v[j].z * v[j].z + v[j].w * v[j].w); }
        const float r = 1.0f / sqrtf(wave_sum(s) * (1.0f / DMOD) + 1e-6f);
        GAS unsigned long long* o8 = (GAS unsigned long long*)(H + (size_t)m * DMOD) + F.lane;
#pragma unroll
        for (int j = 0; j < 4; ++j) { const int k = 4 * F.lane + 256 * j; const LAS float* a = tab + b * 1024 + k; const LAS float* sh = tab + 2048 + b * 1024 + k;
            o8[64 * j] = (unsigned long long)pk2(v[j].x * r * a[0] + sh[0], v[j].y * r * a[1] + sh[1]) | ((unsigned long long)pk2(v[j].z * r * a[2] + sh[2], v[j].w * r * a[3] + sh[3]) << 32); }
    }
    __syncthreads();
}
__device__ __forceinline__ int crow(int r, int hi) { return (r & 3) + 8 * (r >> 2) + 4 * hi; }
constexpr float QKMAXF = 4194303.0f;
struct TkLane { float lo[4], hi[4], sc, off; int qq; };
template <int MODE>
__device__ __forceinline__ void topk_pass(Frame& F, const bf16* KI, const bf16x8 (&qf)[4][4], const TkLane& L, int rowbase, int q0, int gi, unsigned* MW, int b) {
    const int lane = F.lane, r32 = lane & 31, hi = lane >> 5, wid = F.wave;
    LAS unsigned* hist = (LAS unsigned*)F.lds;
    LAS int* par = (LAS int*)(F.lds + PAR_OFF);
    const int ntile = (gi >> 1) + 1, qmax = q0 + 31;
    int tb = 0, tq = 0, cut = 0;
    if (MODE == 1) tb = par[r32];
    if (MODE == 2) { tq = par[96 + r32]; cut = par[128 + r32]; }
    for (int tile = wid; tile < ntile; tile += NWAVES) {
        unsigned W = 0;
#pragma unroll 1
        for (int sub = 0; sub < 2; ++sub) {
            const int key0 = tile * 64 + sub * 32;
            if (key0 > qmax) { W <<= 16; continue; }
            const bf16* kp = KI + (size_t)(rowbase + key0 + r32) * 64 + hi * 8;
            bf16x8 kf[4];
#pragma unroll
            for (int ks = 0; ks < 4; ++ks) kf[ks] = *(const bf16x8*)(kp + ks * 16);
            f32x16 acc[4];
#pragma unroll
            for (int h = 0; h < 4; ++h) { acc[h] = f32x16{};
#pragma unroll
                for (int ks = 0; ks < 4; ++ks) acc[h] = __builtin_amdgcn_mfma_f32_32x32x16_bf16(kf[ks], qf[h][ks], acc[h], 0, 0, 0); }
#pragma unroll
            for (int r = 0; r < 16; ++r) {
                const int key = key0 + crow(r, hi);
                const float s = ((__builtin_amdgcn_fmed3f(acc[0][r], L.lo[0], L.hi[0]) + __builtin_amdgcn_fmed3f(acc[1][r], L.lo[1], L.hi[1])) + __builtin_amdgcn_fmed3f(acc[2][r], L.lo[2], L.hi[2])) + __builtin_amdgcn_fmed3f(acc[3][r], L.lo[3], L.hi[3]);
                const float uq = __builtin_amdgcn_fmed3f(__builtin_fmaf(s, L.sc, L.off), 0.0f, QKMAXF);
                const int qk = (int)uq; const bool valid = key <= L.qq;
                if (MODE == 0) { if (valid) { const int bin = qk >> 11; __hip_atomic_fetch_add(hist + r32 * 1024 + (bin >> 1), (bin & 1) ? 0x10000u : 1u, __ATOMIC_RELAXED, __HIP_MEMORY_SCOPE_WORKGROUP); } }
                else if (MODE == 1) { if (valid && (qk >> 11) == tb) { const unsigned slot = __hip_atomic_fetch_add((LAS unsigned*)par + 64 + r32, 1u, __ATOMIC_RELAXED, __HIP_MEMORY_SCOPE_WORKGROUP);
                        if (slot < 1024u) hist[r32 * 1024 + slot] = ((unsigned)(qk & 2047) << 13) | (unsigned)(8191 - key); } }
                else { const bool sel = valid && (qk > tq || (qk == tq && key <= cut)); W = (W << 1) | (sel ? 1u : 0u); }
            }
        }
        if (MODE == 2) MW[((size_t)(b * 256 + gi) * 128 + tile) * 64 + lane] = W;
    }
    if (MODE == 2) { const int tend = 4 * (gi >> 3) + 4; for (int tile = ntile + wid; tile < tend; tile += NWAVES) MW[((size_t)(b * 256 + gi) * 128 + tile) * 64 + lane] = 0u; }
}
__device__ __forceinline__ void topk_unit(Frame& F, int b, int gi, float kmax) {
    const int lane = F.lane, r32 = lane & 31, hi = lane >> 5, wid = F.wave, tid = F.tid;
    const int rowbase = b * SEQL, q0 = gi * 32;
    const bf16* KI = (const bf16*)(F.ws + WS_KI); const bf16* QI = (const bf16*)(F.ws + WS_QI); unsigned* MW = (unsigned*)(F.ws + WS_MASK);
    const float* WIDX = (const float*)(F.ws + WS_WIDX); const float* QN = (const float*)(F.ws + WS_QN);
    LAS unsigned* hist = (LAS unsigned*)F.lds; LAS int* par = (LAS int*)(F.lds + PAR_OFF);
    TkLane L; L.qq = q0 + r32; const int row = rowbase + L.qq;
    bf16x8 qf[4][4];
#pragma unroll
    for (int h = 0; h < 4; ++h) { _Pragma("unroll") for (int ks = 0; ks < 4; ++ks) qf[h][ks] = *(const bf16x8*)(QI + (size_t)row * 256 + h * 64 + ks * 16 + hi * 8); }
    { const f32x4 w4 = *(const f32x4*)(WIDX + row * 4), n4 = *(const f32x4*)(QN + row * 4); float hs = 0.f, ls = 0.f;
#pragma unroll
      for (int h = 0; h < 4; ++h) { const bool pos = w4[h] > 0.f; L.lo[h] = pos ? 0.f : -INFINITY; L.hi[h] = pos ? INFINITY : 0.f; const float bd = n4[h] * kmax; if (pos) hs += bd; else ls += bd; }
      float range = hs + ls; if (!(range > 1e-30f)) range = 1.0f; L.sc = QKMAXF / range; L.off = ls * L.sc; }
    { LAS v4u* hz = (LAS v4u*)hist; for (int i = tid; i < 8192; i += NWAVES * 64) hz[i] = (v4u){0u, 0u, 0u, 0u}; if (tid < 160) par[tid] = 0; }
    __syncthreads();
    topk_pass<0>(F, KI, qf, L, rowbase, q0, gi, MW, b);
    __syncthreads();
    for (int qi = 0; qi < 4; ++qi) { const int q = wid * 4 + qi; const LAS v4u* hq = (const LAS v4u*)(hist + q * 1024 + lane * 16);
        unsigned w[16];
#pragma unroll
        for (int i = 0; i < 4; ++i) { const v4u t = hq[i]; w[4 * i] = t.x; w[4 * i + 1] = t.y; w[4 * i + 2] = t.z; w[4 * i + 3] = t.w; }
        unsigned tot = 0;
#pragma unroll
        for (int i = 0; i < 16; ++i) tot += (w[i] & 0xffffu) + (w[i] >> 16);
        unsigned incl = tot;
#pragma unroll
        for (int o = 1; o < 64; o <<= 1) { const unsigned t = __shfl_down(incl, o); if (lane + o < 64) incl += t; }
        unsigned running = incl - tot;
        if (q0 + q + 1 <= 256) { if (lane == 0) { par[q] = -1; par[32 + q] = 0; } }
        else {
#pragma unroll
            for (int i = 31; i >= 0; --i) { const unsigned c = (i & 1) ? (w[i >> 1] >> 16) : (w[i >> 1] & 0xffffu);
                if (running < 256u && running + c >= 256u) { par[q] = lane * 32 + i; par[32 + q] = (int)running; } running += c; }
        }
    }
    __syncthreads();
    topk_pass<1>(F, KI, qf, L, rowbase, q0, gi, MW, b);
    __syncthreads();
    for (int qi = 0; qi < 4; ++qi) { const int q = wid * 4 + qi; const int tbq = par[q];
        if (tbq < 0) { if (lane == 0) { par[96 + q] = -1; par[128 + q] = 0; } continue; }
        int n = par[64 + q]; n = n > 1024 ? 1024 : n; const int rr = 256 - par[32 + q];
        unsigned T = 0;
        for (int bit = 23; bit >= 0; --bit) { const unsigned cand = T | (1u << bit); int c = 0;
            for (int base = 0; base < n; base += 64) { const int j = base + lane; const bool ge = (j < n) && (hist[q * 1024 + j] >= cand); c += __builtin_popcountll(__ballot(ge)); }
            if (c >= rr) T = cand; }
        if (lane == 0) { par[96 + q] = (tbq << 11) | (int)(T >> 13); par[128 + q] = 8191 - (int)(T & 8191u); }
    }
    __syncthreads();
    topk_pass<2>(F, KI, qf, L, rowbase, q0, gi, MW, b);
    __syncthreads();
}
constexpr int HG_TOT = 0;
constexpr int HG_SSP = 2048;
constexpr int HG_VT = 4096;
constexpr int HG_KHT = HG_VT + 128 * 144;
constexpr int HG_QT = HG_KHT + 128 * 144;
constexpr int HG_KT = HG_QT + 64 * 272;
constexpr int HG_QH = HG_KT + 64 * 272;
constexpr int HG_ST = HG_QH + 64 * 272;
static_assert(HG_ST + 128 * 272 <= RING_BYTES, "hgrn lds");
typedef LAS unsigned short lbf;
__device__ __forceinline__ void hg_decay(Frame& F, int rowc, int h, float (&bl)[16], float (&kk)[16], float& bend, float& bmid) {
    const int d = F.tid & 127, tq = F.tid >> 7; const bf16* BFp = (const bf16*)(F.ws + WS_BF);
    const float* lbp = F.in[I_LB]; const float lb = sigmf(lbp[h * 128 + d] - lbp[512 + h * 128 + d]);
    float cum = 0.f;
#pragma unroll
    for (int i = 0; i < 16; ++i) { const float x = bf2f(BFp[(size_t)(rowc + tq * 16 + i) * 512 + h * 128 + d]); const float sg = sigmf(x); const float f = lb + (1.0f - lb) * sg;
        kk[i] = (1.0f - lb) * (1.0f - sg); cum += __logf(f); bl[i] = cum; }
    LAS float* tot = (LAS float*)(F.lds + HG_TOT); tot[tq * 128 + d] = cum;
    __syncthreads();
    const float t0 = tot[d], t1 = tot[128 + d], t2 = tot[256 + d], t3 = tot[384 + d];
    const float pre = (tq > 0 ? t0 : 0.f) + (tq > 1 ? t1 : 0.f) + (tq > 2 ? t2 : 0.f);
#pragma unroll
    for (int i = 0; i < 16; ++i) bl[i] += pre;
    bmid = t0 + t1; bend = (t0 + t1) + (t2 + t3);
}
__device__ __forceinline__ void hg_vt(Frame& F, int rowc, int h) {
    const int v = F.tid & 127, tq = F.tid >> 7; const bf16* BIp = (const bf16*)(F.ws + WS_BI); lbf* VT = (lbf*)(F.lds + HG_VT);
#pragma unroll
    for (int i = 0; i < 16; ++i) VT[v * 72 + tq * 16 + i] = BIp[(size_t)(rowc + tq * 16 + i) * 512 + h * 128 + v];
}
#define HG_FRAG(base, row, stride, k) (*(const LAS bf16x8*)((base) + ((row) * (stride) + (k)) * 2))
__device__ __forceinline__ void hg_state_item(Frame& F, int item) {
    const int bh = item >> 7, c = item & 127, b = bh >> 2, h = bh & 3, rowc = b * SEQL + c * 64;
    const int lane = F.lane, r32 = lane & 31, hi = lane >> 5, d = F.tid & 127, tq = F.tid >> 7;
    float bl[16], kk[16], bend, bmid; hg_decay(F, rowc, h, bl, kk, bend, bmid);
    lbf* KHT = (lbf*)(F.lds + HG_KHT);
#pragma unroll
    for (int i = 0; i < 16; ++i) KHT[d * 72 + tq * 16 + i] = (unsigned short)f2bf(kk[i] * __expf(bend - bl[i]));
    hg_vt(F, rowc, h);
    if (tq == 0) ((float*)(F.ws + WS_HDEC))[item * 128 + d] = __expf(bend);
    __syncthreads();
    const LAS unsigned char* VTb = F.lds + HG_VT; const LAS unsigned char* KHb = F.lds + HG_KHT; bf16* KV = (bf16*)(F.ws + WS_KV) + (size_t)item * 16384;
    const int vi = F.wave >> 1;
#pragma unroll
    for (int jj = 0; jj < 2; ++jj) { const int dj = (F.wave & 1) * 2 + jj; f32x16 acc = f32x16{};
#pragma unroll
        for (int ks = 0; ks < 4; ++ks) acc = __builtin_amdgcn_mfma_f32_32x32x16_bf16(HG_FRAG(VTb, 32 * vi + r32, 72, 16 * ks + 8 * hi), HG_FRAG(KHb, 32 * dj + r32, 72, 16 * ks + 8 * hi), acc, 0, 0, 0);
#pragma unroll
        for (int r = 0; r < 16; ++r) KV[(size_t)(32 * vi + crow(r, hi)) * 128 + 32 * dj + r32] = (bf16)f2bf(acc[r]); }
    __syncthreads();
}
__device__ __forceinline__ void hg_scan(Frame& F) {
    const bf16* KV = (const bf16*)(F.ws + WS_KV); bf16* SP = (bf16*)(F.ws + WS_SP); const float* HD = (const float*)(F.ws + WS_HDEC);
    for (int e = F.vcu * (NWAVES * 64) + F.tid; e < 8 * 16384; e += F.G * NWAVES * 64) { const int bh = e >> 14, vd = e & 16383, d = vd & 127; float S = 0.f;
        for (int c0 = 0; c0 < 128; c0 += 8) { float kv[8], dc[8];
#pragma unroll
            for (int j = 0; j < 8; ++j) { const int item = bh * 128 + c0 + j; kv[j] = bf2f(KV[(size_t)item * 16384 + vd]); dc[j] = HD[item * 128 + d]; }
#pragma unroll
            for (int j = 0; j < 8; ++j) { const int item = bh * 128 + c0 + j; SP[(size_t)item * 16384 + vd] = (bf16)f2bf(S); S = dc[j] * S + kv[j]; } }
    }
}
__device__ __forceinline__ void hg_out_item(Frame& F, int item) {
    const int bh = item >> 7, c = item & 127, b = bh >> 2, h = bh & 3, rowc = b * SEQL + c * 64;
    const int lane = F.lane, r32 = lane & 31, hi = lane >> 5, d = F.tid & 127, tq = F.tid >> 7, wid = F.wave;
    float bl[16], kk[16], bend, bmid; hg_decay(F, rowc, h, bl, kk, bend, bmid);
    { const bf16* BQp = (const bf16*)(F.ws + WS_BQ); lbf* QT = (lbf*)(F.lds + HG_QT); lbf* KT = (lbf*)(F.lds + HG_KT); lbf* QH = (lbf*)(F.lds + HG_QH);
#pragma unroll
      for (int i = 0; i < 16; ++i) { const int t = tq * 16 + i; const float q = bf2f(BQp[(size_t)(rowc + t) * 512 + h * 128 + d]); const float e = bl[i] - bmid;
          QT[t * 136 + d] = (unsigned short)f2bf(q * __expf(fminf(e, 80.f))); KT[t * 136 + d] = (unsigned short)f2bf(kk[i] * __expf(fminf(-e, 80.f))); QH[t * 136 + d] = (unsigned short)f2bf(q * __expf(bl[i])); } }
    hg_vt(F, rowc, h);
    { const bf16* SP = (const bf16*)(F.ws + WS_SP) + (size_t)item * 16384; LAS unsigned char* ST = F.lds + HG_ST;
#pragma unroll
      for (int i = 0; i < 4; ++i) { const int chunk = F.tid + 512 * i, row = chunk >> 4, c16 = chunk & 15; *(LAS v4u*)(ST + row * 272 + c16 * 16) = *(const v4u*)(SP + row * 128 + c16 * 8); } }
    __syncthreads();
    const LAS unsigned char* QTb = F.lds + HG_QT; const LAS unsigned char* KTb = F.lds + HG_KT; const LAS unsigned char* QHb = F.lds + HG_QH;
    const LAS unsigned char* VTb = F.lds + HG_VT; const LAS unsigned char* STb = F.lds + HG_ST; LAS unsigned char* AMb = F.lds + HG_KHT;
    if (wid < 3) { const int ti = wid > 0 ? 1 : 0, sj = wid > 1 ? 1 : 0; f32x16 acc = f32x16{};
#pragma unroll
        for (int ks = 0; ks < 8; ++ks) acc = __builtin_amdgcn_mfma_f32_32x32x16_bf16(HG_FRAG(QTb, 32 * ti + r32, 136, 16 * ks + 8 * hi), HG_FRAG(KTb, 32 * sj + r32, 136, 16 * ks + 8 * hi), acc, 0, 0, 0);
        lbf* AM = (lbf*)AMb;
#pragma unroll
        for (int r = 0; r < 16; ++r) { const int t = 32 * ti + crow(r, hi), s = 32 * sj + r32; AM[t * 72 + s] = (unsigned short)f2bf(s <= t ? acc[r] : 0.f); } }
    __syncthreads();
    const int ti = wid >> 2, vj = wid & 3; f32x16 o = f32x16{};
#pragma unroll
    for (int ks = 0; ks < 4; ++ks) if (ks < 2 * (ti + 1)) o = __builtin_amdgcn_mfma_f32_32x32x16_bf16(HG_FRAG(AMb, 32 * ti + r32, 72, 16 * ks + 8 * hi), HG_FRAG(VTb, 32 * vj + r32, 72, 16 * ks + 8 * hi), o, 0, 0, 0);
#pragma unroll
    for (int ks = 0; ks < 8; ++ks) o = __builtin_amdgcn_mfma_f32_32x32x16_bf16(HG_FRAG(QHb, 32 * ti + r32, 136, 16 * ks + 8 * hi), HG_FRAG(STb, 32 * vj + r32, 136, 16 * ks + 8 * hi), o, 0, 0, 0);
    LAS float* SSP = (LAS float*)(F.lds + HG_SSP);
#pragma unroll
    for (int r = 0; r < 16; ++r) { float s = o[r] * o[r];
#pragma unroll
        for (int x = 1; x < 32; x <<= 1) s += __shfl_xor(s, x);
        if (r32 == 0) SSP[(32 * ti + crow(r, hi)) * 4 + vj] = s; }
    __syncthreads();
    { const float* go = F.in[I_HOG]; const float g = go[h * 128 + 32 * vj + r32]; const bf16* BGp = (const bf16*)(F.ws + WS_BG); bf16* OB = (bf16*)(F.ws + WS_OB);
#pragma unroll
      for (int r = 0; r < 16; ++r) { const int t = 32 * ti + crow(r, hi); const LAS float* sp = SSP + t * 4; const float rs = 1.0f / sqrtf(((sp[0] + sp[1]) + (sp[2] + sp[3])) * (1.0f / 128.0f) + 1e-6f);
          const size_t off = (size_t)(rowc + t) * 512 + h * 128 + 32 * vj + r32; OB[off] = (bf16)f2bf(o[r] * rs * g * bf2f(BGp[off])); } }
    __syncthreads();
}
struct Args { const float* in[22]; float* out; unsigned char* ws; int ph_lo, ph_hi, li, pad; };
__device__ __forceinline__ float absmax64(const float* g, int lane) { float v = fabsf(g[lane]);
#pragma unroll
    for (int o = 1; o < 64; o <<= 1) v = fmaxf(v, __shfl_xor(v, o));
    return v; }
__global__ void __launch_bounds__(NWAVES * 64, 2) mk_fwd(Args args) {
    extern __shared__ __attribute__((aligned(16))) unsigned char lds[];
    Frame F;
    F.lds = (LAS unsigned char*)lds; F.MISC = (volatile LAS unsigned*)(F.lds + MISC_OFF);
    F.tid = threadIdx.x; F.lane = F.tid & 63; F.wave = __builtin_amdgcn_readfirstlane(F.tid >> 6);
    F.G = gridDim.x; { const int bx = blockIdx.x; F.vcu = (F.G % 8 == 0) ? (bx % 8) * (F.G / 8) + bx / 8 : bx; }
    unsigned char* ws = args.ws; F.ws = ws; F.ctl = (gu32*)(ws + WS_CTL); F.out = args.out;
#pragma unroll
    for (int i = 0; i < 22; ++i) F.in[i] = args.in[i];
    for (int u = F.tid; u < (LDS_BYTES - LDSCTL_OFF) / 4; u += NWAVES * 64) ((LAS unsigned*)(F.lds + LDSCTL_OFF))[u] = 0u;
    __syncthreads();
    XcdBarrier bar; bar.bar = (unsigned*)(F.ctl + CW_BAR); bar.x = 0; bar.st = nullptr;
    if (N_LAUNCHES == 1) bar = xcd_barrier_post((unsigned*)(F.ctl + CW_BAR), F.MISC + 8);
    const int lo = args.ph_lo, hi = args.ph_hi;
#ifndef PHSEL
#define PHSEL 0x1fff
#endif
#define IN(k) (((PHSEL >> (k)) & 1) && lo <= (k) && (k) < hi)
#define SEAM(k) do { if (IN(k) && IN((k) + 1)) xcd_barrier(bar); } while (0)
    bf16* Hb = (bf16*)(ws + WS_H);
    if (IN(0)) { p0_prologue(F); SEAM(0); }
    if (IN(1)) { norm_rows<0>(F, F.in[I_X], Hb); SEAM(1); }
    if (IN(2)) {
        pg8::Gemm g{Hb, (const bf16*)(ws + WS_WIN), M, NPROJ, DMOD}; pg8::StaticOrder S; S.init(M, NPROJ, F.G, (int)blockIdx.x);
        pg8::EpiProj E{(bf16*)(ws + WS_QLAT), (bf16*)(ws + WS_AK), (bf16*)(ws + WS_AV), (bf16*)(ws + WS_KI), (bf16*)(ws + WS_BQ),
                       (bf16*)F.out, (float*)(ws + WS_QLSS), (float*)(ws + WS_WIDX), F.in[I_KNG], F.in[I_KIG]};
        pg8::gemm_phase<pg8::EpiProj, pg8::StaticOrder, true, true>(F.lds, g, S, E);
        SEAM(2);
    }
    if (IN(3)) {
        int Kq = 256; asm volatile("" : "+s"(Kq));
        pg8::Gemm g{(const bf16*)(ws + WS_QLAT), (const bf16*)(ws + WS_WQ), M, 768, Kq}; pg8::StaticOrder S; S.init(M, 768, F.G, (int)blockIdx.x);
        pg8::EpiQ E{(bf16*)(ws + WS_AQ), (bf16*)(ws + WS_QI), (float*)(ws + WS_QN), (const float*)(ws + WS_QLSS), (const float*)(ws + WS_WIDX), F.in[I_QNG]};
        pg8::gemm_phase<pg8::EpiQ, pg8::StaticOrder, true, true>(F.lds, g, S, E);
        SEAM(3);
    }
    if (IN(4)) {
        const float kmax = 8.0f * absmax64(F.in[I_KIG], F.lane) * 1.02f;
        { const int b = F.vcu >> 7, p = F.vcu & 127; if (F.vcu < 256) { topk_unit(F, b, p, kmax); topk_unit(F, b, 255 - p, kmax); } }
        for (int it = F.vcu; it < 1024; it += F.G) hg_state_item(F, it);
        SEAM(4);
    }
    if (IN(5)) {
        if (F.vcu < 256) { const int bh = F.vcu >> 4, s = F.vcu & 15;
            for (int i = 0; i < 2; ++i) attn_body::attn_unit(bh >> 3, bh & 7, i == 0 ? s : 31 - s, (const attn_body::bf16*)(ws + WS_AQ), (const attn_body::bf16*)(ws + WS_AK), (const attn_body::bf16*)(ws + WS_AV),
                                                             (attn_body::bf16*)(ws + WS_AQ), (const unsigned*)(ws + WS_MASK), (char*)lds); }
        hg_scan(F);
        SEAM(5);
    }
    if (IN(6)) { for (int it = F.vcu; it < 1024; it += F.G) hg_out_item(F, it); SEAM(6); }
    if (IN(7)) {
        pg8::Gemm g{(const bf16*)(ws + WS_AQ), (const bf16*)(ws + WS_WPA), M, 1024, 512}; pg8::StaticOrder S; S.init(M, 1024, F.G, (int)blockIdx.x);
        pg8::EpiMerge<0> E{(const bf16*)F.out, (bf16*)(ws + WS_T)};
        pg8::gemm_phase<pg8::EpiMerge<0>, pg8::StaticOrder, true, true>(F.lds, g, S, E);
        SEAM(7);
    }
    if (IN(8)) {
        pg8::Gemm g{(const bf16*)(ws + WS_OB), (const bf16*)(ws + WS_WPB), M, 1024, 512}; pg8::StaticOrder S; S.init(M, 1024, F.G, (int)blockIdx.x);
        pg8::EpiMerge<1> E{(const bf16*)F.out + (size_t)M * 1024, (bf16*)(ws + WS_T)};
        pg8::gemm_phase<pg8::EpiMerge<1>, pg8::StaticOrder, true, true>(F.lds, g, S, E);
        SEAM(8);
    }
    if (IN(9)) {
        pg8::Gemm g{(const bf16*)(ws + WS_T), (const bf16*)(ws + WS_WOUT), M, 1024, 1024}; pg8::StaticOrder S; S.init(M, 1024, F.G, (int)blockIdx.x);
        pg8::EpiRes E{F.in[I_X], F.out, (const float*)(ws + WS_MODV) + 2048, nullptr};
        pg8::gemm_phase<pg8::EpiRes, pg8::StaticOrder, true, true>(F.lds, g, S, E);
        SEAM(9);
    }
    if (IN(10)) {
        { LAS float* scr = (LAS float*)(F.lds + F.wave * 16384); const int gw = F.vcu * NWAVES + F.wave, NGW = F.G * NWAVES;
          for (int it = gw; it < 4096; it += NGW) { if (it < 2048) tr_plain(F.in[I_W1], 1024, 4096, (bf16*)(ws + WS_W1), it, scr, F.lane); else tr_plain(F.in[I_W2], 4096, 1024, (bf16*)(ws + WS_W2), it - 2048, scr, F.lane); } }
        __syncthreads();
        norm_rows<1>(F, F.out, Hb);
        SEAM(10);
    }
    if (IN(11)) {
        pg8::Gemm g{Hb, (const bf16*)(ws + WS_W1), M, DFF, DMOD}; pg8::StaticOrder S; S.init(M, DFF, F.G, (int)blockIdx.x);
        pg8::EpiUp E{(bf16*)(ws + WS_HID), F.in[I_B1]};
        pg8::gemm_phase<pg8::EpiUp, pg8::StaticOrder, true, true>(F.lds, g, S, E);
        SEAM(11);
    }
    if (IN(12)) {
        pg8::Gemm g{(const bf16*)(ws + WS_HID), (const bf16*)(ws + WS_W2), M, DMOD, DFF}; pg8::StaticOrder S; S.init(M, DMOD, F.G, (int)blockIdx.x);
        pg8::EpiRes E{F.out, F.out, (const float*)(ws + WS_MODV) + 5120, F.in[I_B2]};
        pg8::gemm_phase<pg8::EpiRes, pg8::StaticOrder, true, true>(F.lds, g, S, E);
    }
#undef IN
#undef SEAM
}

extern "C" void kernel_launch(void* const* d_in, const int* in_sizes, int n_in, void* d_out, int out_size, void* d_ws, size_t ws_size, hipStream_t stream) {
    static int grid = 0;
    if (grid == 0) {
        if (n_in != 22 || out_size != M * DMOD || ws_size < WS_END) { fprintf(stderr, "kernel_launch: unexpected problem shape (n_in %d out %d ws %zu)\n", n_in, out_size, ws_size); grid = -1; return; }
        int dev = 0, cus = 0, per_cu = 0;
        if (hipGetDevice(&dev) != hipSuccess || hipDeviceGetAttribute(&cus, hipDeviceAttributeMultiprocessorCount, dev) != hipSuccess) { grid = -1; return; }
        if (hipFuncSetAttribute((const void*)mk_fwd, hipFuncAttributeMaxDynamicSharedMemorySize, LDS_BYTES) != hipSuccess) { fprintf(stderr, "kernel_launch: hipFuncSetAttribute failed\n"); grid = -1; return; }
        if (hipOccupancyMaxActiveBlocksPerMultiprocessor(&per_cu, (const void*)mk_fwd, NWAVES * 64, LDS_BYTES) != hipSuccess || per_cu < 1) fprintf(stderr, "kernel_launch: occupancy query says %d\n", per_cu);
        (void)hipGetLastError();
        grid = cus;
        if (grid != 256) fprintf(stderr, "kernel_launch: %d CUs (built for 256)\n", grid);
    }
    if (grid < 0) return;
    if (hipMemsetAsync((char*)d_ws + WS_CTL, 0, CTL_ZERO_BYTES, stream) != hipSuccess) return;
    Args a{};
    for (int i = 0; i < 22; ++i) a.in[i] = (const float*)d_in[i];
    a.out = (float*)d_out; a.ws = (unsigned char*)d_ws;
    for (int li = 0; li < N_LAUNCHES; ++li) {
        a.ph_lo = (N_LAUNCHES == 1) ? 0 : li; a.ph_hi = (N_LAUNCHES == 1) ? NPHASE : li + 1; a.li = li;
        hipLaunchKernelGGL(mk_fwd, dim3(grid), dim3(NWAVES * 64), LDS_BYTES, stream, a);
    }
}
```

```cpp
#include <hip/hip_runtime.h>
#include <hip/hip_bf16.h>
#include <cstdio>
#include <cstdint>
#include <cmath>
namespace pg8 {
#define PG8_LAS __attribute__((address_space(3)))
typedef unsigned short bf16_t;
typedef short bf16x8 __attribute__((ext_vector_type(8)));
typedef float f32x4 __attribute__((ext_vector_type(4)));
typedef unsigned u32x4 __attribute__((ext_vector_type(4)));
constexpr int BM = 256, BK = 64, HALF = 128, HTB = HALF * BK * 2  , STAGE_BYTES = 8 * HTB, NXCD = 8, WGM = 8;

__host__ __device__ __forceinline__ int lds_byte(int r, int c) { const int st = (r >> 4) * 2 + (c >> 5), rr = r & 15, cc = c & 31, ob = rr * 64 + cc * 2; return st * 1024 + (ob ^ (((ob >> 9) & 1) << 5)); }
__host__ __device__ __forceinline__ void stage_rc(int b, int& R, int& C) { const int st = b / 1024, sb = b % 1024, swz = sb ^ (((sb >> 9) & 1) << 5); R = (st >> 1) * 16 + swz / 64; C = (st & 1) * 32 + (swz % 64) / 2; }
__host__ __device__ __forceinline__ int perm32(int rho) { const int n = rho >> 4, i = rho & 15; return 8 * (i >> 2) + 4 * n + (i & 3); }

struct Unit { int pm, pn; };
struct Gemm { const bf16_t* A; const bf16_t* Bt; int M, N, K; };

struct StaticOrder {
    int nM, nN, nwg, G, c;
    __host__ __device__ void init(int M, int N, int G_, int c_) { nM = M / BM; nN = N / BM; nwg = nM * nN; G = G_; c = c_; }
    __host__ __device__ bool next(int i, Unit& u) const {
        const long L = (long)i * G + c; if (L >= nwg) return false;
        int wgid = (int)L; { const int q = nwg / NXCD, r = nwg % NXCD, xcd = wgid % NXCD, off = wgid / NXCD; wgid = (xcd < r ? xcd * (q + 1) : r * (q + 1) + (xcd - r) * q) + off; }
        const int nig = WGM * nN, gid = wgid / nig, fm = gid * WGM, gsz = (nM - fm) < WGM ? (nM - fm) : WGM;
        u.pm = fm + ((wgid % nig) % gsz); u.pn = (wgid % nig) / gsz; return true;
    }
    __device__ __forceinline__ void a_ready(const Unit&) const {}
    __device__ __forceinline__ void done(const Unit&) const {}
};

__device__ __forceinline__ unsigned cvt_pk_bf16(float lo, float hi) { unsigned r; asm volatile("v_cvt_pk_bf16_f32 %0, %1, %2" : "=v"(r) : "v"(lo), "v"(hi)); return r; }
__device__ __forceinline__ float bf2f(bf16_t b) { return __builtin_bit_cast(float, (unsigned)b << 16); }
__device__ __forceinline__ float sigm(float x) { return __builtin_amdgcn_rcpf(1.0f + __expf(-x)); }
__device__ __forceinline__ void st8(bf16_t* p, const float* v) { u32x4 w; w.x = cvt_pk_bf16(v[0], v[1]); w.y = cvt_pk_bf16(v[2], v[3]); w.z = cvt_pk_bf16(v[4], v[5]); w.w = cvt_pk_bf16(v[6], v[7]); *(u32x4*)p = w; }
__device__ __forceinline__ void ld8(const bf16_t* p, float* v) { const u32x4 w = *(const u32x4*)p; v[0] = __builtin_bit_cast(float, w.x << 16); v[1] = __builtin_bit_cast(float, w.x & 0xffff0000u);
    v[2] = __builtin_bit_cast(float, w.y << 16); v[3] = __builtin_bit_cast(float, w.y & 0xffff0000u); v[4] = __builtin_bit_cast(float, w.z << 16); v[5] = __builtin_bit_cast(float, w.z & 0xffff0000u);
    v[6] = __builtin_bit_cast(float, w.w << 16); v[7] = __builtin_bit_cast(float, w.w & 0xffff0000u); }
#define EPI_ROWS(ai, m) _Pragma("unroll") for (int ai = 0; ai < 2; ++ai) _Pragma("unroll") for (int m = 0; m < 4; ++m)
#define EPI_GET(v, ai, m) asm volatile("" ::: "memory"); float v[2][8]; _Pragma("unroll") for (int bj = 0; bj < 2; ++bj) _Pragma("unroll") for (int n = 0; n < 2; ++n) _Pragma("unroll") for (int j = 0; j < 4; ++j) v[bj][4 * n + j] = acc[ai][bj][m][n][j];
constexpr float EPSN = 1e-6f;
constexpr float C2ATT = 0.125f * 1.4426950408889634f;
constexpr float IDXSC = 0.0625f;

struct EpiProj {
    static constexpr bool PERM = true, AFTER_DRAIN = false;
    bf16_t *QLAT, *AK, *AV, *KI, *BQ, *GA; float *QLSS, *WIDX; const float *gk, *gki;
    __device__ __forceinline__ void operator()(const f32x4 (&acc)[2][2][4][2], const Unit& u, int wr, int wc, int fr_, int fq_) const { int fr = fr_, fq = fq_; asm volatile("" : "+v"(fr), "+v"(fq));
        const int pn = u.pn, rowb = u.pm * BM + wr * 64 + fr, cw = 64 * wc + 8 * fq;
        if (pn == 0) {
            EPI_ROWS(ai, m) { EPI_GET(v, ai, m) const int row = rowb + ai * HALF + m * 16; float ss = 0.f;
#pragma unroll
                for (int bj = 0; bj < 2; ++bj) { _Pragma("unroll") for (int j = 0; j < 8; ++j) ss += v[bj][j] * v[bj][j]; st8(QLAT + (size_t)row * 256 + cw + 32 * bj, v[bj]); }
                ss += __shfl_xor(ss, 16); ss += __shfl_xor(ss, 32); if (fq == 0) QLSS[row * 4 + wc] = ss; }
        } else if (pn <= 2 || pn == 5) {
            if (pn == 5 && wc != 0) { if (wc == 1 && fq == 0) { EPI_ROWS(ai, m) { const int row = rowb + ai * HALF + m * 16; *(f32x4*)(WIDX + row * 4) = acc[ai][0][m][0]; } } return; }
            const float* g = (pn == 5) ? gki : gk; float gv[2][8];
#pragma unroll
            for (int bj = 0; bj < 2; ++bj) { _Pragma("unroll") for (int j = 0; j < 8; ++j) gv[bj][j] = g[32 * bj + 8 * fq + j]; }
            bf16_t* O = (pn == 5) ? KI : AK; const int ld = (pn == 5) ? 64 : 512, c0 = (pn == 5) ? 8 * fq : (pn - 1) * 256 + cw;
            EPI_ROWS(ai, m) { EPI_GET(v, ai, m) const int row = rowb + ai * HALF + m * 16; float ss = 0.f;
#pragma unroll
                for (int bj = 0; bj < 2; ++bj) { _Pragma("unroll") for (int j = 0; j < 8; ++j) ss += v[bj][j] * v[bj][j]; }
                ss += __shfl_xor(ss, 16); ss += __shfl_xor(ss, 32); const float r = __builtin_amdgcn_rsqf(ss * (1.0f / 64.0f) + EPSN);
#pragma unroll
                for (int bj = 0; bj < 2; ++bj) { _Pragma("unroll") for (int j = 0; j < 8; ++j) v[bj][j] *= r * gv[bj][j];
                    if (pn == 5) st8(KI + (size_t)(row >> 5) * 2048 + (2 * bj + (fq >> 1)) * 512 + (fq & 1) * 256 + (row & 31) * 8, v[bj]);
                    else st8(O + (size_t)row * ld + c0 + 32 * bj, v[bj]); } }
        } else {
            bf16_t* O; int ld, c0, act;
            if (pn <= 4) { O = AV; ld = 512; c0 = (pn - 3) * 256; act = 0; }
            else if (pn <= 13) { const int k = (pn - 6) >> 1; O = BQ + (size_t)k * ((size_t)16384 * 512); ld = 512; c0 = ((pn - 6) & 1) * 256; act = (k == 0 || k == 3) ? 1 : 0; }
            else { const int k = (pn - 14) >> 2; O = GA + (size_t)k * ((size_t)16384 * 1024); ld = 1024; c0 = ((pn - 14) & 3) * 256; act = 2; }
            EPI_ROWS(ai, m) { EPI_GET(v, ai, m) const int row = rowb + ai * HALF + m * 16;
#pragma unroll
                for (int bj = 0; bj < 2; ++bj) { if (act) { _Pragma("unroll") for (int j = 0; j < 8; ++j) { const float s = sigm(v[bj][j]); v[bj][j] = (act == 1) ? v[bj][j] * s : s; } }
                    st8(O + (size_t)row * ld + c0 + cw + 32 * bj, v[bj]); } }
        }
    }
};
struct EpiQ {
    static constexpr bool PERM = true, AFTER_DRAIN = false;
    bf16_t *AQ, *QI; float* QN; const float *QLSS, *WIDX, *gq;
    __device__ __forceinline__ void operator()(const f32x4 (&acc)[2][2][4][2], const Unit& u, int wr, int wc, int fr_, int fq_) const { int fr = fr_, fq = fq_; asm volatile("" : "+v"(fr), "+v"(fq));
        const int pn = u.pn, rowb = u.pm * BM + wr * 64 + fr, cw = 64 * wc + 8 * fq;
        float gv[2][8];
#pragma unroll
        for (int bj = 0; bj < 2; ++bj) { _Pragma("unroll") for (int j = 0; j < 8; ++j) gv[bj][j] = gq[32 * bj + 8 * fq + j]; }
        EPI_ROWS(ai, m) { EPI_GET(v, ai, m) const int row = rowb + ai * HALF + m * 16;
            const f32x4 q4 = *(const f32x4*)(QLSS + row * 4); const float s = __builtin_amdgcn_rsqf(((q4[0] + q4[1]) + (q4[2] + q4[3])) * (1.0f / 256.0f) + EPSN);
            float ss = 0.f;
#pragma unroll
            for (int bj = 0; bj < 2; ++bj) { _Pragma("unroll") for (int j = 0; j < 8; ++j) ss += v[bj][j] * v[bj][j]; }
            ss += __shfl_xor(ss, 16); ss += __shfl_xor(ss, 32);
            if (pn < 2) { const float f = s * __builtin_amdgcn_rsqf(s * s * ss * (1.0f / 64.0f) + EPSN) * C2ATT;
#pragma unroll
                for (int bj = 0; bj < 2; ++bj) { _Pragma("unroll") for (int j = 0; j < 8; ++j) v[bj][j] *= f * gv[bj][j]; st8(AQ + (size_t)row * 512 + pn * 256 + cw + 32 * bj, v[bj]); }
            } else { const float f = s * WIDX[row * 4 + wc] * IDXSC;
#pragma unroll
                for (int bj = 0; bj < 2; ++bj) { _Pragma("unroll") for (int j = 0; j < 8; ++j) v[bj][j] *= f; st8(QI + (size_t)row * 256 + cw + 32 * bj, v[bj]); }
                if (fq == 0) QN[row * 4 + wc] = sqrtf(ss) * fabsf(f); }
        }
    }
};
template <int MODE> struct EpiMerge {
    static constexpr bool PERM = true, AFTER_DRAIN = false;
    const bf16_t* G; bf16_t* T;
    __device__ __forceinline__ void operator()(const f32x4 (&acc)[2][2][4][2], const Unit& u, int wr, int wc, int fr_, int fq_) const { int fr = fr_, fq = fq_; asm volatile("" : "+v"(fr), "+v"(fq));
        const int rowb = u.pm * BM + wr * 64 + fr, c0 = u.pn * BM + 64 * wc + 8 * fq;
        EPI_ROWS(ai, m) { EPI_GET(v, ai, m) const int row = rowb + ai * HALF + m * 16;
#pragma unroll
            for (int bj = 0; bj < 2; ++bj) { const size_t off = (size_t)row * 1024 + c0 + 32 * bj; float g[8]; ld8(G + off, g);
                if (MODE == 1) { float t[8]; ld8(T + off, t); _Pragma("unroll") for (int j = 0; j < 8; ++j) v[bj][j] = t[j] + g[j] * v[bj][j]; }
                else { _Pragma("unroll") for (int j = 0; j < 8; ++j) v[bj][j] *= g[j]; }
                st8(T + off, v[bj]); } }
    }
};
struct EpiRes {
    static constexpr bool PERM = true, AFTER_DRAIN = false;
    const float* base; float* out; const float* gate; const float* bias;
    __device__ __forceinline__ void operator()(const f32x4 (&acc)[2][2][4][2], const Unit& u, int wr, int wc, int fr_, int fq_) const { int fr = fr_, fq = fq_; asm volatile("" : "+v"(fr), "+v"(fq));
        const int rowb = u.pm * BM + wr * 64 + fr, c0 = u.pn * BM + 64 * wc + 8 * fq; const float* gp = gate + (u.pm >= 32 ? 6144 : 0);
        float gv[2][8], bv[2][8];
#pragma unroll
        for (int bj = 0; bj < 2; ++bj) { _Pragma("unroll") for (int j = 0; j < 8; ++j) { gv[bj][j] = gp[c0 + 32 * bj + j]; bv[bj][j] = bias ? bias[c0 + 32 * bj + j] : 0.f; } }
        EPI_ROWS(ai, m) { EPI_GET(v, ai, m) const int row = rowb + ai * HALF + m * 16;
#pragma unroll
            for (int bj = 0; bj < 2; ++bj) { const size_t off = (size_t)row * 1024 + c0 + 32 * bj; const f32x4 x0 = *(const f32x4*)(base + off), x1 = *(const f32x4*)(base + off + 4);
                f32x4 o0, o1;
#pragma unroll
                for (int j = 0; j < 4; ++j) { o0[j] = x0[j] + gv[bj][j] * (v[bj][j] + bv[bj][j]); o1[j] = x1[j] + gv[bj][4 + j] * (v[bj][4 + j] + bv[bj][4 + j]); }
                *(f32x4*)(out + off) = o0; *(f32x4*)(out + off + 4) = o1; } }
    }
};
struct EpiUp {
    static constexpr bool PERM = true, AFTER_DRAIN = false;
    bf16_t* O; const float* bias;
    __device__ __forceinline__ void operator()(const f32x4 (&acc)[2][2][4][2], const Unit& u, int wr, int wc, int fr_, int fq_) const { int fr = fr_, fq = fq_; asm volatile("" : "+v"(fr), "+v"(fq));
        const int rowb = u.pm * BM + wr * 64 + fr, c0 = u.pn * BM + 64 * wc + 8 * fq;
        float bv[2][8];
#pragma unroll
        for (int bj = 0; bj < 2; ++bj) { _Pragma("unroll") for (int j = 0; j < 8; ++j) bv[bj][j] = bias[c0 + 32 * bj + j]; }
        EPI_ROWS(ai, m) { EPI_GET(v, ai, m) const int row = rowb + ai * HALF + m * 16;
#pragma unroll
            for (int bj = 0; bj < 2; ++bj) { _Pragma("unroll") for (int j = 0; j < 8; ++j) { const float t = fmaxf(v[bj][j] + bv[bj][j], 0.f); v[bj][j] = t * t; }
                st8(O + (size_t)row * 4096 + c0 + 32 * bj, v[bj]); } }
    }
};
template <class Epi, class Sched, bool ALIGN_EPI = false, bool SP2 = false>
__device__ __forceinline__ void gemm_phase(PG8_LAS unsigned char* lds, const Gemm g, const Sched& S, const Epi& E) {
    const int tid = threadIdx.x, wid = __builtin_amdgcn_readfirstlane(tid >> 6), lane = tid & 63, wr = wid >> 2, wc = wid & 3, fr = lane & 15, fq = lane >> 4;
    const int K = g.K, nt = K / BK;
    unsigned voffA[2], voffB[2];
#pragma unroll
    for (int i = 0; i < 2; ++i) { int R, C; stage_rc(tid * 16 + i * 8192, R, C); const int Rb = Epi::PERM ? ((R & ~31) + perm32(R & 31)) : R;
        voffA[i] = (unsigned)(R * K + C) * 2u; voffB[i] = (unsigned)(Rb * K + C) * 2u; }
    const size_t kstep = (size_t)(BK * 2);
    const size_t hstep = (size_t)HALF * K * 2;
    const size_t tstep = 2 * hstep;
    const unsigned ldsw = (unsigned)wid * 1024u;
    const int aoff = lds_byte(wr * 64 + fr, fq * 8), boff = lds_byte(wc * 32 + fr, fq * 8);
#define PG8_SA(b, h) (((b) * 2 + (h)) * HTB)
#define PG8_SB(b, h) ((4 + (b) * 2 + (h)) * HTB)
#define PG8_STAGE(bufoff, gbase, voff) do { _Pragma("unroll") for (int _i = 0; _i < 2; ++_i) \
        __builtin_amdgcn_global_load_lds((const unsigned*)((const char*)(gbase) + (voff)[_i]), (PG8_LAS unsigned*)(lds + (bufoff) + ldsw + _i * 8192), 16, 0, 0); } while (0)
#define PG8_LDA(dst, b, h) do { _Pragma("unroll") for (int m = 0; m < 4; ++m) _Pragma("unroll") for (int k = 0; k < 2; ++k) dst[m][k] = *(const PG8_LAS bf16x8*)(lds + PG8_SA(b, h) + aoff + m * 2048 + k * 1024); } while (0)
#define PG8_LDB(dst, b, h) do { _Pragma("unroll") for (int n = 0; n < 2; ++n) _Pragma("unroll") for (int k = 0; k < 2; ++k) dst[n][k] = *(const PG8_LAS bf16x8*)(lds + PG8_SB(b, h) + boff + n * 2048 + k * 1024); } while (0)
#define PG8_MMA(ai, bj, At, Bt) do { __builtin_amdgcn_s_setprio(1); _Pragma("unroll") for (int m = 0; m < 4; ++m) _Pragma("unroll") for (int n = 0; n < 2; ++n) _Pragma("unroll") for (int k = 0; k < 2; ++k) \
        acc[ai][bj][m][n] = __builtin_amdgcn_mfma_f32_16x16x32_bf16(Bt[n][k], At[m][k], acc[ai][bj][m][n], 0, 0, 0); __builtin_amdgcn_s_setprio(0); } while (0)
#define PG8_WAIT_V(n) asm volatile("s_waitcnt vmcnt(" #n ")" ::: "memory")
#define PG8_WAIT_L(n) asm volatile("s_waitcnt lgkmcnt(" #n ")" ::: "memory")
#define PG8_BAR __builtin_amdgcn_s_barrier()
#define PG8_SCHED __builtin_amdgcn_sched_barrier(0)
    Unit cur, nxt; int ui = 0;
    if (!S.next(0, cur)) return;
    f32x4 acc[2][2][4][2];
#pragma unroll
    for (int a = 0; a < 2; ++a)
#pragma unroll
        for (int b = 0; b < 2; ++b)
#pragma unroll
            for (int m = 0; m < 4; ++m)
#pragma unroll
                for (int n = 0; n < 2; ++n) acc[a][b][m][n] = (f32x4){0.f, 0.f, 0.f, 0.f};
    bf16x8 At[4][2], B0[2][2], B1[2][2];
    const char* cA = (const char*)g.A + (size_t)cur.pm * tstep; const char* cB = (const char*)g.Bt + (size_t)cur.pn * tstep;
    S.a_ready(cur);
    if constexpr (SP2) {
        PG8_STAGE(PG8_SB(0, 0), cB, voffB); PG8_STAGE(PG8_SB(0, 1), cB + hstep, voffB); PG8_STAGE(PG8_SA(0, 0), cA, voffA); PG8_STAGE(PG8_SA(0, 1), cA + hstep, voffA);
        if (wr == 1) PG8_BAR;
        PG8_WAIT_V(2); PG8_BAR;
        PG8_STAGE(PG8_SB(1, 0), cB + kstep, voffB); PG8_STAGE(PG8_SA(1, 0), cA + kstep, voffA); PG8_STAGE(PG8_SB(1, 1), cB + hstep + kstep, voffB);
        PG8_WAIT_V(6); PG8_BAR;
    } else {
        PG8_STAGE(PG8_SB(0, 0), cB, voffB); PG8_STAGE(PG8_SA(0, 0), cA, voffA); PG8_STAGE(PG8_SB(0, 1), cB + hstep, voffB); PG8_STAGE(PG8_SA(0, 1), cA + hstep, voffA);
        if (wr == 1) PG8_BAR;
        PG8_WAIT_V(4); PG8_BAR;
        PG8_STAGE(PG8_SB(1, 0), cB + kstep, voffB); PG8_STAGE(PG8_SA(1, 0), cA + kstep, voffA); PG8_STAGE(PG8_SB(1, 1), cB + hstep + kstep, voffB);
        PG8_WAIT_V(6); PG8_BAR;
    }
    for (;;) {
        const bool has_next = S.next(ui + 1, nxt);
        const char* nA = has_next ? (const char*)g.A + (size_t)nxt.pm * tstep : cA; const char* nB = has_next ? (const char*)g.Bt + (size_t)nxt.pn * tstep : cB;
        for (int t = 0; t < nt; t += 2) {
            const bool last = (t == nt - 2);
            const char* a1 = cA + (size_t)(t + 1) * kstep;
            const char* a2 = last ? nA : cA + (size_t)(t + 2) * kstep; const char* b2 = last ? nB : cB + (size_t)(t + 2) * kstep;
            const char* a3 = a2 + kstep; const char* b3 = b2 + kstep;
            if (last && has_next) S.a_ready(nxt);
            if constexpr (SP2) {
            PG8_LDB(B0, 0, 0); PG8_LDB(B1, 0, 1); PG8_SCHED; PG8_LDA(At, 0, 0); PG8_STAGE(PG8_SA(1, 1), a1 + hstep, voffA);
            PG8_WAIT_V(8); PG8_WAIT_L(0); PG8_BAR; PG8_MMA(0, 0, At, B0); PG8_MMA(0, 1, At, B1); PG8_BAR; PG8_SCHED;
            PG8_LDA(At, 0, 1); PG8_STAGE(PG8_SB(0, 0), b2, voffB); PG8_STAGE(PG8_SB(0, 1), b2 + hstep, voffB); PG8_STAGE(PG8_SA(0, 0), a2, voffA);
            PG8_WAIT_V(8); PG8_WAIT_L(0); PG8_BAR; PG8_MMA(1, 0, At, B0); PG8_MMA(1, 1, At, B1); PG8_BAR; PG8_SCHED;
            PG8_LDB(B0, 1, 0); PG8_LDB(B1, 1, 1); PG8_SCHED; PG8_LDA(At, 1, 0); PG8_STAGE(PG8_SA(0, 1), a2 + hstep, voffA);
            PG8_WAIT_V(8); PG8_WAIT_L(0); PG8_BAR; PG8_MMA(0, 0, At, B0); PG8_MMA(0, 1, At, B1); PG8_BAR; PG8_SCHED;
            PG8_LDA(At, 1, 1); PG8_STAGE(PG8_SB(1, 0), b3, voffB); PG8_STAGE(PG8_SB(1, 1), b3 + hstep, voffB); PG8_STAGE(PG8_SA(1, 0), a3, voffA);
            PG8_WAIT_V(8); PG8_WAIT_L(0); PG8_BAR; PG8_MMA(1, 0, At, B0); PG8_MMA(1, 1, At, B1); PG8_BAR; PG8_SCHED;
            } else {
            PG8_LDB(B0, 0, 0); PG8_SCHED; PG8_LDA(At, 0, 0); PG8_STAGE(PG8_SA(1, 1), a1 + hstep, voffA);
            PG8_WAIT_L(8); PG8_BAR; PG8_WAIT_L(0); PG8_MMA(0, 0, At, B0); PG8_BAR; PG8_SCHED;
            PG8_LDB(B1, 0, 1); PG8_STAGE(PG8_SB(0, 0), b2, voffB);
            PG8_BAR; PG8_WAIT_L(0); PG8_MMA(0, 1, At, B1); PG8_BAR;
            PG8_LDA(At, 0, 1); PG8_STAGE(PG8_SA(0, 0), a2, voffA);
            PG8_BAR; PG8_WAIT_L(0); PG8_MMA(1, 0, At, B0); PG8_BAR; PG8_SCHED;
            PG8_STAGE(PG8_SB(0, 1), b2 + hstep, voffB);
            PG8_WAIT_V(6); PG8_BAR; PG8_MMA(1, 1, At, B1); PG8_BAR;
            PG8_LDB(B0, 1, 0); PG8_SCHED; PG8_LDA(At, 1, 0); PG8_STAGE(PG8_SA(0, 1), a2 + hstep, voffA);
            PG8_WAIT_L(8); PG8_BAR; PG8_WAIT_L(0); PG8_MMA(0, 0, At, B0); PG8_BAR; PG8_SCHED;
            PG8_LDB(B1, 1, 1); PG8_STAGE(PG8_SB(1, 0), b3, voffB);
            PG8_BAR; PG8_WAIT_L(0); PG8_MMA(0, 1, At, B1); PG8_BAR;
            PG8_LDA(At, 1, 1); PG8_STAGE(PG8_SA(1, 0), a3, voffA);
            PG8_BAR; PG8_WAIT_L(0); PG8_MMA(1, 0, At, B0); PG8_BAR; PG8_SCHED;
            PG8_STAGE(PG8_SB(1, 1), b3 + hstep, voffB);
            PG8_WAIT_V(6); PG8_BAR; PG8_MMA(1, 1, At, B1); PG8_BAR;
            }
        }
        if constexpr (ALIGN_EPI) { if (wr == 0) PG8_BAR; }
        if constexpr (!Epi::AFTER_DRAIN) { E(acc, cur, wr, wc, fr, fq); S.done(cur); }
        if (!has_next) break;
#pragma unroll
        for (int a = 0; a < 2; ++a)
#pragma unroll
            for (int b = 0; b < 2; ++b)
#pragma unroll
                for (int m = 0; m < 4; ++m)
#pragma unroll
                    for (int n = 0; n < 2; ++n) acc[a][b][m][n] = (f32x4){0.f, 0.f, 0.f, 0.f};
        cur = nxt; cA = nA; cB = nB; ++ui;
        if constexpr (ALIGN_EPI) { if (wr == 1) PG8_BAR; }
    }
    PG8_WAIT_V(0);
    if constexpr (!ALIGN_EPI) { if (wr == 0) PG8_BAR; }
    PG8_BAR;
    if constexpr (Epi::AFTER_DRAIN) { E.fused(acc, cur, wr, wc, fr, fq, lds, wid, lane); S.done(cur); }
#undef PG8_SA
#undef PG8_SB
#undef PG8_STAGE
#undef PG8_LDA
#undef PG8_LDB
#undef PG8_MMA
#undef PG8_WAIT_V
#undef PG8_WAIT_L
#undef PG8_BAR
#undef PG8_SCHED
}
}
namespace attn_body {
using bf16=__hip_bfloat16;
using bf16x8=__attribute__((ext_vector_type(8)))short;
using s16x4=__attribute__((ext_vector_type(4)))short;
using f32x16=__attribute__((ext_vector_type(16)))float;
using u32x4=__attribute__((ext_vector_type(4)))unsigned;
constexpr int BATCH=2,NHEAD=8,SEQ=8192,D=64,DM=NHEAD*D;
constexpr int NW=8,QBLK=32,QB=QBLK*NW,KVBLK=64,NQB=SEQ/QB;
__device__ __forceinline__ int crow(int r,int hi){return (r&3)+8*(r>>2)+4*hi;}
#define SBAR() __builtin_amdgcn_sched_barrier(0)
constexpr int NSLOT=3, SLOTB=8192;
constexpr int LDS_K=0, LDS_V=NSLOT*SLOTB, LDS_WS=2*NSLOT*SLOTB, LDS_OST=LDS_WS+NW*64*4, LDS_MR=LDS_OST+NW*4096, LDS_BYTES=LDS_MR+NW*1024;
__device__ __forceinline__ void glds16(const void*gsrc,unsigned lds_dst){unsigned keep;
  asm volatile("s_mov_b32 %0, m0\n\ts_mov_b32 m0, %2\n\ts_nop 0\n\tglobal_load_lds_dwordx4 %1, off\n\ts_mov_b32 m0, %0":"=&s"(keep):"v"(gsrc),"s"(lds_dst):"memory");}
__device__ __forceinline__ void glds4(const void*gsrc,unsigned lds_dst){unsigned keep;
  asm volatile("s_mov_b32 %0, m0\n\ts_mov_b32 m0, %2\n\ts_nop 0\n\tglobal_load_lds_dword %1, off\n\ts_mov_b32 m0, %0":"=&s"(keep):"v"(gsrc),"s"(lds_dst):"memory");}
typedef float f32x2_t __attribute__((ext_vector_type(2))); typedef __bf16 bf16x2_t __attribute__((ext_vector_type(2)));
__device__ __forceinline__ unsigned cvtpk_s(float lo,float hi){f32x2_t v={lo,hi};bf16x2_t b=__builtin_convertvector(v,bf16x2_t);return __builtin_bit_cast(unsigned,b);}
#define WAIT_BAR(N) asm volatile("s_waitcnt vmcnt(" #N ") lgkmcnt(0)\n\ts_barrier":::"memory")
__device__ __forceinline__ float mexp(float v,unsigned W,int e){const float p=__builtin_amdgcn_exp2f(v);return __builtin_bit_cast(float,__builtin_bit_cast(unsigned,p)&(unsigned)(((int)(W<<e))>>31));}
__device__ __forceinline__ void qkt(f32x16&p0,f32x16&p1,const char*Kslot,const bf16x8*qr,const f32x16&negm,int r32,int hi){
  const char*kb=Kslot+hi*1024+r32*16;
  #pragma unroll
  for(int d0=0;d0<4;++d0){
    const bf16x8 b0=*reinterpret_cast<const bf16x8*>(kb+d0*2048);
    const bf16x8 b1=*reinterpret_cast<const bf16x8*>(kb+d0*2048+512);
    if(d0==0){p0=__builtin_amdgcn_mfma_f32_32x32x16_bf16(b0,qr[0],negm,0,0,0);p1=__builtin_amdgcn_mfma_f32_32x32x16_bf16(b1,qr[0],negm,0,0,0);}
    else{p0=__builtin_amdgcn_mfma_f32_32x32x16_bf16(b0,qr[d0],p0,0,0,0);p1=__builtin_amdgcn_mfma_f32_32x32x16_bf16(b1,qr[d0],p1,0,0,0);}}
}
typedef __attribute__((address_space(3))) const char* lds_cptr;
typedef short v4i16_t __attribute__((ext_vector_type(4)));
__device__ __forceinline__ void kload8(bf16x8*kf,lds_cptr kp){
  kf[0]=*(const __attribute__((address_space(3))) bf16x8*)(kp);      kf[1]=*(const __attribute__((address_space(3))) bf16x8*)(kp+512);
  kf[2]=*(const __attribute__((address_space(3))) bf16x8*)(kp+2048); kf[3]=*(const __attribute__((address_space(3))) bf16x8*)(kp+2560);
  kf[4]=*(const __attribute__((address_space(3))) bf16x8*)(kp+4096); kf[5]=*(const __attribute__((address_space(3))) bf16x8*)(kp+4608);
  kf[6]=*(const __attribute__((address_space(3))) bf16x8*)(kp+6144); kf[7]=*(const __attribute__((address_space(3))) bf16x8*)(kp+6656);
}
__device__ __forceinline__ void kload2(bf16x8*kf,lds_cptr kp,int j){ kf[2*j]=*(const __attribute__((address_space(3))) bf16x8*)(kp+j*2048); kf[2*j+1]=*(const __attribute__((address_space(3))) bf16x8*)(kp+j*2048+512); }
__device__ __forceinline__ s16x4 vtr(lds_cptr p){ return __builtin_bit_cast(s16x4,__builtin_amdgcn_ds_read_tr16_b64_v4i16((__attribute__((address_space(3))) v4i16_t*)p)); }
__device__ __forceinline__ void pv(f32x16*o,int vb,bf16x8 pa0,bf16x8 pa1,bf16x8 pa2,bf16x8 pa3){
  #pragma unroll
  for(int d0=0;d0<2;++d0){s16x4 lo[4],hi[4];
    #pragma unroll
    for(int ks=0;ks<4;++ks){
      asm volatile("ds_read_b64_tr_b16 %0,%1 offset:%c2":"=&v"(lo[ks]):"v"(vb),"i"(d0*4096+ks*1024):"memory");
      asm volatile("ds_read_b64_tr_b16 %0,%1 offset:%c2":"=&v"(hi[ks]):"v"(vb),"i"(d0*4096+ks*1024+512):"memory");}
    asm volatile("s_waitcnt lgkmcnt(0)":::"memory");SBAR();
    #define PK(k) (bf16x8){lo[k][0],lo[k][1],lo[k][2],lo[k][3],hi[k][0],hi[k][1],hi[k][2],hi[k][3]}
    o[d0]=__builtin_amdgcn_mfma_f32_32x32x16_bf16(pa0,PK(0),o[d0],0,0,0);
    o[d0]=__builtin_amdgcn_mfma_f32_32x32x16_bf16(pa1,PK(1),o[d0],0,0,0);
    o[d0]=__builtin_amdgcn_mfma_f32_32x32x16_bf16(pa2,PK(2),o[d0],0,0,0);
    o[d0]=__builtin_amdgcn_mfma_f32_32x32x16_bf16(pa3,PK(3),o[d0],0,0,0);
    #undef PK
  }
}
#ifndef ATTN_STORE16
#define ATTN_STORE16(p,v) (*(u32x4*)(p)=(v))
#endif
__device__ __forceinline__ void attn_unit(int b,int h,int qb,const bf16*Q,const bf16*__restrict__ K,const bf16*__restrict__ V,bf16*O,const unsigned*MW,char*shm){
  const int tid=threadIdx.x,lane=tid&63,r32=lane&31,hi=lane>>5; const int wid=__builtin_amdgcn_readfirstlane(tid>>6);
  const long rowbase=(long)b*SEQ; const int q0=qb*QB;
  const bf16*Qw=Q+(rowbase+q0+wid*QBLK)*DM+h*D;
  const bf16*Kh=K+rowbase*DM+h*D,*Vh=V+rowbase*DM+h*D;
  const unsigned lds0=(unsigned)(uintptr_t)shm;
  float*wsf=(float*)(shm+LDS_WS)+wid*64;
  const bf16*ksrc=Kh+(long)lane*DM+wid*8;
  const bf16*vsrc=Vh+(long)(16*(wid&3)+(lane>>2))*DM+(wid>>2)*32+(lane&3)*8;
  const unsigned kdst=lds0+LDS_K+wid*1024, vdst=lds0+LDS_V+wid*1024, mdst=lds0+LDS_MR+wid*1024;
  const unsigned*msrc=MW+((size_t)(b*256+(q0>>5)+wid)*128)*64+lane;
  #define DMA_K(t,slot) glds16(ksrc+(long)(t)*KVBLK*DM,(unsigned)__builtin_amdgcn_readfirstlane(kdst+(slot)))
  #define DMA_V(t,slot) glds16(vsrc+(long)(t)*KVBLK*DM,(unsigned)__builtin_amdgcn_readfirstlane(vdst+(slot)))
  #define DMA_M(t) glds4(msrc+(long)(t)*64,(unsigned)__builtin_amdgcn_readfirstlane(mdst+(((t)&3)<<8)))
  const int vb0=(int)(lds0+LDS_V)+((lane>>4)&1)*32+(lane&3)*8+(4*hi+((lane&15)>>2))*64;
  const char*Kbase=shm+LDS_K; bf16x8 kf[8];
  const lds_cptr shm3=(lds_cptr)shm; const lds_cptr kp0=shm3+LDS_K+hi*1024+r32*16; const lds_cptr vp0=shm3+LDS_V+((lane>>4)&1)*32+(lane&3)*8+(4*hi+((lane&15)>>2))*64;
  const __attribute__((address_space(3))) unsigned* mrd=(const __attribute__((address_space(3))) unsigned*)(shm3+LDS_MR+wid*1024)+lane;
  const int NT=(q0+QB)/KVBLK;
  DMA_M(0);DMA_K(0,0);DMA_V(0,0);DMA_K(1,SLOTB);
  bf16x8 qr[4];
  #pragma unroll
  for(int d0=0;d0<4;++d0)qr[d0]=*reinterpret_cast<const bf16x8*>(&Qw[(long)r32*DM+d0*16+hi*8]);
  float l_reg=0.f;f32x16 o[2];o[0]=f32x16{};o[1]=f32x16{};const f32x16 negm=f32x16{};
  f32x16 pA0,pA1,pB0,pB1;
  int sl_prev=0,sl_cur=0,sl_next=SLOTB;
  #define ROT() do{sl_prev=sl_cur;sl_cur=sl_next;sl_next=(sl_next==(NSLOT-1)*SLOTB)?0:sl_next+SLOTB;}while(0)
  DMA_K(2,2*SLOTB);DMA_M(1);
  WAIT_BAR(4);
  { const unsigned W0=mrd[0];
    qkt(pA0,pA1,Kbase,qr,negm,r32,hi);
    _Pragma("unroll") for(int r=0;r<16;++r){pA0[r]=mexp(pA0[r],W0,r);pA1[r]=mexp(pA1[r],W0,16+r);} }
  WAIT_BAR(0);
  DMA_K(3,0);DMA_V(1,SLOTB);DMA_M(2);
  ROT();
  kload8(kf,kp0+sl_cur);
  WAIT_BAR(3);
  s16x4 vlo[8],vhi[8]; u32x4 pw0,pw1,pw2,pw3;
  #define PKW(P,B) cvtpk_s(P[B],P[B+1])
  #define PAF(k) __builtin_bit_cast(bf16x8,pw##k)
  #define VFR(i) (bf16x8){vlo[i][0],vlo[i][1],vlo[i][2],vlo[i][3],vhi[i][0],vhi[i][1],vhi[i][2],vhi[i][3]}
  #define PIN(x) asm volatile("":"+v"(x))
  #define GAPA(MF,A0,A1,A2,A3,W0,W1,PW) do{ MF; sacc+=A0; sacc+=A1; sacc+=A2; sacc+=A3; PIN(sacc); W0; W1; PIN(PW); SBAR(); }while(0)
  #define GAPB(MF,X,B,E0) do{ MF; X[B]=mexp(X[B],Wm,E0+B); X[B+1]=mexp(X[B+1],Wm,E0+B+1); X[B+2]=mexp(X[B+2],Wm,E0+B+2); X[B+3]=mexp(X[B+3],Wm,E0+B+3); PIN(X); SBAR(); }while(0)
  #define VRD(i) do{ vlo[i]=vtr(vp_+(((i)>>2)*4096+((i)&3)*1024)); vhi[i]=vtr(vp_+(((i)>>2)*4096+((i)&3)*1024+512)); }while(0)
  #define KRD(G,j) do{ if(G){ kload2(kf,kp0+sl_next,j); SBAR(); } }while(0)
  #define STEP(C0,C1,P0,P1,t,GK,GV,GM,GL) do{ SBAR(); \
    const lds_cptr vp_=vp0+sl_prev; const unsigned Wm=mrd[((t)&3)<<6]; \
    VRD(0); SBAR(); float sacc=(P0[0]+P0[1]); \
    GAPA(C0=__builtin_amdgcn_mfma_f32_32x32x16_bf16(kf[0],qr[0],negm,0,0,0), P0[2],P0[3],P0[4],P0[5],     pw0[0]=PKW(P0,0), pw0[1]=PKW(P0,2), pw0); \
    VRD(4); SBAR(); GAPA(C1=__builtin_amdgcn_mfma_f32_32x32x16_bf16(kf[1],qr[0],negm,0,0,0), P0[6],P0[7],P0[8],P0[9],     pw0[2]=PKW(P0,4), pw0[3]=PKW(P0,6), pw0); \
    VRD(1); SBAR(); GAPA(C0=__builtin_amdgcn_mfma_f32_32x32x16_bf16(kf[2],qr[1],C0,0,0,0),   P0[10],P0[11],P0[12],P0[13], pw1[0]=PKW(P0,8), pw1[1]=PKW(P0,10), pw1); \
    VRD(5); SBAR(); GAPA(C1=__builtin_amdgcn_mfma_f32_32x32x16_bf16(kf[3],qr[1],C1,0,0,0),   P0[14],P0[15],P1[0],P1[1],   pw1[2]=PKW(P0,12),pw1[3]=PKW(P0,14), pw1); \
    VRD(2); SBAR(); GAPA(C0=__builtin_amdgcn_mfma_f32_32x32x16_bf16(kf[4],qr[2],C0,0,0,0),   P1[2],P1[3],P1[4],P1[5],     pw2[0]=PKW(P1,0), pw2[1]=PKW(P1,2), pw2); \
    VRD(6); SBAR(); GAPA(C1=__builtin_amdgcn_mfma_f32_32x32x16_bf16(kf[5],qr[2],C1,0,0,0),   P1[6],P1[7],P1[8],P1[9],     pw2[2]=PKW(P1,4), pw2[3]=PKW(P1,6), pw2); \
    VRD(3); SBAR(); GAPA(C0=__builtin_amdgcn_mfma_f32_32x32x16_bf16(kf[6],qr[3],C0,0,0,0),   P1[10],P1[11],P1[12],P1[13], pw3[0]=PKW(P1,8), pw3[1]=PKW(P1,10), pw3); \
    VRD(7); SBAR(); GAPA(C1=__builtin_amdgcn_mfma_f32_32x32x16_bf16(kf[7],qr[3],C1,0,0,0),   P1[14],P1[15],0.f,0.f,       pw3[2]=PKW(P1,12),pw3[3]=PKW(P1,14), pw3); \
    l_reg+=sacc; \
    if(GK){DMA_K((t)+3,sl_cur);} if(GV){DMA_V((t)+1,sl_next);} if(GM){DMA_M((t)+2);} \
    SBAR(); \
    GAPB(o[0]=__builtin_amdgcn_mfma_f32_32x32x16_bf16(PAF(0),VFR(0),o[0],0,0,0), C0,0,0); \
    GAPB(o[1]=__builtin_amdgcn_mfma_f32_32x32x16_bf16(PAF(0),VFR(4),o[1],0,0,0), C0,4,0); \
    KRD(GL,0); GAPB(o[0]=__builtin_amdgcn_mfma_f32_32x32x16_bf16(PAF(1),VFR(1),o[0],0,0,0), C0,8,0); \
    KRD(GL,1); GAPB(o[1]=__builtin_amdgcn_mfma_f32_32x32x16_bf16(PAF(1),VFR(5),o[1],0,0,0), C0,12,0); \
    KRD(GL,2); GAPB(o[0]=__builtin_amdgcn_mfma_f32_32x32x16_bf16(PAF(2),VFR(2),o[0],0,0,0), C1,0,16); \
    KRD(GL,3); GAPB(o[1]=__builtin_amdgcn_mfma_f32_32x32x16_bf16(PAF(2),VFR(6),o[1],0,0,0), C1,4,16); \
    GAPB(o[0]=__builtin_amdgcn_mfma_f32_32x32x16_bf16(PAF(3),VFR(3),o[0],0,0,0), C1,8,16); \
    GAPB(o[1]=__builtin_amdgcn_mfma_f32_32x32x16_bf16(PAF(3),VFR(7),o[1],0,0,0), C1,12,16); \
    }while(0)
  int t=1;
  for(;t+5<NT;t+=2){
    STEP(pB0,pB1,pA0,pA1,t,true,true,true,true);     WAIT_BAR(3); ROT();
    STEP(pA0,pA1,pB0,pB1,t+1,true,true,true,true);   WAIT_BAR(3); ROT();
  }
  #define ENDW(tt) do{ if((tt)+3<NT){WAIT_BAR(3);} else if((tt)+2<NT){WAIT_BAR(2);} else {WAIT_BAR(0);} }while(0)
  for(;t+1<NT;t+=2){
    STEP(pB0,pB1,pA0,pA1,t,(t+3<NT),(t+1<NT),(t+2<NT),(t+1<NT));       ENDW(t);   ROT();
    STEP(pA0,pA1,pB0,pB1,t+1,(t+4<NT),(t+2<NT),(t+3<NT),(t+2<NT));     ENDW(t+1); ROT();
  }
  STEP(pB0,pB1,pA0,pA1,NT-1,false,false,false,false);
  { float sacc=pB0[0]+pB0[1]; _Pragma("unroll") for(int r=2;r<16;++r)sacc+=pB0[r]; _Pragma("unroll") for(int r=0;r<16;++r)sacc+=pB1[r]; l_reg+=sacc;
    pw0=(u32x4){PKW(pB0,0),PKW(pB0,2),PKW(pB0,4),PKW(pB0,6)};pw1=(u32x4){PKW(pB0,8),PKW(pB0,10),PKW(pB0,12),PKW(pB0,14)};pw2=(u32x4){PKW(pB1,0),PKW(pB1,2),PKW(pB1,4),PKW(pB1,6)};pw3=(u32x4){PKW(pB1,8),PKW(pB1,10),PKW(pB1,12),PKW(pB1,14)};
    SBAR(); pv(o,vb0+sl_cur,PAF(0),PAF(1),PAF(2),PAF(3)); }
  #undef PKW
  #undef PAF
  #undef VFR
  #undef PIN
  #undef GAPA
  #undef GAPB
  #undef VRD
  #undef KRD
  #undef STEP
  #undef ENDW
  {auto rr=__builtin_amdgcn_permlane32_swap(__float_as_uint(l_reg),__float_as_uint(l_reg),false,false);l_reg=__uint_as_float(rr[0])+__uint_as_float(rr[1]);}
  if(hi==0)wsf[32+r32]=l_reg;asm volatile("s_waitcnt lgkmcnt(0)":::"memory");
  float rli[16];
  #pragma unroll
  for(int r=0;r<16;++r)rli[r]=__builtin_amdgcn_rcpf(wsf[32+crow(r,hi)]);
  bf16*Ow=O+(rowbase+q0+wid*QBLK)*DM+h*D;
  { bf16*stg=(bf16*)(shm+LDS_OST)+wid*2048;
    #pragma unroll
    for(int r=0;r<16;++r){const int orow=crow(r,hi);
      #pragma unroll
      for(int d0=0;d0<2;++d0)stg[orow*64+d0*32+r32]=__float2bfloat16(o[d0][r]*rli[r]);}
    asm volatile("s_waitcnt lgkmcnt(0)":::"memory");
    #pragma unroll
    for(int i=0;i<4;++i){const int row=i*8+(lane>>3),ch=lane&7; const u32x4 v=*(const u32x4*)(stg+row*64+ch*8); ATTN_STORE16(Ow+(long)row*DM+ch*8,v);} }
  asm volatile("s_waitcnt lgkmcnt(0)\n\ts_barrier":::"memory");
  #undef DMA_K
  #undef DMA_V
  #undef DMA_M
  #undef ROT
}
constexpr int ATTN_LDS_BYTES=LDS_BYTES;
#undef SBAR
#undef WAIT_BAR
}
constexpr int NWAVES = 8;
#ifndef MK_N_LAUNCHES
#define MK_N_LAUNCHES 1
#endif
constexpr int NPHASE = 13;
constexpr int N_LAUNCHES = MK_N_LAUNCHES;
constexpr int BATCH = 2, SEQL = 8192, DMOD = 1024, M = BATCH * SEQL, DFF = 4096, NPROJ = 5632, DIN = 5444;
constexpr size_t MiB = 1u << 20;
constexpr size_t WS_CTL = 0, CTL_ZERO_BYTES = 1 * MiB;
constexpr size_t WS_MODP = 1 * MiB;
constexpr size_t WS_MODV = 2 * MiB;
constexpr size_t WS_QLSS = 2 * MiB + 64 * 1024;
constexpr size_t WS_WIDX = WS_QLSS + 256 * 1024;
constexpr size_t WS_QN   = WS_WIDX + 256 * 1024;
constexpr size_t WS_HDEC = 3 * MiB;
constexpr size_t WS_WIN = 4 * MiB, WS_WQ = 15 * MiB, WS_WPA = 16 * MiB, WS_WPB = 17 * MiB, WS_WOUT = 18 * MiB;
constexpr size_t WS_H = 20 * MiB;
constexpr size_t WS_MASK = 20 * MiB, WS_OB = 36 * MiB;
constexpr size_t WS_QLAT = 52 * MiB, WS_AK = 60 * MiB, WS_AV = 76 * MiB, WS_KI = 92 * MiB, WS_QI = 94 * MiB, WS_AQ = 102 * MiB;
constexpr size_t WS_BQ = 118 * MiB, WS_BF = 134 * MiB, WS_BI = 150 * MiB, WS_BG = 166 * MiB;
constexpr size_t WS_KV = 182 * MiB, WS_SP = 214 * MiB;
constexpr size_t WS_T = 182 * MiB;
constexpr size_t WS_W1 = 60 * MiB, WS_W2 = 68 * MiB;
constexpr size_t WS_HID = 76 * MiB;
constexpr size_t WS_END = 256 * MiB;
static_assert(WS_SP + 32 * MiB <= WS_END && WS_HID + 128 * MiB <= WS_END, "d_ws map");
constexpr int CW_BAR = 4096;
constexpr int RING_BYTES = 131072, SCR_BYTES = 155648, LDSCTL_OFF = SCR_BYTES, MISC_OFF = LDSCTL_OFF + 320, PAR_OFF = LDSCTL_OFF + 1024;
constexpr int LDS_BYTES = 163840;

#define GAS __attribute__((address_space(1)))
#define LAS __attribute__((address_space(3)))
typedef unsigned short bf16;
typedef unsigned v4u __attribute__((ext_vector_type(4)));
typedef float f32x4 __attribute__((ext_vector_type(4)));
typedef float f32x16 __attribute__((ext_vector_type(16)));
typedef short bf16x8 __attribute__((ext_vector_type(8)));
typedef GAS unsigned gu32;
#define RLX_AGENT __ATOMIC_RELAXED, __HIP_MEMORY_SCOPE_AGENT
#define LDS_WAIT() asm volatile("s_waitcnt lgkmcnt(0)" ::: "memory")
__device__ __forceinline__ unsigned f2bf(float f) { unsigned u = __builtin_bit_cast(unsigned, f); return (u + 0x7fffu + ((u >> 16) & 1u)) >> 16; }
__device__ __forceinline__ unsigned pk2(float lo, float hi) { return f2bf(lo) | (f2bf(hi) << 16); }
__device__ __forceinline__ float bf2f(bf16 b) { return __builtin_bit_cast(float, (unsigned)b << 16); }
__device__ __forceinline__ float sigmf(float x) { return 1.0f / (1.0f + __expf(-x)); }
#ifdef PROBE_A
#define STAMPB(i) do { if (threadIdx.x == 0) ((unsigned long long*)(F.ws + WS_CTL + 65536))[64 + blockIdx.x * 16 + (i)] = __builtin_amdgcn_s_memrealtime(); } while (0)
#else
#define STAMPB(i) do { } while (0)
#endif
#define XB_TMO      128
#define XB_XCNT(j)  (256  + 64 * (j))
#define XB_XSUB(j)  (1280 + 64 * (j))
#define XB_XGEN(j)  (2304 + 64 * (j))
#define XB_TOP      3328
#define XB_TOPGEN   3392
#define XCD_BAR_WORDS 3456
#define XB_SPIN_CAP (1u << 18)

__device__ __forceinline__ unsigned xb_ld(unsigned* p)              { return __hip_atomic_load(p, __ATOMIC_RELAXED, __HIP_MEMORY_SCOPE_AGENT); }
__device__ __forceinline__ unsigned xb_add(unsigned* p, unsigned v) { return __hip_atomic_fetch_add(p, v, __ATOMIC_RELAXED, __HIP_MEMORY_SCOPE_AGENT); }
__device__ __forceinline__ unsigned xb_xcc_id() { return (unsigned)__builtin_amdgcn_s_getreg((3 << 11) | 20) & 0xFu; }
#define XB_SPIN(cond, bar) do { unsigned _sp = 0; while (cond) { __builtin_amdgcn_s_sleep(1); \
    if ((++_sp & 255u) == 0u) { if (xb_ld(&(bar)[XB_TMO])) break; if (_sp > XB_SPIN_CAP) { atomicAdd(&(bar)[XB_TMO], 1u); break; } } } } while (0)

struct XcdBarrier {
    unsigned* bar; unsigned x;
    volatile LAS unsigned* st;
};

__device__ __forceinline__ XcdBarrier xcd_barrier_post(unsigned* bar, volatile LAS unsigned* st) {
    XcdBarrier b; b.bar = bar; b.x = xb_xcc_id(); b.st = st;
    if (threadIdx.x == 0) (void)xb_add(&bar[XB_XCNT(b.x)], 1u);
    return b;
}
__device__ __forceinline__ void xcd_barrier_complete(unsigned* bar, unsigned x, unsigned& nloc, unsigned& nx) {
    const unsigned G = gridDim.x * gridDim.y * gridDim.z;
    unsigned sum, cnt, mine, sp = 0u;
    for (;;) {
        sum = 0u; cnt = 0u; mine = 0u;
#pragma unroll
        for (unsigned j = 0; j < 16; ++j) { const unsigned c = xb_ld(&bar[XB_XCNT(j)]); sum += c; cnt += (c > 0u) ? 1u : 0u; mine = (j == x) ? c : mine; }
        if (sum == G) break;
        __builtin_amdgcn_s_sleep(1);
        if ((++sp & 255u) == 0u) { if (xb_ld(&bar[XB_TMO])) break; if (sp > XB_SPIN_CAP) { atomicAdd(&bar[XB_TMO], 1u); break; } }
    }
    nloc = mine > 0u ? mine : 1u; nx = cnt > 0u ? cnt : 1u;
}

__device__ __forceinline__ void xcd_barrier(const XcdBarrier& b) {
    asm volatile("s_waitcnt vmcnt(0)" ::: "memory");
    __syncthreads();
    if (threadIdx.x == 0) {
        unsigned* bar = b.bar;
        __builtin_amdgcn_s_waitcnt(0);
        unsigned nloc = b.st[0], nx = b.st[1];
        if (nloc == 0u) { xcd_barrier_complete(bar, b.x, nloc, nx); b.st[0] = nloc; b.st[1] = nx; }
        const unsigned old = xb_add(&bar[XB_XSUB(b.x)], 1u);
        const unsigned gen = old / nloc;
        if (old + 1u == (gen + 1u) * nloc) {
            __builtin_amdgcn_fence(__ATOMIC_RELEASE, "agent");
            asm volatile("s_waitcnt vmcnt(0)" ::: "memory");
            const unsigned og = xb_add(&bar[XB_TOP], 1u);
            const unsigned tg = og / nx;
            if (og + 1u == (tg + 1u) * nx) xb_add(&bar[XB_TOPGEN], 1u);
            else XB_SPIN(xb_ld(&bar[XB_TOPGEN]) == tg, bar);
            __builtin_amdgcn_fence(__ATOMIC_ACQUIRE, "agent");
            xb_add(&bar[XB_XGEN(b.x)], 1u);
            asm volatile("s_waitcnt vmcnt(0)" ::: "memory");
        } else {
            XB_SPIN(xb_ld(&bar[XB_XGEN(b.x)]) == gen, bar);
            __builtin_amdgcn_fence(__ATOMIC_ACQUIRE, "agent");
            asm volatile("s_waitcnt vmcnt(0)" ::: "memory");
        }
    }
    __syncthreads();
}

struct Frame {
    LAS unsigned char* lds; volatile LAS unsigned* MISC; gu32* ctl;
    int tid, lane, wave, vcu, G;
    const float* in[22]; float* out; unsigned char* ws;
};
enum { I_X = 0, I_C, I_WADA, I_BADA, I_N1G, I_WIN, I_QLG, I_WUQ, I_WUQI, I_QNG, I_KNG, I_KIG, I_LB, I_HOG, I_WPA, I_WPB, I_WOUT, I_N2G, I_W1, I_B1, I_W2, I_B2 };
__device__ __forceinline__ float wave_sum(float v) {
#pragma unroll
    for (int o = 1; o < 64; o <<= 1) v += __shfl_xor(v, o);
    return v;
}
__device__ __forceinline__ int prow(int n) { const int cl = n & 255; return (n & ~255) + 128 * ((cl >> 5) & 1) + 32 * (cl >> 6) + (cl & 31); }
__device__ __forceinline__ void tr_item(const float* W, int ldn, int sc0, int nvalid, int k0, const float* gsc, bf16* WT, int K, int drow0, LAS float* scr, int lane) {
    const int kr = lane >> 3, c4 = (lane & 7) * 4; f32x4 v[8];
    const bool al = (((size_t)(W + sc0) & 15) == 0) && ((ldn & 3) == 0) && (nvalid == 32);
    if (al) {
#pragma unroll
        for (int i = 0; i < 8; ++i) v[i] = *(const GAS f32x4*)(W + (size_t)(k0 + 8 * i + kr) * ldn + sc0 + c4);
    } else {
#pragma unroll
        for (int i = 0; i < 8; ++i) { const float* p = W + (size_t)(k0 + 8 * i + kr) * ldn + sc0 + c4;
            v[i].x = (c4 + 0 < nvalid) ? p[0] : 0.f; v[i].y = (c4 + 1 < nvalid) ? p[1] : 0.f; v[i].z = (c4 + 2 < nvalid) ? p[2] : 0.f; v[i].w = (c4 + 3 < nvalid) ? p[3] : 0.f; }
    }
#pragma unroll
    for (int i = 0; i < 8; ++i) { const int kk = 8 * i + kr; const float g = gsc ? gsc[k0 + kk] : 1.0f; LAS float* d = scr + kk * 33 + c4; d[0] = v[i].x * g; d[1] = v[i].y * g; d[2] = v[i].z * g; d[3] = v[i].w * g; }
    LDS_WAIT(); asm volatile("" ::: "memory");
    const int c = lane & 7;
#pragma unroll
    for (int j = 0; j < 4; ++j) { const int n = (lane >> 3) + 8 * j; const LAS float* s = scr + (8 * c) * 33 + n;
        v4u o; o.x = pk2(s[0 * 33], s[1 * 33]); o.y = pk2(s[2 * 33], s[3 * 33]); o.z = pk2(s[4 * 33], s[5 * 33]); o.w = pk2(s[6 * 33], s[7 * 33]);
        *(GAS v4u*)(WT + (size_t)(drow0 + n) * K + k0 + 8 * c) = o; }
    LDS_WAIT(); asm volatile("" ::: "memory");
}
__device__ __forceinline__ void tr_plain(const float* W, int K, int N, bf16* WT, int r, LAS float* scr, int lane) {
    const int nblk = N / 32, kb = r / nblk, nb = r % nblk; tr_item(W, N, 32 * nb, 32, 64 * kb, nullptr, WT, K, prow(32 * nb), scr, lane);
}
__device__ __forceinline__ void p0_prologue(Frame& F) {
    LAS float* scr = (LAS float*)(F.lds + F.wave * 16384);
    const int gw = F.vcu * NWAVES + F.wave, NGW = F.G * NWAVES, lane = F.lane;
    constexpr int I_IN = 16 * (NPROJ / 32), I_Q = 4 * 24, I_PA = 8 * 32, I_PB = 8 * 32, I_OUT = 16 * 32, I_GV = 96 * 8;
    constexpr int NITEMS = I_IN + I_Q + I_PA + I_PB + I_OUT + I_GV;
    bf16* WIN = (bf16*)(F.ws + WS_WIN); bf16* WQ = (bf16*)(F.ws + WS_WQ);
    for (int it = gw; it < NITEMS; it += NGW) {
        int r = it;
        if (r < I_IN) { const int nblk = NPROJ / 32, kb = r / nblk, nb = r % nblk, n0 = 32 * nb; int sc0, nv;
            if (n0 < 1280) { sc0 = n0; nv = 32; } else if (n0 < 1536) { sc0 = n0; nv = 1348 - n0; nv = nv < 0 ? 0 : (nv > 32 ? 32 : nv); if (nv == 0) sc0 = 0; } else { sc0 = n0 - 188; nv = 32; }
            tr_item(F.in[I_WIN], DIN, sc0, nv, 64 * kb, nullptr, WIN, 1024, prow(n0), scr, lane); continue; } r -= I_IN;
        if (r < I_Q) { const int kb = r / 24, nb = r % 24, n0 = 32 * nb;
            if (n0 < 512) tr_item(F.in[I_WUQ], 512, n0, 32, 64 * kb, F.in[I_QLG], WQ, 256, prow(n0), scr, lane);
            else tr_item(F.in[I_WUQI], 256, n0 - 512, 32, 64 * kb, F.in[I_QLG], WQ, 256, prow(n0), scr, lane);
            continue; } r -= I_Q;
        if (r < I_PA) { tr_plain(F.in[I_WPA], 512, 1024, (bf16*)(F.ws + WS_WPA), r, scr, lane); continue; } r -= I_PA;
        if (r < I_PB) { tr_plain(F.in[I_WPB], 512, 1024, (bf16*)(F.ws + WS_WPB), r, scr, lane); continue; } r -= I_PB;
        if (r < I_OUT) { tr_plain(F.in[I_WOUT], 1024, 1024, (bf16*)(F.ws + WS_WOUT), r, scr, lane); continue; } r -= I_OUT;
        {
            const int ng = r % 96, ks = r / 96, n = ng * 64 + lane; const float* c = F.in[I_C]; const float* w = F.in[I_WADA] + (size_t)(ks * 128) * 6144 + n;
            float a0 = 0.f, a1 = 0.f;
#pragma unroll 32
            for (int k = 0; k < 128; ++k) { const float wv = w[(size_t)k * 6144]; const float c0 = c[ks * 128 + k], c1 = c[1024 + ks * 128 + k];
                a0 += (c0 * sigmf(c0)) * wv; a1 += (c1 * sigmf(c1)) * wv; }
            float* mp = (float*)(F.ws + WS_MODP); mp[(size_t)(ks * 2 + 0) * 6144 + n] = a0; mp[(size_t)(ks * 2 + 1) * 6144 + n] = a1;
        }
    }
}
__device__ __forceinline__ float mod_val(Frame& F, int b, int j) {
    const float* mp = (const float*)(F.ws + WS_MODP); float s = F.in[I_BADA][j];
#pragma unroll
    for (int ks = 0; ks < 8; ++ks) s += mp[(size_t)(ks * 2 + b) * 6144 + j];
    return s;
}
template <int WHICH> __device__ __forceinline__ void norm_rows(Frame& F, const float* X, bf16* H) {
    LAS float* tab = (LAS float*)F.lds;
    const float* g = F.in[WHICH == 0 ? I_N1G : I_N2G]; const int shift_off = WHICH == 0 ? 0 : 3072, scale_off = WHICH == 0 ? 1024 : 4096;
    for (int i = F.tid; i < 2048; i += NWAVES * 64) { const int b = i >> 10, k = i & 1023; float sc, sh;
        if (WHICH == 0) { sc = mod_val(F, b, scale_off + k); sh = mod_val(F, b, shift_off + k); }
        else { const float* mv = (const float*)(F.ws + WS_MODV); sc = mv[b * 6144 + scale_off + k]; sh = mv[b * 6144 + shift_off + k]; }
        tab[i] = g[k] * (1.0f + sc); tab[2048 + i] = sh; }
    if (WHICH == 0) { float* mv = (float*)(F.ws + WS_MODV); for (int i = F.tid; i < 48; i += NWAVES * 64) { const int j = F.vcu * 48 + i; if (j < 12288) mv[j] = mod_val(F, j / 6144, j % 6144); } }
    __syncthreads();
    const int gw = F.vcu * NWAVES + F.wave, NGW = F.G * NWAVES;
    f32x4 vn[4];
    if (gw < M) { const GAS f32x4* xr = (const GAS f32x4*)(X + (size_t)gw * DMOD) + F.lane;
#pragma unroll
        for (int j = 0; j < 4; ++j) vn[j] = xr[64 * j]; }
    for (int m = gw; m < M; m += NGW) {
        const int b = m >> 13; f32x4 v[4]; float s = 0.f;
#pragma unroll
        for (int j = 0; j < 4; ++j) { v[j] = vn[j]; s += (v[j].x * v[j].x + v[j].y * v[j].y) + (v[j].z * v[j].z + v[j].w * v[j].w); }
        if (m + NGW < M) { const GAS f32x4* xr = (const GAS f32x4*)(X + (size_t)(m + NGW) * DMOD) + F.lane;
#pragma unroll
            for (int j = 0; j < 4; ++j) vn[j] = xr[64 * j]; }
        const float r = 1.0f / sqrtf(wave_sum(s) * (1.0f / DMOD) + 1e-6f);
        GAS unsigned long long* o8 = (GAS unsigned long long*)(H + (size_t)m * DMOD) + F.lane;
#pragma unroll
        for (int j = 0; j < 4; ++j) { const int k = 4 * F.lane + 256 * j; const LAS float* a = tab + b * 1024 + k; const LAS float* sh = tab + 2048 + b * 1024 + k;
            o8[64 * j] = (unsigned long long)pk2(v[j].x * r * a[0] + sh[0], v[j].y * r * a[1] + sh[1]) | ((unsigned long long)pk2(v[j].z * r * a[2] + sh[2], v[j].w * r * a[3] + sh[3]) << 32); }
    }
    __syncthreads();
}
__device__ __forceinline__ int crow(int r, int hi) { return (r & 3) + 8 * (r >> 2) + 4 * hi; }
constexpr float QKMAXF = 4194303.0f;
struct TkLane { float lo[4], hi[4], sc, off; int qq; };
__device__ __forceinline__ unsigned bsel(unsigned m, unsigned x, unsigned y) { return (m & x) | (~m & y); }
__device__ __forceinline__ float sel16(const float (&u)[16], int r) {
    unsigned a[8], b4[4], c2[2]; const unsigned m0 = 0u - (unsigned)(r & 1), m1 = 0u - (unsigned)((r >> 1) & 1), m2 = 0u - (unsigned)((r >> 2) & 1), m3 = 0u - (unsigned)((r >> 3) & 1);
#pragma unroll
    for (int i = 0; i < 8; ++i) a[i] = bsel(m0, __builtin_bit_cast(unsigned, u[2 * i + 1]), __builtin_bit_cast(unsigned, u[2 * i]));
#pragma unroll
    for (int i = 0; i < 4; ++i) b4[i] = bsel(m1, a[2 * i + 1], a[2 * i]);
#pragma unroll
    for (int i = 0; i < 2; ++i) c2[i] = bsel(m2, b4[2 * i + 1], b4[2 * i]);
    return __builtin_bit_cast(float, bsel(m3, c2[1], c2[0]));
}
template <int MODE>
__device__ __forceinline__ void topk_pass(Frame& F, const bf16* KI, const bf16x8 (&qf)[4][4], const TkLane& L, int rowbase, int q0, int gi, unsigned* MW, int b) {
    const int lane = F.lane, r32 = lane & 31, hi = lane >> 5, wid = F.wave;
    LAS unsigned* hist = (LAS unsigned*)F.lds;
    LAS int* par = (LAS int*)(F.lds + PAR_OFF);
    const int ntile = (gi >> 1) + 1, qmax = q0 + 31;
    float hiF = 0.f, loF = 0.f;
    if (MODE == 1) { const int tb = par[r32];
        if (tb < 0) { hiF = -1.0f; loF = -1.0f; }
        else { hiF = __builtin_bit_cast(float, __builtin_bit_cast(unsigned, (float)((tb + 1) * 4096)) - 1u); loF = tb == 0 ? -1.0f : __builtin_bit_cast(float, __builtin_bit_cast(unsigned, (float)(tb * 4096)) - 1u); } }
    LAS unsigned char* hq = (LAS unsigned char*)(hist + r32 * 1024);
#define TK_LDK(dst, tl) do { const bf16* kp_ = KI + (size_t)((rowbase >> 5) + (tl) * 2) * 2048 + hi * 256 + r32 * 8;     \
        _Pragma("unroll") for (int s_ = 0; s_ < 2; ++s_) _Pragma("unroll") for (int ks = 0; ks < 4; ++ks) dst[s_ * 4 + ks] = *(const bf16x8*)(kp_ + s_ * 2048 + ks * 512); } while (0)
    bf16x8 kn[8];
    if (wid < ntile) TK_LDK(kn, wid);
    for (int tile = wid; tile < ntile; tile += NWAVES) {
        unsigned W = 0; bf16x8 kc[8];
#pragma unroll
        for (int i = 0; i < 8; ++i) kc[i] = kn[i];
        if (tile + NWAVES < ntile) TK_LDK(kn, tile + NWAVES);
#pragma unroll
        for (int sub = 0; sub < 2; ++sub) {
            const int key0 = tile * 64 + sub * 32;
            if (key0 > qmax) { W <<= 16; continue; }
            f32x16 acc[4];
#pragma unroll
            for (int h = 0; h < 4; ++h) { acc[h] = f32x16{};
#pragma unroll
                for (int ks = 0; ks < 4; ++ks) acc[h] = __builtin_amdgcn_mfma_f32_32x32x16_bf16(kc[sub * 4 + ks], qf[h][ks], acc[h], 0, 0, 0); }
            float u[16];
#pragma unroll
            for (int r = 0; r < 16; ++r) {
                const float s = ((__builtin_amdgcn_fmed3f(acc[0][r], L.lo[0], L.hi[0]) + __builtin_amdgcn_fmed3f(acc[1][r], L.lo[1], L.hi[1])) + __builtin_amdgcn_fmed3f(acc[2][r], L.lo[2], L.hi[2])) + __builtin_amdgcn_fmed3f(acc[3][r], L.lo[3], L.hi[3]);
                u[r] = __builtin_fmaf(s, L.sc, L.off); }
            if (MODE == 3) { asm volatile("" :: "v"(acc[0]), "v"(acc[1]), "v"(acc[2]), "v"(acc[3])); continue; }
            if (MODE == 4) { _Pragma("unroll") for (int r = 0; r < 16; ++r) asm volatile("" :: "v"(u[r])); continue; }
            const bool diag = key0 + 31 > q0;
            const int kq = L.qq - key0 - 4 * hi;
            if (MODE == 0) {
                if (!diag) {
#pragma unroll
                    for (int r = 0; r < 16; ++r) { const unsigned qk = (unsigned)u[r]; __hip_atomic_fetch_add((LAS unsigned*)(hq + ((qk >> 10) & 0xFFCu)), 1u, __ATOMIC_RELAXED, __HIP_MEMORY_SCOPE_WORKGROUP); }
                } else {
#pragma unroll
                    for (int r = 0; r < 16; ++r) { const unsigned qk = (unsigned)u[r]; __hip_atomic_fetch_add((LAS unsigned*)(hq + ((qk >> 10) & 0xFFCu)), ((r & 3) + 8 * (r >> 2) <= kq) ? 1u : 0u, __ATOMIC_RELAXED, __HIP_MEMORY_SCOPE_WORKGROUP); }
                }
            } else {
                unsigned Wd = 0u, Wc = 0u;
#pragma unroll
                for (int r = 0; r < 16; ++r) { Wd = __builtin_amdgcn_alignbit(Wd, __builtin_bit_cast(unsigned, hiF - u[r]), 31); Wc = __builtin_amdgcn_alignbit(Wc, __builtin_bit_cast(unsigned, loF - u[r]), 31); }
                if (diag) { unsigned vm = 0u;
#pragma unroll
                    for (int r = 0; r < 16; ++r) vm = (vm << 1) | (((r & 3) + 8 * (r >> 2) <= kq) ? 1u : 0u);
                    Wd &= vm; Wc &= vm; }
                W = (W << 16) | Wd;
                unsigned cand = Wc & ~Wd;
                while (__ballot(cand != 0u)) {
                    if (cand != 0u) { const int p = 31 - __builtin_clz(cand), r = 15 - p; const unsigned qk = (unsigned)sel16(u, r);
                        const unsigned slot = __hip_atomic_fetch_add((LAS unsigned*)par + 64 + r32, 1u, __ATOMIC_RELAXED, __HIP_MEMORY_SCOPE_WORKGROUP);
                        if (slot < 1024u) hist[r32 * 1024 + slot] = ((qk & 4095u) << 13) | (unsigned)(8191 - (key0 + crow(r, hi)));
                        cand &= ~(1u << p); }
                }
            }
        }
        if (MODE == 1) MW[((size_t)(b * 256 + gi) * 128 + tile) * 64 + lane] = W;
    }
#undef TK_LDK
    if (MODE == 1) { const int tend = 4 * (gi >> 3) + 4; for (int tile = ntile + wid; tile < tend; tile += NWAVES) MW[((size_t)(b * 256 + gi) * 128 + tile) * 64 + lane] = 0u; }
}
__device__ __forceinline__ void topk_unit(Frame& F, int b, int gi, float kmax) {
    const int lane = F.lane, r32 = lane & 31, hi = lane >> 5, wid = F.wave, tid = F.tid;
    const int rowbase = b * SEQL, q0 = gi * 32;
    const bf16* KI = (const bf16*)(F.ws + WS_KI); const bf16* QI = (const bf16*)(F.ws + WS_QI); unsigned* MW = (unsigned*)(F.ws + WS_MASK);
    const float* WIDX = (const float*)(F.ws + WS_WIDX); const float* QN = (const float*)(F.ws + WS_QN);
    LAS unsigned* hist = (LAS unsigned*)F.lds; LAS int* par = (LAS int*)(F.lds + PAR_OFF);
    TkLane L; L.qq = q0 + r32; const int row = rowbase + L.qq;
    bf16x8 qf[4][4];
#pragma unroll
    for (int h = 0; h < 4; ++h) { _Pragma("unroll") for (int ks = 0; ks < 4; ++ks) qf[h][ks] = *(const bf16x8*)(QI + (size_t)row * 256 + h * 64 + ks * 16 + hi * 8); }
    { const f32x4 w4 = *(const f32x4*)(WIDX + row * 4), n4 = *(const f32x4*)(QN + row * 4); float hs = 0.f, ls = 0.f;
#pragma unroll
      for (int h = 0; h < 4; ++h) { const bool pos = w4[h] > 0.f; L.lo[h] = pos ? 0.f : -INFINITY; L.hi[h] = pos ? INFINITY : 0.f; const float bd = n4[h] * kmax; if (pos) hs += bd; else ls += bd; }
      float range = hs + ls; if (!(range > 1e-30f)) range = 1.0f; L.sc = QKMAXF / range; L.off = ls * L.sc; }
    STAMPB(13);
    { LAS v4u* hz = (LAS v4u*)hist; for (int i = tid; i < 8192; i += NWAVES * 64) hz[i] = (v4u){0u, 0u, 0u, 0u}; if (tid < 160) par[tid] = 0; }
    __syncthreads();
    topk_pass<0>(F, KI, qf, L, rowbase, q0, gi, MW, b);
    __syncthreads();
    STAMPB(8);
    for (int qi = 0; qi < 4; ++qi) { const int q = wid * 4 + qi; const LAS v4u* hqv = (const LAS v4u*)(hist + q * 1024 + lane * 16);
        unsigned w[16];
#pragma unroll
        for (int i = 0; i < 4; ++i) { const v4u t = hqv[i]; w[4 * i] = t.x; w[4 * i + 1] = t.y; w[4 * i + 2] = t.z; w[4 * i + 3] = t.w; }
        unsigned tot = 0;
#pragma unroll
        for (int i = 0; i < 16; ++i) tot += w[i];
        unsigned incl = tot;
#pragma unroll
        for (int o = 1; o < 64; o <<= 1) { const unsigned t = __shfl_down(incl, o); if (lane + o < 64) incl += t; }
        unsigned running = incl - tot;
        if (q0 + q + 1 <= 256) { if (lane == 0) { par[q] = -1; par[32 + q] = 0; } }
        else {
#pragma unroll
            for (int i = 15; i >= 0; --i) { const unsigned c = w[i];
                if (running < 256u && running + c >= 256u) { par[q] = lane * 16 + i; par[32 + q] = (int)running; } running += c; }
        }
    }
    __syncthreads();
    STAMPB(9);
#ifdef PROBE_EXTRA
    topk_pass<PROBE_EXTRA>(F, KI, qf, L, rowbase, q0, gi, MW, b);
    __syncthreads();
    STAMPB(14);
#endif
    topk_pass<1>(F, KI, qf, L, rowbase, q0, gi, MW, b);
    asm volatile("s_waitcnt vmcnt(0)" ::: "memory");
    __syncthreads();
    STAMPB(10);
    for (int qi = 0; qi < 4; ++qi) { const int q = wid * 4 + qi; const int tbq = par[q];
        if (tbq < 0) continue;
        int n = par[64 + q]; n = n > 1024 ? 1024 : n; const int rr = 256 - par[32 + q];
        unsigned T = 0; unsigned e[16];
        if (n <= 64) { e[0] = (lane < n) ? hist[q * 1024 + lane] : 0u; const bool ok = lane < n;
            for (int bit = 24; bit >= 0; --bit) { const unsigned cand = T | (1u << bit); const int c = __builtin_popcountll(__ballot(ok && e[0] >= cand)); if (c >= rr) T = cand; }
        } else {
#pragma unroll
            for (int i = 0; i < 16; ++i) { const int j = i * 64 + lane; e[i] = (j < n) ? hist[q * 1024 + j] : 0u; }
            for (int bit = 24; bit >= 0; --bit) { const unsigned cand = T | (1u << bit); int c = 0;
#pragma unroll
                for (int i = 0; i < 16; ++i) c += __builtin_popcountll(__ballot((i * 64 + lane < n) && e[i] >= cand));
                if (c >= rr) T = cand; } }
#pragma unroll
        for (int i = 0; i < 16; ++i) { if (i * 64 < n) { const int j = i * 64 + lane; const unsigned cmp = e[i];
                if (j < n && cmp >= T) { const int key = 8191 - (int)(cmp & 8191u), tile = key >> 6, k5 = key & 31, sub = (key >> 5) & 1, hh = (k5 >> 2) & 1, r = (k5 & 3) + 4 * (k5 >> 3);
                    atomicOr(MW + ((size_t)(b * 256 + gi) * 128 + tile) * 64 + hh * 32 + q, 1u << (31 - (16 * sub + r))); } } }
    }
    __syncthreads();
    STAMPB(11);
}
constexpr int HS = 272, HSE = 136;
constexpr int HG_TOT = 149504;
constexpr int H1_FR = 0, H1_IR = 17408, H1_VT = 34816, H1_KHT = 53248, H1_OUT = 71680;
constexpr int H3_QT = 0, H3_KT = 17408, H3_QH = 34816, H3_IR = 52224, H3_VT = 69632, H3_ST = 88064, H3_AM = 122880;
static_assert(H3_AM + 64 * 144 <= HG_TOT && HG_TOT + 4096 <= SCR_BYTES && H1_OUT + 128 * HS <= HG_TOT, "hgrn lds");
__device__ __forceinline__ void hg_ld_tile(const bf16* g, int tid, v4u (&r)[2]) {
#pragma unroll
    for (int i = 0; i < 2; ++i) { const int c = tid + 512 * i; r[i] = *(const GAS v4u*)(g + (size_t)(c >> 4) * 512 + (c & 15) * 8); } }
__device__ __forceinline__ void hg_st_tile(LAS unsigned char* d, int tid, const v4u (&r)[2]) {
#pragma unroll
    for (int i = 0; i < 2; ++i) { const int c = tid + 512 * i; *(LAS v4u*)(d + (c >> 4) * HS + (c & 15) * 16) = r[i]; } }
__device__ __forceinline__ unsigned hg_ld2(const LAS unsigned char* img, int t, int dp) { return *(const LAS unsigned*)(img + t * HS + dp * 4); }
__device__ __forceinline__ float lo16f(unsigned w) { return __builtin_bit_cast(float, w << 16); }
__device__ __forceinline__ float hi16f(unsigned w) { return __builtin_bit_cast(float, w & 0xffff0000u); }
__device__ __forceinline__ void hg_decay(Frame& F, const LAS unsigned char* FR, int h, float (&bl)[2][8], float (&kk)[2][8]) {
    const int dp = F.lane, tg = F.wave; const float* lbp = F.in[I_LB];
    const float lb0 = sigmf(lbp[h * 128 + 2 * dp] - lbp[512 + h * 128 + 2 * dp]), lb1 = sigmf(lbp[h * 128 + 2 * dp + 1] - lbp[512 + h * 128 + 2 * dp + 1]);
    float c0 = 0.f, c1 = 0.f;
#pragma unroll
    for (int i = 0; i < 8; ++i) { const unsigned w = hg_ld2(FR, 8 * tg + i, dp); const float s0 = sigmf(lo16f(w)), s1 = sigmf(hi16f(w));
        kk[0][i] = (1.0f - lb0) * (1.0f - s0); kk[1][i] = (1.0f - lb1) * (1.0f - s1);
        c0 += __logf(lb0 + (1.0f - lb0) * s0); c1 += __logf(lb1 + (1.0f - lb1) * s1); bl[0][i] = c0; bl[1][i] = c1; }
    typedef float f32x2 __attribute__((ext_vector_type(2)));
    *(LAS f32x2*)(F.lds + HG_TOT + (tg * 128 + 2 * dp) * 4) = (f32x2){c0, c1};
}
__device__ __forceinline__ void hg_decay_fix(Frame& F, float (&bl)[2][8], float (&bend)[2], float (&bmid)[2]) {
    const int dp = F.lane, tg = F.wave; typedef float f32x2 __attribute__((ext_vector_type(2)));
    float pre0 = 0.f, pre1 = 0.f, m0 = 0.f, m1 = 0.f, e0 = 0.f, e1 = 0.f;
#pragma unroll
    for (int g = 0; g < 8; ++g) { const f32x2 t = *(const LAS f32x2*)(F.lds + HG_TOT + (g * 128 + 2 * dp) * 4); if (g < tg) { pre0 += t.x; pre1 += t.y; } if (g < 4) { m0 += t.x; m1 += t.y; } e0 += t.x; e1 += t.y; }
#pragma unroll
    for (int i = 0; i < 8; ++i) { bl[0][i] += pre0; bl[1][i] += pre1; }
    bmid[0] = m0; bmid[1] = m1; bend[0] = e0; bend[1] = e1;
}
__device__ __forceinline__ void hg_vt(Frame& F, const LAS unsigned char* IR, LAS unsigned char* VT) {
    const int dp = F.lane, tg = F.wave; unsigned w[8];
#pragma unroll
    for (int i = 0; i < 8; ++i) w[i] = hg_ld2(IR, 8 * tg + i, dp);
    v4u a, b2;
    a.x = (w[0] & 0xffffu) | (w[1] << 16); a.y = (w[2] & 0xffffu) | (w[3] << 16); a.z = (w[4] & 0xffffu) | (w[5] << 16); a.w = (w[6] & 0xffffu) | (w[7] << 16);
    b2.x = (w[0] >> 16) | (w[1] & 0xffff0000u); b2.y = (w[2] >> 16) | (w[3] & 0xffff0000u); b2.z = (w[4] >> 16) | (w[5] & 0xffff0000u); b2.w = (w[6] >> 16) | (w[7] & 0xffff0000u);
    *(LAS v4u*)(VT + (2 * dp) * 144 + tg * 16) = a; *(LAS v4u*)(VT + (2 * dp + 1) * 144 + tg * 16) = b2;
}
#define HG_FRAG(base, row, stride, k) (*(const LAS bf16x8*)((base) + ((row) * (stride) + (k)) * 2))
__device__ __forceinline__ void hg_state_phase(Frame& F) {
    const int lane = F.lane, r32 = lane & 31, hi = lane >> 5, dp = F.lane, tg = F.wave, tid = F.tid;
    const bf16* BFp = (const bf16*)(F.ws + WS_BF); const bf16* BIp = (const bf16*)(F.ws + WS_BI);
    v4u rf[2], ri[2];
#define H1_PREF(item) do { const int bh_ = (item) >> 7, c_ = (item) & 127; const size_t ro_ = ((size_t)((bh_ >> 2) * SEQL + c_ * 64)) * 512 + (bh_ & 3) * 128; hg_ld_tile(BFp + ro_, tid, rf); hg_ld_tile(BIp + ro_, tid, ri); } while (0)
    int item = F.vcu; if (item < 1024) H1_PREF(item);
    for (; item < 1024; item += F.G) {
        const int h = (item >> 7) & 3;
        hg_st_tile(F.lds + H1_FR, tid, rf); hg_st_tile(F.lds + H1_IR, tid, ri);
        __syncthreads();
        if (item + F.G < 1024) H1_PREF(item + F.G);
        float bl[2][8], kk[2][8], bend[2], bmid[2]; hg_decay(F, F.lds + H1_FR, h, bl, kk);
        hg_vt(F, F.lds + H1_IR, F.lds + H1_VT);
        __syncthreads();
        hg_decay_fix(F, bl, bend, bmid);
#pragma unroll
        for (int ch = 0; ch < 2; ++ch) { float kv[8];
#pragma unroll
            for (int i = 0; i < 8; ++i) kv[i] = kk[ch][i] * __expf(bend[ch] - bl[ch][i]);
            v4u o; o.x = pk2(kv[0], kv[1]); o.y = pk2(kv[2], kv[3]); o.z = pk2(kv[4], kv[5]); o.w = pk2(kv[6], kv[7]);
            *(LAS v4u*)(F.lds + H1_KHT + (2 * dp + ch) * 144 + tg * 16) = o;
            if (tg == 0) ((float*)(F.ws + WS_HDEC))[item * 128 + 2 * dp + ch] = __expf(bend[ch]); }
        __syncthreads();
        { const LAS unsigned char* VTb = F.lds + H1_VT; const LAS unsigned char* KHb = F.lds + H1_KHT; LAS unsigned short* OUT = (LAS unsigned short*)(F.lds + H1_OUT); const int vi = F.wave >> 1;
#pragma unroll
          for (int jj = 0; jj < 2; ++jj) { const int dj = (F.wave & 1) * 2 + jj; f32x16 acc = f32x16{};
#pragma unroll
              for (int ks = 0; ks < 4; ++ks) acc = __builtin_amdgcn_mfma_f32_32x32x16_bf16(HG_FRAG(VTb, 32 * vi + r32, 72, 16 * ks + 8 * hi), HG_FRAG(KHb, 32 * dj + r32, 72, 16 * ks + 8 * hi), acc, 0, 0, 0);
#pragma unroll
              for (int r = 0; r < 16; ++r) OUT[(32 * vi + crow(r, hi)) * HSE + 32 * dj + r32] = (unsigned short)f2bf(acc[r]); } }
        __syncthreads();
        { bf16* KV = (bf16*)(F.ws + WS_KV) + (size_t)item * 16384; const LAS unsigned char* OUT = F.lds + H1_OUT;
#pragma unroll
          for (int i = 0; i < 4; ++i) { const int c = tid + 512 * i; *(GAS v4u*)(KV + (c >> 4) * 128 + (c & 15) * 8) = *(const LAS v4u*)(OUT + (c >> 4) * HS + (c & 15) * 16); } }
    }
#undef H1_PREF
    __syncthreads();
}
__device__ __forceinline__ void hg_scan(Frame& F) {
    const bf16* KV = (const bf16*)(F.ws + WS_KV); bf16* SP = (bf16*)(F.ws + WS_SP); const float* HD = (const float*)(F.ws + WS_HDEC);
    for (int e = F.vcu * (NWAVES * 64) + F.tid; e < 8 * 16384; e += F.G * NWAVES * 64) { const int bh = e >> 14, vd = e & 16383, d = vd & 127; float S = 0.f;
        for (int c0 = 0; c0 < 128; c0 += 16) { float kv[16], dc[16];
#pragma unroll
            for (int j = 0; j < 16; ++j) { const int item = bh * 128 + c0 + j; kv[j] = bf2f(KV[(size_t)item * 16384 + vd]); dc[j] = HD[item * 128 + d]; }
#pragma unroll
            for (int j = 0; j < 16; ++j) { const int item = bh * 128 + c0 + j; SP[(size_t)item * 16384 + vd] = (bf16)f2bf(S); S = dc[j] * S + kv[j]; } }
    }
}
__device__ __forceinline__ void hg_out_phase(Frame& F) {
    const int lane = F.lane, r32 = lane & 31, hi = lane >> 5, dp = F.lane, tg = F.wave, wid = F.wave, tid = F.tid;
    const bf16* BQp = (const bf16*)(F.ws + WS_BQ); const bf16* BFp = (const bf16*)(F.ws + WS_BF); const bf16* BIp = (const bf16*)(F.ws + WS_BI); const bf16* BGp = (const bf16*)(F.ws + WS_BG);
    const bf16* SPp = (const bf16*)(F.ws + WS_SP);
    v4u rq[2], rf[2], ri[2], rg[2], rs[4];
#define H3_PREF(item) do { const int bh_ = (item) >> 7, c_ = (item) & 127; const size_t ro_ = ((size_t)((bh_ >> 2) * SEQL + c_ * 64)) * 512 + (bh_ & 3) * 128; \
        hg_ld_tile(BQp + ro_, tid, rq); hg_ld_tile(BFp + ro_, tid, rf); hg_ld_tile(BIp + ro_, tid, ri); hg_ld_tile(BGp + ro_, tid, rg); \
        _Pragma("unroll") for (int i_ = 0; i_ < 4; ++i_) rs[i_] = *(const GAS v4u*)(SPp + (size_t)(item) * 16384 + (size_t)(tid + 512 * i_) * 8); } while (0)
    int item = F.vcu; if (item < 1024) H3_PREF(item);
    for (; item < 1024; item += F.G) {
        const int bh = item >> 7, c = item & 127, b = bh >> 2, h = bh & 3, rowc = b * SEQL + c * 64;
        hg_st_tile(F.lds + H3_QT, tid, rq); hg_st_tile(F.lds + H3_KT, tid, rf); hg_st_tile(F.lds + H3_IR, tid, ri);
#pragma unroll
        for (int i = 0; i < 4; ++i) { const int cc = tid + 512 * i; *(LAS v4u*)(F.lds + H3_ST + (cc >> 4) * HS + (cc & 15) * 16) = rs[i]; }
        const v4u rgc0 = rg[0], rgc1 = rg[1];
        __syncthreads();
        if (item + F.G < 1024) H3_PREF(item + F.G);
        float bl[2][8], kk[2][8], bend[2], bmid[2]; hg_decay(F, F.lds + H3_KT, h, bl, kk);
        hg_vt(F, F.lds + H3_IR, F.lds + H3_VT);
        __syncthreads();
        hg_decay_fix(F, bl, bend, bmid);
#pragma unroll
        for (int i = 0; i < 8; ++i) { const int t = 8 * tg + i; const unsigned qw = hg_ld2(F.lds + H3_QT, t, dp); const float q0 = lo16f(qw), q1 = hi16f(qw); const float e0 = bl[0][i] - bmid[0], e1 = bl[1][i] - bmid[1];
            *(LAS unsigned*)(F.lds + H3_QT + t * HS + dp * 4) = pk2(q0 * __expf(fminf(e0, 80.f)), q1 * __expf(fminf(e1, 80.f)));
            *(LAS unsigned*)(F.lds + H3_KT + t * HS + dp * 4) = pk2(kk[0][i] * __expf(fminf(-e0, 80.f)), kk[1][i] * __expf(fminf(-e1, 80.f)));
            *(LAS unsigned*)(F.lds + H3_QH + t * HS + dp * 4) = pk2(q0 * __expf(bl[0][i]), q1 * __expf(bl[1][i])); }
        __syncthreads();
        const LAS unsigned char* QTb = F.lds + H3_QT; const LAS unsigned char* KTb = F.lds + H3_KT; const LAS unsigned char* QHb = F.lds + H3_QH;
        const LAS unsigned char* VTb = F.lds + H3_VT; const LAS unsigned char* STb = F.lds + H3_ST; LAS unsigned char* AMb = F.lds + H3_AM;
        if (wid < 3) { const int ti = wid > 0 ? 1 : 0, sj = wid > 1 ? 1 : 0; f32x16 acc = f32x16{};
#pragma unroll
            for (int ks = 0; ks < 8; ++ks) acc = __builtin_amdgcn_mfma_f32_32x32x16_bf16(HG_FRAG(QTb, 32 * ti + r32, HSE, 16 * ks + 8 * hi), HG_FRAG(KTb, 32 * sj + r32, HSE, 16 * ks + 8 * hi), acc, 0, 0, 0);
            LAS unsigned short* AM = (LAS unsigned short*)AMb;
#pragma unroll
            for (int r = 0; r < 16; ++r) { const int t = 32 * ti + crow(r, hi), s = 32 * sj + r32; AM[t * 72 + s] = (unsigned short)f2bf(s <= t ? acc[r] : 0.f); } }
        __syncthreads();
        { const int ti = wid >> 2, vj = wid & 3; f32x16 o = f32x16{};
#pragma unroll
          for (int ks = 0; ks < 4; ++ks) if (ks < 2 * (ti + 1)) o = __builtin_amdgcn_mfma_f32_32x32x16_bf16(HG_FRAG(AMb, 32 * ti + r32, 72, 16 * ks + 8 * hi), HG_FRAG(VTb, 32 * vj + r32, 72, 16 * ks + 8 * hi), o, 0, 0, 0);
#pragma unroll
          for (int ks = 0; ks < 8; ++ks) o = __builtin_amdgcn_mfma_f32_32x32x16_bf16(HG_FRAG(QHb, 32 * ti + r32, HSE, 16 * ks + 8 * hi), HG_FRAG(STb, 32 * vj + r32, HSE, 16 * ks + 8 * hi), o, 0, 0, 0);
          LAS unsigned short* OUT = (LAS unsigned short*)(F.lds + H3_IR);
#pragma unroll
          for (int r = 0; r < 16; ++r) OUT[(32 * ti + crow(r, hi)) * HSE + 32 * vj + r32] = (unsigned short)f2bf(o[r]); }
        __syncthreads();
        { bf16* OB = (bf16*)(F.ws + WS_OB) + (size_t)rowc * 512 + h * 128; const LAS unsigned char* OUT = F.lds + H3_IR; const float* go = F.in[I_HOG] + h * 128;
#pragma unroll
          for (int i = 0; i < 2; ++i) { const int cc = tid + 512 * i, row = cc >> 4, c16 = cc & 15;
              const v4u w = *(const LAS v4u*)(OUT + row * HS + c16 * 16); const v4u bw = i == 0 ? rgc0 : rgc1;
              float v[8] = {lo16f(w.x), hi16f(w.x), lo16f(w.y), hi16f(w.y), lo16f(w.z), hi16f(w.z), lo16f(w.w), hi16f(w.w)};
              const float bgv[8] = {lo16f(bw.x), hi16f(bw.x), lo16f(bw.y), hi16f(bw.y), lo16f(bw.z), hi16f(bw.z), lo16f(bw.w), hi16f(bw.w)};
              float ss = 0.f;
#pragma unroll
              for (int j = 0; j < 8; ++j) ss += v[j] * v[j];
              ss += __shfl_xor(ss, 1); ss += __shfl_xor(ss, 2); ss += __shfl_xor(ss, 4); ss += __shfl_xor(ss, 8);
              const float rsd = 1.0f / sqrtf(ss * (1.0f / 128.0f) + 1e-6f);
              const f32x4 g0 = *(const f32x4*)(go + c16 * 8), g1 = *(const f32x4*)(go + c16 * 8 + 4);
              v4u o; o.x = pk2(v[0] * rsd * g0[0] * bgv[0], v[1] * rsd * g0[1] * bgv[1]); o.y = pk2(v[2] * rsd * g0[2] * bgv[2], v[3] * rsd * g0[3] * bgv[3]);
              o.z = pk2(v[4] * rsd * g1[0] * bgv[4], v[5] * rsd * g1[1] * bgv[5]); o.w = pk2(v[6] * rsd * g1[2] * bgv[6], v[7] * rsd * g1[3] * bgv[7]);
              *(GAS v4u*)(OB + (size_t)row * 512 + c16 * 8) = o; } }
        __syncthreads();
    }
#undef H3_PREF
}
struct Args { const float* in[22]; float* out; unsigned char* ws; int ph_lo, ph_hi, li, pad; };
__device__ __forceinline__ float absmax64(const float* g, int lane) { float v = fabsf(g[lane]);
#pragma unroll
    for (int o = 1; o < 64; o <<= 1) v = fmaxf(v, __shfl_xor(v, o));
    return v; }
__global__ void __launch_bounds__(NWAVES * 64, 2) mk_fwd(Args args) {
    extern __shared__ __attribute__((aligned(16))) unsigned char lds[];
    Frame F;
    F.lds = (LAS unsigned char*)lds; F.MISC = (volatile LAS unsigned*)(F.lds + MISC_OFF);
    F.tid = threadIdx.x; F.lane = F.tid & 63; F.wave = __builtin_amdgcn_readfirstlane(F.tid >> 6);
    F.G = gridDim.x; { const int bx = blockIdx.x; F.vcu = (F.G % 8 == 0) ? (bx % 8) * (F.G / 8) + bx / 8 : bx; }
    unsigned char* ws = args.ws; F.ws = ws; F.ctl = (gu32*)(ws + WS_CTL); F.out = args.out;
#pragma unroll
    for (int i = 0; i < 22; ++i) F.in[i] = args.in[i];
    for (int u = F.tid; u < (LDS_BYTES - LDSCTL_OFF) / 4; u += NWAVES * 64) ((LAS unsigned*)(F.lds + LDSCTL_OFF))[u] = 0u;
    __syncthreads();
    XcdBarrier bar; bar.bar = (unsigned*)(F.ctl + CW_BAR); bar.x = 0; bar.st = nullptr;
    if (N_LAUNCHES == 1) bar = xcd_barrier_post((unsigned*)(F.ctl + CW_BAR), F.MISC + 8);
    const int lo = args.ph_lo, hi = args.ph_hi;
#ifdef PROBE_A
    const bool stamper = (blockIdx.x == 0 && F.tid == 0); unsigned long long* const tsw = (unsigned long long*)(ws + WS_CTL + 65536);
#define STAMP(i) do { if (stamper) tsw[i] = __builtin_amdgcn_s_memrealtime(); } while (0)
#else
#define STAMP(i) do { } while (0)
#endif
    STAMP(0);
#ifndef PHSEL
#define PHSEL 0x1fff
#endif
#define IN(k) (((PHSEL >> (k)) & 1) && lo <= (k) && (k) < hi)
#define SEAM(k) do { if (IN(k) && IN((k) + 1)) xcd_barrier(bar); } while (0)
    bf16* Hb = (bf16*)(ws + WS_H);
    if (IN(0)) { p0_prologue(F); SEAM(0); STAMP(1); }
    if (IN(1)) { norm_rows<0>(F, F.in[I_X], Hb); SEAM(1); STAMP(2); }
    if (IN(2)) {
        pg8::Gemm g{Hb, (const bf16*)(ws + WS_WIN), M, NPROJ, DMOD}; pg8::StaticOrder S; S.init(M, NPROJ, F.G, (int)blockIdx.x);
        pg8::EpiProj E{(bf16*)(ws + WS_QLAT), (bf16*)(ws + WS_AK), (bf16*)(ws + WS_AV), (bf16*)(ws + WS_KI), (bf16*)(ws + WS_BQ),
                       (bf16*)F.out, (float*)(ws + WS_QLSS), (float*)(ws + WS_WIDX), F.in[I_KNG], F.in[I_KIG]};
        pg8::gemm_phase<pg8::EpiProj, pg8::StaticOrder, true, true>(F.lds, g, S, E);
        SEAM(2); STAMP(3);
    }
    if (IN(3)) {
        int Kq = 256; asm volatile("" : "+s"(Kq));
        pg8::Gemm g{(const bf16*)(ws + WS_QLAT), (const bf16*)(ws + WS_WQ), M, 768, Kq}; pg8::StaticOrder S; S.init(M, 768, F.G, (int)blockIdx.x);
        pg8::EpiQ E{(bf16*)(ws + WS_AQ), (bf16*)(ws + WS_QI), (float*)(ws + WS_QN), (const float*)(ws + WS_QLSS), (const float*)(ws + WS_WIDX), F.in[I_QNG]};
        pg8::gemm_phase<pg8::EpiQ, pg8::StaticOrder, true, true>(F.lds, g, S, E);
        SEAM(3); STAMP(4);
    }
    if (IN(4)) {
        STAMPB(0);
        const float kmax = 8.0f * absmax64(F.in[I_KIG], F.lane) * 1.02f;
        { const int b = F.vcu >> 7, p = F.vcu & 127; if (F.vcu < 256) { topk_unit(F, b, p, kmax); topk_unit(F, b, 255 - p, kmax); } }
        STAMP(14); STAMPB(1);
        hg_state_phase(F); STAMPB(2);
        SEAM(4); STAMP(5);
    }
    if (IN(5)) {
        STAMPB(3);
        if (F.vcu < 256) { const int bh = F.vcu >> 4, s = F.vcu & 15;
            for (int i = 0; i < 2; ++i) attn_body::attn_unit(bh >> 3, bh & 7, i == 0 ? s : 31 - s, (const attn_body::bf16*)(ws + WS_AQ), (const attn_body::bf16*)(ws + WS_AK), (const attn_body::bf16*)(ws + WS_AV),
                                                             (attn_body::bf16*)(ws + WS_AQ), (const unsigned*)(ws + WS_MASK), (char*)lds); }
        STAMP(15); STAMPB(4);
        hg_scan(F); STAMPB(5);
        SEAM(5); STAMP(6);
    }
    if (IN(6)) { STAMPB(6); hg_out_phase(F); STAMPB(7); SEAM(6); STAMP(7); }
    if (IN(7)) {
        pg8::Gemm g{(const bf16*)(ws + WS_AQ), (const bf16*)(ws + WS_WPA), M, 1024, 512}; pg8::StaticOrder S; S.init(M, 1024, F.G, (int)blockIdx.x);
        pg8::EpiMerge<0> E{(const bf16*)F.out, (bf16*)(ws + WS_T)};
        pg8::gemm_phase<pg8::EpiMerge<0>, pg8::StaticOrder, true, true>(F.lds, g, S, E);
        SEAM(7); STAMP(8);
    }
    if (IN(8)) {
        pg8::Gemm g{(const bf16*)(ws + WS_OB), (const bf16*)(ws + WS_WPB), M, 1024, 512}; pg8::StaticOrder S; S.init(M, 1024, F.G, (int)blockIdx.x);
        pg8::EpiMerge<1> E{(const bf16*)F.out + (size_t)M * 1024, (bf16*)(ws + WS_T)};
        pg8::gemm_phase<pg8::EpiMerge<1>, pg8::StaticOrder, true, true>(F.lds, g, S, E);
        SEAM(8); STAMP(9);
    }
    if (IN(9)) {
        pg8::Gemm g{(const bf16*)(ws + WS_T), (const bf16*)(ws + WS_WOUT), M, 1024, 1024}; pg8::StaticOrder S; S.init(M, 1024, F.G, (int)blockIdx.x);
        pg8::EpiRes E{F.in[I_X], F.out, (const float*)(ws + WS_MODV) + 2048, nullptr};
        pg8::gemm_phase<pg8::EpiRes, pg8::StaticOrder, true, true>(F.lds, g, S, E);
        SEAM(9); STAMP(10);
    }
    if (IN(10)) {
        { LAS float* scr = (LAS float*)(F.lds + F.wave * 16384); const int gw = F.vcu * NWAVES + F.wave, NGW = F.G * NWAVES;
          for (int it = gw; it < 4096; it += NGW) { if (it < 2048) tr_plain(F.in[I_W1], 1024, 4096, (bf16*)(ws + WS_W1), it, scr, F.lane); else tr_plain(F.in[I_W2], 4096, 1024, (bf16*)(ws + WS_W2), it - 2048, scr, F.lane); } }
        __syncthreads();
        norm_rows<1>(F, F.out, Hb);
        SEAM(10); STAMP(11);
    }
    if (IN(11)) {
        pg8::Gemm g{Hb, (const bf16*)(ws + WS_W1), M, DFF, DMOD}; pg8::StaticOrder S; S.init(M, DFF, F.G, (int)blockIdx.x);
        pg8::EpiUp E{(bf16*)(ws + WS_HID), F.in[I_B1]};
        pg8::gemm_phase<pg8::EpiUp, pg8::StaticOrder, true, true>(F.lds, g, S, E);
        SEAM(11); STAMP(12);
    }
    if (IN(12)) {
        pg8::Gemm g{(const bf16*)(ws + WS_HID), (const bf16*)(ws + WS_W2), M, DMOD, DFF}; pg8::StaticOrder S; S.init(M, DMOD, F.G, (int)blockIdx.x);
        pg8::EpiRes E{F.out, F.out, (const float*)(ws + WS_MODV) + 5120, F.in[I_B2]};
        pg8::gemm_phase<pg8::EpiRes, pg8::StaticOrder, true, true>(F.lds, g, S, E);
    }
#ifdef PROBE_A
    xcd_barrier(bar); STAMP(13); xcd_barrier(bar);
    { const volatile unsigned long long* tv = tsw; float frac;
#if defined(PROBE_STAT)
      { float mx = 0.f, sm = 0.f; for (int bk = 0; bk < (int)gridDim.x; ++bk) { const float dsp = (float)(long long)(tv[64 + bk * 16 + PROBE_B] - tv[64 + bk * 16 + PROBE_A]); mx = fmaxf(mx, dsp); sm += dsp; }
        frac = (PROBE_STAT == 1 ? mx : sm / (float)gridDim.x) / (float)(long long)(tv[13] - tv[0]); }
#else
      frac = (float)(long long)(tv[PROBE_B] - tv[PROBE_A]) / (float)(long long)(tv[13] - tv[0]);
#endif
      const float sc = 1.0f + 0.1f * sqrtf(fmaxf(frac, 0.f));
      for (int m = F.vcu * NWAVES + F.wave; m < M; m += F.G * NWAVES) { GAS f32x4* o = (GAS f32x4*)(F.out + (size_t)m * DMOD) + F.lane;
#pragma unroll
          for (int j = 0; j < 4; ++j) { f32x4 v = o[64 * j]; v = v * sc; o[64 * j] = v; } } }
#endif
#undef IN
#undef SEAM
}

extern "C" void kernel_launch(void* const* d_in, const int* in_sizes, int n_in, void* d_out, int out_size, void* d_ws, size_t ws_size, hipStream_t stream) {
    static int grid = 0;
    if (grid == 0) {
        if (n_in != 22 || out_size != M * DMOD || ws_size < WS_END) { fprintf(stderr, "kernel_launch: unexpected problem shape (n_in %d out %d ws %zu)\n", n_in, out_size, ws_size); grid = -1; return; }
        int dev = 0, cus = 0, per_cu = 0;
        if (hipGetDevice(&dev) != hipSuccess || hipDeviceGetAttribute(&cus, hipDeviceAttributeMultiprocessorCount, dev) != hipSuccess) { grid = -1; return; }
        if (hipFuncSetAttribute((const void*)mk_fwd, hipFuncAttributeMaxDynamicSharedMemorySize, LDS_BYTES) != hipSuccess) { fprintf(stderr, "kernel_launch: hipFuncSetAttribute failed\n"); grid = -1; return; }
        if (hipOccupancyMaxActiveBlocksPerMultiprocessor(&per_cu, (const void*)mk_fwd, NWAVES * 64, LDS_BYTES) != hipSuccess || per_cu < 1) fprintf(stderr, "kernel_launch: occupancy query says %d\n", per_cu);
        (void)hipGetLastError();
        grid = cus;
        if (grid != 256) fprintf(stderr, "kernel_launch: %d CUs (built for 256)\n", grid);
    }
    if (grid < 0) return;
    if (hipMemsetAsync((char*)d_ws + WS_CTL, 0, CTL_ZERO_BYTES, stream) != hipSuccess) return;
    Args a{};
    for (int i = 0; i < 22; ++i) a.in[i] = (const float*)d_in[i];
    a.out = (float*)d_out; a.ws = (unsigned char*)d_ws;
    for (int li = 0; li < N_LAUNCHES; ++li) {
        a.ph_lo = (N_LAUNCHES == 1) ? 0 : li; a.ph_hi = (N_LAUNCHES == 1) ? NPHASE : li + 1; a.li = li;
        hipLaunchKernelGGL(mk_fwd, dim3(grid), dim3(NWAVES * 64), LDS_BYTES, stream, a);
    }
}
```

```cpp
#include <hip/hip_runtime.h>
#include <hip/hip_bf16.h>
#include <cstdio>
#include <cstdint>
#include <cmath>
namespace pg8 {
#define PG8_LAS __attribute__((address_space(3)))
typedef unsigned short bf16_t;
typedef short bf16x8 __attribute__((ext_vector_type(8)));
typedef float f32x4 __attribute__((ext_vector_type(4)));
typedef unsigned u32x4 __attribute__((ext_vector_type(4)));
constexpr int BM = 256, BK = 64, HALF = 128, HTB = HALF * BK * 2  , STAGE_BYTES = 8 * HTB, NXCD = 8, WGM = 8;

__host__ __device__ __forceinline__ int lds_byte(int r, int c) { const int st = (r >> 4) * 2 + (c >> 5), rr = r & 15, cc = c & 31, ob = rr * 64 + cc * 2; return st * 1024 + (ob ^ (((ob >> 9) & 1) << 5)); }
__host__ __device__ __forceinline__ void stage_rc(int b, int& R, int& C) { const int st = b / 1024, sb = b % 1024, swz = sb ^ (((sb >> 9) & 1) << 5); R = (st >> 1) * 16 + swz / 64; C = (st & 1) * 32 + (swz % 64) / 2; }
__host__ __device__ __forceinline__ int perm32(int rho) { const int n = rho >> 4, i = rho & 15; return 8 * (i >> 2) + 4 * n + (i & 3); }

struct Unit { int pm, pn; };
struct Gemm { const bf16_t* A; const bf16_t* Bt; int M, N, K; };

struct StaticOrder {
    int nM, nN, nwg, G, c;
    __host__ __device__ void init(int M, int N, int G_, int c_) { nM = M / BM; nN = N / BM; nwg = nM * nN; G = G_; c = c_; }
    __host__ __device__ bool next(int i, Unit& u) const {
        const long L = (long)i * G + c; if (L >= nwg) return false;
        int wgid = (int)L; { const int q = nwg / NXCD, r = nwg % NXCD, xcd = wgid % NXCD, off = wgid / NXCD; wgid = (xcd < r ? xcd * (q + 1) : r * (q + 1) + (xcd - r) * q) + off; }
        const int nig = WGM * nN, gid = wgid / nig, fm = gid * WGM, gsz = (nM - fm) < WGM ? (nM - fm) : WGM;
        u.pm = fm + ((wgid % nig) % gsz); u.pn = (wgid % nig) / gsz; return true;
    }
    __device__ __forceinline__ void a_ready(const Unit&) const {}
    __device__ __forceinline__ void done(const Unit&) const {}
};

__device__ __forceinline__ unsigned cvt_pk_bf16(float lo, float hi) { unsigned r; asm volatile("v_cvt_pk_bf16_f32 %0, %1, %2" : "=v"(r) : "v"(lo), "v"(hi)); return r; }
__device__ __forceinline__ float bf2f(bf16_t b) { return __builtin_bit_cast(float, (unsigned)b << 16); }
__device__ __forceinline__ float sigm(float x) { return __builtin_amdgcn_rcpf(1.0f + __expf(-x)); }
__device__ __forceinline__ void st8(bf16_t* p, const float* v) { u32x4 w; w.x = cvt_pk_bf16(v[0], v[1]); w.y = cvt_pk_bf16(v[2], v[3]); w.z = cvt_pk_bf16(v[4], v[5]); w.w = cvt_pk_bf16(v[6], v[7]); *(u32x4*)p = w; }
__device__ __forceinline__ void ld8(const bf16_t* p, float* v) { const u32x4 w = *(const u32x4*)p; v[0] = __builtin_bit_cast(float, w.x << 16); v[1] = __builtin_bit_cast(float, w.x & 0xffff0000u);
    v[2] = __builtin_bit_cast(float, w.y << 16); v[3] = __builtin_bit_cast(float, w.y & 0xffff0000u); v[4] = __builtin_bit_cast(float, w.z << 16); v[5] = __builtin_bit_cast(float, w.z & 0xffff0000u);
    v[6] = __builtin_bit_cast(float, w.w << 16); v[7] = __builtin_bit_cast(float, w.w & 0xffff0000u); }
#define EPI_ROWS(ai, m) _Pragma("unroll") for (int ai = 0; ai < 2; ++ai) _Pragma("unroll") for (int m = 0; m < 4; ++m)
#define EPI_GET(v, ai, m) asm volatile("" ::: "memory"); float v[2][8]; _Pragma("unroll") for (int bj = 0; bj < 2; ++bj) _Pragma("unroll") for (int n = 0; n < 2; ++n) _Pragma("unroll") for (int j = 0; j < 4; ++j) v[bj][4 * n + j] = acc[ai][bj][m][n][j];
constexpr float EPSN = 1e-6f;
constexpr float C2ATT = 0.125f * 1.4426950408889634f;
constexpr float IDXSC = 0.0625f;

struct EpiProj {
    static constexpr bool PERM = true, AFTER_DRAIN = false, MID = false;
    bf16_t *QLAT, *AK, *AV, *KI, *BQ, *GA; float *QLSS, *WIDX; const float *gk, *gki;
    __device__ __forceinline__ void operator()(const f32x4 (&acc)[2][2][4][2], const Unit& u, int wr, int wc, int fr_, int fq_) const { int fr = fr_, fq = fq_; asm volatile("" : "+v"(fr), "+v"(fq));
        const int pn = u.pn, rowb = u.pm * BM + wr * 64 + fr, cw = 64 * wc + 8 * fq;
        if (pn == 0) {
            EPI_ROWS(ai, m) { EPI_GET(v, ai, m) const int row = rowb + ai * HALF + m * 16; float ss = 0.f;
#pragma unroll
                for (int bj = 0; bj < 2; ++bj) { _Pragma("unroll") for (int j = 0; j < 8; ++j) ss += v[bj][j] * v[bj][j]; st8(QLAT + (size_t)row * 256 + cw + 32 * bj, v[bj]); }
                ss += __shfl_xor(ss, 16); ss += __shfl_xor(ss, 32); if (fq == 0) QLSS[row * 4 + wc] = ss; }
        } else if (pn <= 2 || pn == 5) {
            if (pn == 5 && wc != 0) { if (wc == 1 && fq == 0) { EPI_ROWS(ai, m) { const int row = rowb + ai * HALF + m * 16; *(f32x4*)(WIDX + row * 4) = acc[ai][0][m][0]; } } return; }
            const float* g = (pn == 5) ? gki : gk; float gv[2][8];
#pragma unroll
            for (int bj = 0; bj < 2; ++bj) { _Pragma("unroll") for (int j = 0; j < 8; ++j) gv[bj][j] = g[32 * bj + 8 * fq + j]; }
            bf16_t* O = (pn == 5) ? KI : AK; const int ld = (pn == 5) ? 64 : 512, c0 = (pn == 5) ? 8 * fq : (pn - 1) * 256 + cw;
            EPI_ROWS(ai, m) { EPI_GET(v, ai, m) const int row = rowb + ai * HALF + m * 16; float ss = 0.f;
#pragma unroll
                for (int bj = 0; bj < 2; ++bj) { _Pragma("unroll") for (int j = 0; j < 8; ++j) ss += v[bj][j] * v[bj][j]; }
                ss += __shfl_xor(ss, 16); ss += __shfl_xor(ss, 32); const float r = __builtin_amdgcn_rsqf(ss * (1.0f / 64.0f) + EPSN);
#pragma unroll
                for (int bj = 0; bj < 2; ++bj) { _Pragma("unroll") for (int j = 0; j < 8; ++j) v[bj][j] *= r * gv[bj][j];
                    if (pn == 5) st8(KI + (size_t)(row >> 5) * 2048 + (2 * bj + (fq >> 1)) * 512 + (fq & 1) * 256 + (row & 31) * 8, v[bj]);
                    else st8(O + (size_t)row * ld + c0 + 32 * bj, v[bj]); } }
        } else {
            bf16_t* O; int ld, c0, act;
            if (pn <= 4) { O = AV; ld = 512; c0 = (pn - 3) * 256; act = 0; }
            else if (pn <= 13) { const int k = (pn - 6) >> 1; O = BQ + (size_t)k * ((size_t)16384 * 512); ld = 512; c0 = ((pn - 6) & 1) * 256; act = (k == 0 || k == 3) ? 1 : 0; }
            else { const int k = (pn - 14) >> 2; O = GA + (size_t)k * ((size_t)16384 * 1024); ld = 1024; c0 = ((pn - 14) & 3) * 256; act = 2; }
            EPI_ROWS(ai, m) { EPI_GET(v, ai, m) const int row = rowb + ai * HALF + m * 16;
#pragma unroll
                for (int bj = 0; bj < 2; ++bj) { if (act) { _Pragma("unroll") for (int j = 0; j < 8; ++j) { const float s = sigm(v[bj][j]); v[bj][j] = (act == 1) ? v[bj][j] * s : s; } }
                    st8(O + (size_t)row * ld + c0 + cw + 32 * bj, v[bj]); } }
        }
    }
};
struct EpiQ {
    static constexpr bool PERM = true, AFTER_DRAIN = false, MID = false;
    bf16_t *AQ, *QI; float* QN; const float *QLSS, *WIDX, *gq;
    __device__ __forceinline__ void operator()(const f32x4 (&acc)[2][2][4][2], const Unit& u, int wr, int wc, int fr_, int fq_) const { int fr = fr_, fq = fq_; asm volatile("" : "+v"(fr), "+v"(fq));
        const int pn = u.pn, rowb = u.pm * BM + wr * 64 + fr, cw = 64 * wc + 8 * fq;
        float gv[2][8];
#pragma unroll
        for (int bj = 0; bj < 2; ++bj) { _Pragma("unroll") for (int j = 0; j < 8; ++j) gv[bj][j] = gq[32 * bj + 8 * fq + j]; }
        EPI_ROWS(ai, m) { EPI_GET(v, ai, m) const int row = rowb + ai * HALF + m * 16;
            const f32x4 q4 = *(const f32x4*)(QLSS + row * 4); const float s = __builtin_amdgcn_rsqf(((q4[0] + q4[1]) + (q4[2] + q4[3])) * (1.0f / 256.0f) + EPSN);
            float ss = 0.f;
#pragma unroll
            for (int bj = 0; bj < 2; ++bj) { _Pragma("unroll") for (int j = 0; j < 8; ++j) ss += v[bj][j] * v[bj][j]; }
            ss += __shfl_xor(ss, 16); ss += __shfl_xor(ss, 32);
            if (pn < 2) { const float f = s * __builtin_amdgcn_rsqf(s * s * ss * (1.0f / 64.0f) + EPSN) * C2ATT;
#pragma unroll
                for (int bj = 0; bj < 2; ++bj) { _Pragma("unroll") for (int j = 0; j < 8; ++j) v[bj][j] *= f * gv[bj][j]; st8(AQ + (size_t)row * 512 + pn * 256 + cw + 32 * bj, v[bj]); }
            } else { const float f = s * WIDX[row * 4 + wc] * IDXSC;
#pragma unroll
                for (int bj = 0; bj < 2; ++bj) { _Pragma("unroll") for (int j = 0; j < 8; ++j) v[bj][j] *= f; st8(QI + (size_t)row * 256 + cw + 32 * bj, v[bj]); }
                if (fq == 0) QN[row * 4 + wc] = sqrtf(ss) * fabsf(f); }
        }
    }
};
struct EpiMergeF {
    static constexpr bool PERM = true, AFTER_DRAIN = false, MID = true;
    const bf16_t* GA; bf16_t* T;
    __device__ __forceinline__ void mid(f32x4 (&acc)[2][2][4][2], const Unit& u, int wr, int wc, int fr_, int fq_) const { int fr = fr_, fq = fq_; asm volatile("" : "+v"(fr), "+v"(fq));
        const int rowb = u.pm * BM + wr * 64 + fr, c0 = u.pn * BM + 64 * wc + 8 * fq; const bf16_t* GB = GA + (size_t)16384 * 1024;
        EPI_ROWS(ai, m) { asm volatile("" ::: "memory"); const int row = rowb + ai * HALF + m * 16;
#pragma unroll
            for (int bj = 0; bj < 2; ++bj) { const size_t off = (size_t)row * 1024 + c0 + 32 * bj; float ga[8], gb[8]; ld8(GA + off, ga); ld8(GB + off, gb);
#pragma unroll
                for (int n = 0; n < 2; ++n) { _Pragma("unroll") for (int j = 0; j < 4; ++j) acc[ai][bj][m][n][j] *= ga[4 * n + j] * __builtin_amdgcn_rcpf(gb[4 * n + j]); } } }
    }
    __device__ __forceinline__ void operator()(const f32x4 (&acc)[2][2][4][2], const Unit& u, int wr, int wc, int fr_, int fq_) const { int fr = fr_, fq = fq_; asm volatile("" : "+v"(fr), "+v"(fq));
        const int rowb = u.pm * BM + wr * 64 + fr, c0 = u.pn * BM + 64 * wc + 8 * fq; const bf16_t* GB = GA + (size_t)16384 * 1024;
        EPI_ROWS(ai, m) { EPI_GET(v, ai, m) const int row = rowb + ai * HALF + m * 16;
#pragma unroll
            for (int bj = 0; bj < 2; ++bj) { const size_t off = (size_t)row * 1024 + c0 + 32 * bj; float g[8]; ld8(GB + off, g);
                _Pragma("unroll") for (int j = 0; j < 8; ++j) v[bj][j] *= g[j];
                st8(T + off, v[bj]); } }
    }
};
struct EpiRes {
    static constexpr bool PERM = true, AFTER_DRAIN = false, MID = false;
    const float* base; float* out; const float* gate; const float* bias;
    __device__ __forceinline__ void operator()(const f32x4 (&acc)[2][2][4][2], const Unit& u, int wr, int wc, int fr_, int fq_) const { int fr = fr_, fq = fq_; asm volatile("" : "+v"(fr), "+v"(fq));
        const int rowb = u.pm * BM + wr * 64 + fr, c0 = u.pn * BM + 64 * wc + 8 * fq; const float* gp = gate + (u.pm >= 32 ? 6144 : 0);
        float gv[2][8], bv[2][8];
#pragma unroll
        for (int bj = 0; bj < 2; ++bj) { _Pragma("unroll") for (int j = 0; j < 8; ++j) { gv[bj][j] = gp[c0 + 32 * bj + j]; bv[bj][j] = bias ? bias[c0 + 32 * bj + j] : 0.f; } }
        EPI_ROWS(ai, m) { EPI_GET(v, ai, m) const int row = rowb + ai * HALF + m * 16;
#pragma unroll
            for (int bj = 0; bj < 2; ++bj) { const size_t off = (size_t)row * 1024 + c0 + 32 * bj; const f32x4 x0 = *(const f32x4*)(base + off), x1 = *(const f32x4*)(base + off + 4);
                f32x4 o0, o1;
#pragma unroll
                for (int j = 0; j < 4; ++j) { o0[j] = x0[j] + gv[bj][j] * (v[bj][j] + bv[bj][j]); o1[j] = x1[j] + gv[bj][4 + j] * (v[bj][4 + j] + bv[bj][4 + j]); }
                *(f32x4*)(out + off) = o0; *(f32x4*)(out + off + 4) = o1; } }
    }
};
struct EpiUp {
    static constexpr bool PERM = true, AFTER_DRAIN = false, MID = false;
    bf16_t* O; const float* bias;
    __device__ __forceinline__ void operator()(const f32x4 (&acc)[2][2][4][2], const Unit& u, int wr, int wc, int fr_, int fq_) const { int fr = fr_, fq = fq_; asm volatile("" : "+v"(fr), "+v"(fq));
        const int rowb = u.pm * BM + wr * 64 + fr, c0 = u.pn * BM + 64 * wc + 8 * fq;
        float bv[2][8];
#pragma unroll
        for (int bj = 0; bj < 2; ++bj) { _Pragma("unroll") for (int j = 0; j < 8; ++j) bv[bj][j] = bias[c0 + 32 * bj + j]; }
        EPI_ROWS(ai, m) { EPI_GET(v, ai, m) const int row = rowb + ai * HALF + m * 16;
#pragma unroll
            for (int bj = 0; bj < 2; ++bj) { _Pragma("unroll") for (int j = 0; j < 8; ++j) { const float t = fmaxf(v[bj][j] + bv[bj][j], 0.f); v[bj][j] = t * t; }
                st8(O + (size_t)row * 4096 + c0 + 32 * bj, v[bj]); } }
    }
};
template <class Epi, class Sched, bool ALIGN_EPI = false, bool SP2 = false>
__device__ __forceinline__ void gemm_phase(PG8_LAS unsigned char* lds, const Gemm g, const Sched& S, const Epi& E) {
    const int tid = threadIdx.x, wid = __builtin_amdgcn_readfirstlane(tid >> 6), lane = tid & 63, wr = wid >> 2, wc = wid & 3, fr = lane & 15, fq = lane >> 4;
    const int K = g.K, nt = K / BK;
    unsigned voffA[2], voffB[2];
#pragma unroll
    for (int i = 0; i < 2; ++i) { int R, C; stage_rc(tid * 16 + i * 8192, R, C); const int Rb = Epi::PERM ? ((R & ~31) + perm32(R & 31)) : R;
        voffA[i] = (unsigned)(R * K + C) * 2u; voffB[i] = (unsigned)(Rb * K + C) * 2u; }
    const size_t kstep = (size_t)(BK * 2);
    const size_t hstep = (size_t)HALF * K * 2;
    const size_t tstep = 2 * hstep;
    const unsigned ldsw = (unsigned)wid * 1024u;
    const int aoff = lds_byte(wr * 64 + fr, fq * 8), boff = lds_byte(wc * 32 + fr, fq * 8);
#define PG8_SA(b, h) (((b) * 2 + (h)) * HTB)
#define PG8_SB(b, h) ((4 + (b) * 2 + (h)) * HTB)
#define PG8_STAGE(bufoff, gbase, voff) do { _Pragma("unroll") for (int _i = 0; _i < 2; ++_i) \
        __builtin_amdgcn_global_load_lds((const unsigned*)((const char*)(gbase) + (voff)[_i]), (PG8_LAS unsigned*)(lds + (bufoff) + ldsw + _i * 8192), 16, 0, 0); } while (0)
#define PG8_LDA(dst, b, h) do { _Pragma("unroll") for (int m = 0; m < 4; ++m) _Pragma("unroll") for (int k = 0; k < 2; ++k) dst[m][k] = *(const PG8_LAS bf16x8*)(lds + PG8_SA(b, h) + aoff + m * 2048 + k * 1024); } while (0)
#define PG8_LDB(dst, b, h) do { _Pragma("unroll") for (int n = 0; n < 2; ++n) _Pragma("unroll") for (int k = 0; k < 2; ++k) dst[n][k] = *(const PG8_LAS bf16x8*)(lds + PG8_SB(b, h) + boff + n * 2048 + k * 1024); } while (0)
#define PG8_MMA(ai, bj, At, Bt) do { __builtin_amdgcn_s_setprio(1); _Pragma("unroll") for (int m = 0; m < 4; ++m) _Pragma("unroll") for (int n = 0; n < 2; ++n) _Pragma("unroll") for (int k = 0; k < 2; ++k) \
        acc[ai][bj][m][n] = __builtin_amdgcn_mfma_f32_16x16x32_bf16(Bt[n][k], At[m][k], acc[ai][bj][m][n], 0, 0, 0); __builtin_amdgcn_s_setprio(0); } while (0)
#define PG8_WAIT_V(n) asm volatile("s_waitcnt vmcnt(" #n ")" ::: "memory")
#define PG8_WAIT_L(n) asm volatile("s_waitcnt lgkmcnt(" #n ")" ::: "memory")
#define PG8_BAR __builtin_amdgcn_s_barrier()
#define PG8_SCHED __builtin_amdgcn_sched_barrier(0)
    Unit cur, nxt; int ui = 0;
    if (!S.next(0, cur)) return;
    f32x4 acc[2][2][4][2];
#pragma unroll
    for (int a = 0; a < 2; ++a)
#pragma unroll
        for (int b = 0; b < 2; ++b)
#pragma unroll
            for (int m = 0; m < 4; ++m)
#pragma unroll
                for (int n = 0; n < 2; ++n) acc[a][b][m][n] = (f32x4){0.f, 0.f, 0.f, 0.f};
    bf16x8 At[4][2], B0[2][2], B1[2][2];
    const char* cA = (const char*)g.A + (size_t)cur.pm * tstep; const char* cB = (const char*)g.Bt + (size_t)cur.pn * tstep;
    S.a_ready(cur);
    if constexpr (SP2) {
        PG8_STAGE(PG8_SB(0, 0), cB, voffB); PG8_STAGE(PG8_SB(0, 1), cB + hstep, voffB); PG8_STAGE(PG8_SA(0, 0), cA, voffA); PG8_STAGE(PG8_SA(0, 1), cA + hstep, voffA);
        if (wr == 1) PG8_BAR;
        PG8_WAIT_V(2); PG8_BAR;
        PG8_STAGE(PG8_SB(1, 0), cB + kstep, voffB); PG8_STAGE(PG8_SA(1, 0), cA + kstep, voffA); PG8_STAGE(PG8_SB(1, 1), cB + hstep + kstep, voffB);
        PG8_WAIT_V(6); PG8_BAR;
    } else {
        PG8_STAGE(PG8_SB(0, 0), cB, voffB); PG8_STAGE(PG8_SA(0, 0), cA, voffA); PG8_STAGE(PG8_SB(0, 1), cB + hstep, voffB); PG8_STAGE(PG8_SA(0, 1), cA + hstep, voffA);
        if (wr == 1) PG8_BAR;
        PG8_WAIT_V(4); PG8_BAR;
        PG8_STAGE(PG8_SB(1, 0), cB + kstep, voffB); PG8_STAGE(PG8_SA(1, 0), cA + kstep, voffA); PG8_STAGE(PG8_SB(1, 1), cB + hstep + kstep, voffB);
        PG8_WAIT_V(6); PG8_BAR;
    }
    for (;;) {
        const bool has_next = S.next(ui + 1, nxt);
        const char* nA = has_next ? (const char*)g.A + (size_t)nxt.pm * tstep : cA; const char* nB = has_next ? (const char*)g.Bt + (size_t)nxt.pn * tstep : cB;
        for (int t = 0; t < nt; t += 2) {
            if constexpr (Epi::MID) { if (t == nt / 2) E.mid(acc, cur, wr, wc, fr, fq); }
            const bool last = (t == nt - 2);
            const char* a1 = cA + (size_t)(t + 1) * kstep;
            const char* a2 = last ? nA : cA + (size_t)(t + 2) * kstep; const char* b2 = last ? nB : cB + (size_t)(t + 2) * kstep;
            const char* a3 = a2 + kstep; const char* b3 = b2 + kstep;
            if (last && has_next) S.a_ready(nxt);
            if constexpr (SP2) {
            PG8_LDB(B0, 0, 0); PG8_LDB(B1, 0, 1); PG8_SCHED; PG8_LDA(At, 0, 0); PG8_STAGE(PG8_SA(1, 1), a1 + hstep, voffA);
            PG8_WAIT_V(8); PG8_WAIT_L(0); PG8_BAR; PG8_MMA(0, 0, At, B0); PG8_MMA(0, 1, At, B1); PG8_BAR; PG8_SCHED;
            PG8_LDA(At, 0, 1); PG8_STAGE(PG8_SB(0, 0), b2, voffB); PG8_STAGE(PG8_SB(0, 1), b2 + hstep, voffB); PG8_STAGE(PG8_SA(0, 0), a2, voffA);
            PG8_WAIT_V(8); PG8_WAIT_L(0); PG8_BAR; PG8_MMA(1, 0, At, B0); PG8_MMA(1, 1, At, B1); PG8_BAR; PG8_SCHED;
            PG8_LDB(B0, 1, 0); PG8_LDB(B1, 1, 1); PG8_SCHED; PG8_LDA(At, 1, 0); PG8_STAGE(PG8_SA(0, 1), a2 + hstep, voffA);
            PG8_WAIT_V(8); PG8_WAIT_L(0); PG8_BAR; PG8_MMA(0, 0, At, B0); PG8_MMA(0, 1, At, B1); PG8_BAR; PG8_SCHED;
            PG8_LDA(At, 1, 1); PG8_STAGE(PG8_SB(1, 0), b3, voffB); PG8_STAGE(PG8_SB(1, 1), b3 + hstep, voffB); PG8_STAGE(PG8_SA(1, 0), a3, voffA);
            PG8_WAIT_V(8); PG8_WAIT_L(0); PG8_BAR; PG8_MMA(1, 0, At, B0); PG8_MMA(1, 1, At, B1); PG8_BAR; PG8_SCHED;
            } else {
            PG8_LDB(B0, 0, 0); PG8_SCHED; PG8_LDA(At, 0, 0); PG8_STAGE(PG8_SA(1, 1), a1 + hstep, voffA);
            PG8_WAIT_L(8); PG8_BAR; PG8_WAIT_L(0); PG8_MMA(0, 0, At, B0); PG8_BAR; PG8_SCHED;
            PG8_LDB(B1, 0, 1); PG8_STAGE(PG8_SB(0, 0), b2, voffB);
            PG8_BAR; PG8_WAIT_L(0); PG8_MMA(0, 1, At, B1); PG8_BAR;
            PG8_LDA(At, 0, 1); PG8_STAGE(PG8_SA(0, 0), a2, voffA);
            PG8_BAR; PG8_WAIT_L(0); PG8_MMA(1, 0, At, B0); PG8_BAR; PG8_SCHED;
            PG8_STAGE(PG8_SB(0, 1), b2 + hstep, voffB);
            PG8_WAIT_V(6); PG8_BAR; PG8_MMA(1, 1, At, B1); PG8_BAR;
            PG8_LDB(B0, 1, 0); PG8_SCHED; PG8_LDA(At, 1, 0); PG8_STAGE(PG8_SA(0, 1), a2 + hstep, voffA);
            PG8_WAIT_L(8); PG8_BAR; PG8_WAIT_L(0); PG8_MMA(0, 0, At, B0); PG8_BAR; PG8_SCHED;
            PG8_LDB(B1, 1, 1); PG8_STAGE(PG8_SB(1, 0), b3, voffB);
            PG8_BAR; PG8_WAIT_L(0); PG8_MMA(0, 1, At, B1); PG8_BAR;
            PG8_LDA(At, 1, 1); PG8_STAGE(PG8_SA(1, 0), a3, voffA);
            PG8_BAR; PG8_WAIT_L(0); PG8_MMA(1, 0, At, B0); PG8_BAR; PG8_SCHED;
            PG8_STAGE(PG8_SB(1, 1), b3 + hstep, voffB);
            PG8_WAIT_V(6); PG8_BAR; PG8_MMA(1, 1, At, B1); PG8_BAR;
            }
        }
        if constexpr (ALIGN_EPI) { if (wr == 0) PG8_BAR; }
        if constexpr (!Epi::AFTER_DRAIN) { E(acc, cur, wr, wc, fr, fq); S.done(cur); }
        if (!has_next) break;
#pragma unroll
        for (int a = 0; a < 2; ++a)
#pragma unroll
            for (int b = 0; b < 2; ++b)
#pragma unroll
                for (int m = 0; m < 4; ++m)
#pragma unroll
                    for (int n = 0; n < 2; ++n) acc[a][b][m][n] = (f32x4){0.f, 0.f, 0.f, 0.f};
        cur = nxt; cA = nA; cB = nB; ++ui;
        if constexpr (ALIGN_EPI) { if (wr == 1) PG8_BAR; }
    }
    PG8_WAIT_V(0);
    if constexpr (!ALIGN_EPI) { if (wr == 0) PG8_BAR; }
    PG8_BAR;
    if constexpr (Epi::AFTER_DRAIN) { E.fused(acc, cur, wr, wc, fr, fq, lds, wid, lane); S.done(cur); }
#undef PG8_SA
#undef PG8_SB
#undef PG8_STAGE
#undef PG8_LDA
#undef PG8_LDB
#undef PG8_MMA
#undef PG8_WAIT_V
#undef PG8_WAIT_L
#undef PG8_BAR
#undef PG8_SCHED
}
}
namespace attn_body {
using bf16=__hip_bfloat16;
using bf16x8=__attribute__((ext_vector_type(8)))short;
using s16x4=__attribute__((ext_vector_type(4)))short;
using f32x16=__attribute__((ext_vector_type(16)))float;
using u32x4=__attribute__((ext_vector_type(4)))unsigned;
constexpr int BATCH=2,NHEAD=8,SEQ=8192,D=64,DM=NHEAD*D,DMO=1024;
constexpr int NW=8,QBLK=32,QB=QBLK*NW,KVBLK=64,NQB=SEQ/QB;
__device__ __forceinline__ int crow(int r,int hi){return (r&3)+8*(r>>2)+4*hi;}
#define SBAR() __builtin_amdgcn_sched_barrier(0)
constexpr int NSLOT=3, SLOTB=8192;
constexpr int LDS_K=0, LDS_V=NSLOT*SLOTB, LDS_WS=2*NSLOT*SLOTB, LDS_OST=LDS_WS+NW*64*4, LDS_MR=LDS_OST+NW*4096, LDS_BYTES=LDS_MR+NW*1024;
__device__ __forceinline__ void glds16(const void*gsrc,unsigned lds_dst){unsigned keep;
  asm volatile("s_mov_b32 %0, m0\n\ts_mov_b32 m0, %2\n\ts_nop 0\n\tglobal_load_lds_dwordx4 %1, off\n\ts_mov_b32 m0, %0":"=&s"(keep):"v"(gsrc),"s"(lds_dst):"memory");}
__device__ __forceinline__ void glds4(const void*gsrc,unsigned lds_dst){unsigned keep;
  asm volatile("s_mov_b32 %0, m0\n\ts_mov_b32 m0, %2\n\ts_nop 0\n\tglobal_load_lds_dword %1, off\n\ts_mov_b32 m0, %0":"=&s"(keep):"v"(gsrc),"s"(lds_dst):"memory");}
typedef float f32x2_t __attribute__((ext_vector_type(2))); typedef __bf16 bf16x2_t __attribute__((ext_vector_type(2)));
__device__ __forceinline__ unsigned cvtpk_s(float lo,float hi){f32x2_t v={lo,hi};bf16x2_t b=__builtin_convertvector(v,bf16x2_t);return __builtin_bit_cast(unsigned,b);}
#define WAIT_BAR(N) asm volatile("s_waitcnt vmcnt(" #N ") lgkmcnt(0)\n\ts_barrier":::"memory")
__device__ __forceinline__ float mexp(float v,unsigned W,int e){const float p=__builtin_amdgcn_exp2f(v);return __builtin_bit_cast(float,__builtin_bit_cast(unsigned,p)&(unsigned)(((int)(W<<e))>>31));}
__device__ __forceinline__ void qkt(f32x16&p0,f32x16&p1,const char*Kslot,const bf16x8*qr,const f32x16&negm,int r32,int hi){
  const char*kb=Kslot+hi*1024+r32*16;
  #pragma unroll
  for(int d0=0;d0<4;++d0){
    const bf16x8 b0=*reinterpret_cast<const bf16x8*>(kb+d0*2048);
    const bf16x8 b1=*reinterpret_cast<const bf16x8*>(kb+d0*2048+512);
    if(d0==0){p0=__builtin_amdgcn_mfma_f32_32x32x16_bf16(b0,qr[0],negm,0,0,0);p1=__builtin_amdgcn_mfma_f32_32x32x16_bf16(b1,qr[0],negm,0,0,0);}
    else{p0=__builtin_amdgcn_mfma_f32_32x32x16_bf16(b0,qr[d0],p0,0,0,0);p1=__builtin_amdgcn_mfma_f32_32x32x16_bf16(b1,qr[d0],p1,0,0,0);}}
}
typedef __attribute__((address_space(3))) const char* lds_cptr;
typedef short v4i16_t __attribute__((ext_vector_type(4)));
__device__ __forceinline__ void kload8(bf16x8*kf,lds_cptr kp){
  kf[0]=*(const __attribute__((address_space(3))) bf16x8*)(kp);      kf[1]=*(const __attribute__((address_space(3))) bf16x8*)(kp+512);
  kf[2]=*(const __attribute__((address_space(3))) bf16x8*)(kp+2048); kf[3]=*(const __attribute__((address_space(3))) bf16x8*)(kp+2560);
  kf[4]=*(const __attribute__((address_space(3))) bf16x8*)(kp+4096); kf[5]=*(const __attribute__((address_space(3))) bf16x8*)(kp+4608);
  kf[6]=*(const __attribute__((address_space(3))) bf16x8*)(kp+6144); kf[7]=*(const __attribute__((address_space(3))) bf16x8*)(kp+6656);
}
__device__ __forceinline__ void kload2(bf16x8*kf,lds_cptr kp,int j){ kf[2*j]=*(const __attribute__((address_space(3))) bf16x8*)(kp+j*2048); kf[2*j+1]=*(const __attribute__((address_space(3))) bf16x8*)(kp+j*2048+512); }
__device__ __forceinline__ s16x4 vtr(lds_cptr p){ return __builtin_bit_cast(s16x4,__builtin_amdgcn_ds_read_tr16_b64_v4i16((__attribute__((address_space(3))) v4i16_t*)p)); }
__device__ __forceinline__ void pv(f32x16*o,int vb,bf16x8 pa0,bf16x8 pa1,bf16x8 pa2,bf16x8 pa3){
  #pragma unroll
  for(int d0=0;d0<2;++d0){s16x4 lo[4],hi[4];
    #pragma unroll
    for(int ks=0;ks<4;++ks){
      asm volatile("ds_read_b64_tr_b16 %0,%1 offset:%c2":"=&v"(lo[ks]):"v"(vb),"i"(d0*4096+ks*1024):"memory");
      asm volatile("ds_read_b64_tr_b16 %0,%1 offset:%c2":"=&v"(hi[ks]):"v"(vb),"i"(d0*4096+ks*1024+512):"memory");}
    asm volatile("s_waitcnt lgkmcnt(0)":::"memory");SBAR();
    #define PK(k) (bf16x8){lo[k][0],lo[k][1],lo[k][2],lo[k][3],hi[k][0],hi[k][1],hi[k][2],hi[k][3]}
    o[d0]=__builtin_amdgcn_mfma_f32_32x32x16_bf16(pa0,PK(0),o[d0],0,0,0);
    o[d0]=__builtin_amdgcn_mfma_f32_32x32x16_bf16(pa1,PK(1),o[d0],0,0,0);
    o[d0]=__builtin_amdgcn_mfma_f32_32x32x16_bf16(pa2,PK(2),o[d0],0,0,0);
    o[d0]=__builtin_amdgcn_mfma_f32_32x32x16_bf16(pa3,PK(3),o[d0],0,0,0);
    #undef PK
  }
}
#ifndef ATTN_STORE16
#define ATTN_STORE16(p,v) (*(u32x4*)(p)=(v))
#endif
__device__ __forceinline__ void attn_unit(int b,int h,int qb,const bf16*Q,const bf16*__restrict__ K,const bf16*__restrict__ V,bf16*O,const unsigned*MW,char*shm){
  const int tid=threadIdx.x,lane=tid&63,r32=lane&31,hi=lane>>5; const int wid=__builtin_amdgcn_readfirstlane(tid>>6);
  const long rowbase=(long)b*SEQ; const int q0=qb*QB;
  const bf16*Qw=Q+(rowbase+q0+wid*QBLK)*DM+h*D;
  const bf16*Kh=K+rowbase*DM+h*D,*Vh=V+rowbase*DM+h*D;
  const unsigned lds0=(unsigned)(uintptr_t)shm;
  float*wsf=(float*)(shm+LDS_WS)+wid*64;
  const bf16*ksrc=Kh+(long)lane*DM+wid*8;
  const bf16*vsrc=Vh+(long)(16*(wid&3)+(lane>>2))*DM+(wid>>2)*32+(lane&3)*8;
  const unsigned kdst=lds0+LDS_K+wid*1024, vdst=lds0+LDS_V+wid*1024, mdst=lds0+LDS_MR+wid*1024;
  const unsigned*msrc=MW+((size_t)b*16896+16*qb*(qb+1)+wid*(4*qb+4))*64+lane;
  #define DMA_K(t,slot) glds16(ksrc+(long)(t)*KVBLK*DM,(unsigned)__builtin_amdgcn_readfirstlane(kdst+(slot)))
  #define DMA_V(t,slot) glds16(vsrc+(long)(t)*KVBLK*DM,(unsigned)__builtin_amdgcn_readfirstlane(vdst+(slot)))
  #define DMA_M(t) glds4(msrc+(long)(t)*64,(unsigned)__builtin_amdgcn_readfirstlane(mdst+(((t)&3)<<8)))
  const int vb0=(int)(lds0+LDS_V)+((lane>>4)&1)*32+(lane&3)*8+(4*hi+((lane&15)>>2))*64;
  const char*Kbase=shm+LDS_K; bf16x8 kf[8];
  const lds_cptr shm3=(lds_cptr)shm; const lds_cptr kp0=shm3+LDS_K+hi*1024+r32*16; const lds_cptr vp0=shm3+LDS_V+((lane>>4)&1)*32+(lane&3)*8+(4*hi+((lane&15)>>2))*64;
  const __attribute__((address_space(3))) unsigned* mrd=(const __attribute__((address_space(3))) unsigned*)(shm3+LDS_MR+wid*1024)+lane;
  const int NT=(q0+QB)/KVBLK;
  DMA_M(0);DMA_K(0,0);DMA_V(0,0);DMA_K(1,SLOTB);
  bf16x8 qr[4];
  #pragma unroll
  for(int d0=0;d0<4;++d0)qr[d0]=*reinterpret_cast<const bf16x8*>(&Qw[(long)r32*DM+d0*16+hi*8]);
  float l_reg=0.f;f32x16 o[2];o[0]=f32x16{};o[1]=f32x16{};const f32x16 negm=f32x16{};
  f32x16 pA0,pA1,pB0,pB1;
  int sl_prev=0,sl_cur=0,sl_next=SLOTB;
  #define ROT() do{sl_prev=sl_cur;sl_cur=sl_next;sl_next=(sl_next==(NSLOT-1)*SLOTB)?0:sl_next+SLOTB;}while(0)
  DMA_K(2,2*SLOTB);DMA_M(1);
  WAIT_BAR(4);
  { const unsigned W0=mrd[0];
    qkt(pA0,pA1,Kbase,qr,negm,r32,hi);
    _Pragma("unroll") for(int r=0;r<16;++r){pA0[r]=mexp(pA0[r],W0,r);pA1[r]=mexp(pA1[r],W0,16+r);} }
  WAIT_BAR(0);
  DMA_K(3,0);DMA_V(1,SLOTB);DMA_M(2);
  ROT();
  kload8(kf,kp0+sl_cur);
  WAIT_BAR(3);
  s16x4 vlo[8],vhi[8]; u32x4 pw0,pw1,pw2,pw3;
  #define PKW(P,B) cvtpk_s(P[B],P[B+1])
  #define PAF(k) __builtin_bit_cast(bf16x8,pw##k)
  #define VFR(i) (bf16x8){vlo[i][0],vlo[i][1],vlo[i][2],vlo[i][3],vhi[i][0],vhi[i][1],vhi[i][2],vhi[i][3]}
  #define PIN(x) asm volatile("":"+v"(x))
  #define GAPA(MF,A0,A1,A2,A3,W0,W1,PW) do{ MF; sacc+=A0; sacc+=A1; sacc+=A2; sacc+=A3; PIN(sacc); W0; W1; PIN(PW); SBAR(); }while(0)
  #define GAPB(MF,X,B,E0) do{ MF; X[B]=mexp(X[B],Wm,E0+B); X[B+1]=mexp(X[B+1],Wm,E0+B+1); X[B+2]=mexp(X[B+2],Wm,E0+B+2); X[B+3]=mexp(X[B+3],Wm,E0+B+3); PIN(X); SBAR(); }while(0)
  #define VRD(i) do{ vlo[i]=vtr(vp_+(((i)>>2)*4096+((i)&3)*1024)); vhi[i]=vtr(vp_+(((i)>>2)*4096+((i)&3)*1024+512)); }while(0)
  #define KRD(G,j) do{ if(G){ kload2(kf,kp0+sl_next,j); SBAR(); } }while(0)
  #define STEP(C0,C1,P0,P1,t,GK,GV,GM,GL) do{ SBAR(); \
    const lds_cptr vp_=vp0+sl_prev; const unsigned Wm=mrd[((t)&3)<<6]; \
    VRD(0); SBAR(); float sacc=(P0[0]+P0[1]); \
    GAPA(C0=__builtin_amdgcn_mfma_f32_32x32x16_bf16(kf[0],qr[0],negm,0,0,0), P0[2],P0[3],P0[4],P0[5],     pw0[0]=PKW(P0,0), pw0[1]=PKW(P0,2), pw0); \
    VRD(4); SBAR(); GAPA(C1=__builtin_amdgcn_mfma_f32_32x32x16_bf16(kf[1],qr[0],negm,0,0,0), P0[6],P0[7],P0[8],P0[9],     pw0[2]=PKW(P0,4), pw0[3]=PKW(P0,6), pw0); \
    VRD(1); SBAR(); GAPA(C0=__builtin_amdgcn_mfma_f32_32x32x16_bf16(kf[2],qr[1],C0,0,0,0),   P0[10],P0[11],P0[12],P0[13], pw1[0]=PKW(P0,8), pw1[1]=PKW(P0,10), pw1); \
    VRD(5); SBAR(); GAPA(C1=__builtin_amdgcn_mfma_f32_32x32x16_bf16(kf[3],qr[1],C1,0,0,0),   P0[14],P0[15],P1[0],P1[1],   pw1[2]=PKW(P0,12),pw1[3]=PKW(P0,14), pw1); \
    VRD(2); SBAR(); GAPA(C0=__builtin_amdgcn_mfma_f32_32x32x16_bf16(kf[4],qr[2],C0,0,0,0),   P1[2],P1[3],P1[4],P1[5],     pw2[0]=PKW(P1,0), pw2[1]=PKW(P1,2), pw2); \
    VRD(6); SBAR(); GAPA(C1=__builtin_amdgcn_mfma_f32_32x32x16_bf16(kf[5],qr[2],C1,0,0,0),   P1[6],P1[7],P1[8],P1[9],     pw2[2]=PKW(P1,4), pw2[3]=PKW(P1,6), pw2); \
    VRD(3); SBAR(); GAPA(C0=__builtin_amdgcn_mfma_f32_32x32x16_bf16(kf[6],qr[3],C0,0,0,0),   P1[10],P1[11],P1[12],P1[13], pw3[0]=PKW(P1,8), pw3[1]=PKW(P1,10), pw3); \
    VRD(7); SBAR(); GAPA(C1=__builtin_amdgcn_mfma_f32_32x32x16_bf16(kf[7],qr[3],C1,0,0,0),   P1[14],P1[15],0.f,0.f,       pw3[2]=PKW(P1,12),pw3[3]=PKW(P1,14), pw3); \
    l_reg+=sacc; \
    if(GK){DMA_K((t)+3,sl_cur);} if(GV){DMA_V((t)+1,sl_next);} if(GM){DMA_M((t)+2);} \
    SBAR(); \
    GAPB(o[0]=__builtin_amdgcn_mfma_f32_32x32x16_bf16(PAF(0),VFR(0),o[0],0,0,0), C0,0,0); \
    GAPB(o[1]=__builtin_amdgcn_mfma_f32_32x32x16_bf16(PAF(0),VFR(4),o[1],0,0,0), C0,4,0); \
    KRD(GL,0); GAPB(o[0]=__builtin_amdgcn_mfma_f32_32x32x16_bf16(PAF(1),VFR(1),o[0],0,0,0), C0,8,0); \
    KRD(GL,1); GAPB(o[1]=__builtin_amdgcn_mfma_f32_32x32x16_bf16(PAF(1),VFR(5),o[1],0,0,0), C0,12,0); \
    KRD(GL,2); GAPB(o[0]=__builtin_amdgcn_mfma_f32_32x32x16_bf16(PAF(2),VFR(2),o[0],0,0,0), C1,0,16); \
    KRD(GL,3); GAPB(o[1]=__builtin_amdgcn_mfma_f32_32x32x16_bf16(PAF(2),VFR(6),o[1],0,0,0), C1,4,16); \
    GAPB(o[0]=__builtin_amdgcn_mfma_f32_32x32x16_bf16(PAF(3),VFR(3),o[0],0,0,0), C1,8,16); \
    GAPB(o[1]=__builtin_amdgcn_mfma_f32_32x32x16_bf16(PAF(3),VFR(7),o[1],0,0,0), C1,12,16); \
    }while(0)
  int t=1;
  for(;t+5<NT;t+=2){
    STEP(pB0,pB1,pA0,pA1,t,true,true,true,true);     WAIT_BAR(3); ROT();
    STEP(pA0,pA1,pB0,pB1,t+1,true,true,true,true);   WAIT_BAR(3); ROT();
  }
  #define ENDW(tt) do{ if((tt)+3<NT){WAIT_BAR(3);} else if((tt)+2<NT){WAIT_BAR(2);} else {WAIT_BAR(0);} }while(0)
  for(;t+1<NT;t+=2){
    STEP(pB0,pB1,pA0,pA1,t,(t+3<NT),(t+1<NT),(t+2<NT),(t+1<NT));       ENDW(t);   ROT();
    STEP(pA0,pA1,pB0,pB1,t+1,(t+4<NT),(t+2<NT),(t+3<NT),(t+2<NT));     ENDW(t+1); ROT();
  }
  STEP(pB0,pB1,pA0,pA1,NT-1,false,false,false,false);
  { float sacc=pB0[0]+pB0[1]; _Pragma("unroll") for(int r=2;r<16;++r)sacc+=pB0[r]; _Pragma("unroll") for(int r=0;r<16;++r)sacc+=pB1[r]; l_reg+=sacc;
    pw0=(u32x4){PKW(pB0,0),PKW(pB0,2),PKW(pB0,4),PKW(pB0,6)};pw1=(u32x4){PKW(pB0,8),PKW(pB0,10),PKW(pB0,12),PKW(pB0,14)};pw2=(u32x4){PKW(pB1,0),PKW(pB1,2),PKW(pB1,4),PKW(pB1,6)};pw3=(u32x4){PKW(pB1,8),PKW(pB1,10),PKW(pB1,12),PKW(pB1,14)};
    SBAR(); pv(o,vb0+sl_cur,PAF(0),PAF(1),PAF(2),PAF(3)); }
  #undef PKW
  #undef PAF
  #undef VFR
  #undef PIN
  #undef GAPA
  #undef GAPB
  #undef VRD
  #undef KRD
  #undef STEP
  #undef ENDW
  {auto rr=__builtin_amdgcn_permlane32_swap(__float_as_uint(l_reg),__float_as_uint(l_reg),false,false);l_reg=__uint_as_float(rr[0])+__uint_as_float(rr[1]);}
  if(hi==0)wsf[32+r32]=l_reg;asm volatile("s_waitcnt lgkmcnt(0)":::"memory");
  float rli[16];
  #pragma unroll
  for(int r=0;r<16;++r)rli[r]=__builtin_amdgcn_rcpf(wsf[32+crow(r,hi)]);
  bf16*Ow=O+(rowbase+q0+wid*QBLK)*DMO+h*D;
  { bf16*stg=(bf16*)(shm+LDS_OST)+wid*2048;
    #pragma unroll
    for(int r=0;r<16;++r){const int orow=crow(r,hi);
      #pragma unroll
      for(int d0=0;d0<2;++d0)stg[orow*64+d0*32+r32]=__float2bfloat16(o[d0][r]*rli[r]);}
    asm volatile("s_waitcnt lgkmcnt(0)":::"memory");
    #pragma unroll
    for(int i=0;i<4;++i){const int row=i*8+(lane>>3),ch=lane&7; const u32x4 v=*(const u32x4*)(stg+row*64+ch*8); ATTN_STORE16(Ow+(long)row*DMO+ch*8,v);} }
  asm volatile("s_waitcnt lgkmcnt(0)\n\ts_barrier":::"memory");
  #undef DMA_K
  #undef DMA_V
  #undef DMA_M
  #undef ROT
}
constexpr int ATTN_LDS_BYTES=LDS_BYTES;
#undef SBAR
#undef WAIT_BAR
}
constexpr int NWAVES = 8;
#ifndef MK_N_LAUNCHES
#define MK_N_LAUNCHES 1
#endif
constexpr int NPHASE = 13;
constexpr int N_LAUNCHES = MK_N_LAUNCHES;
constexpr int BATCH = 2, SEQL = 8192, DMOD = 1024, M = BATCH * SEQL, DFF = 4096, NPROJ = 5632, DIN = 5444;
constexpr size_t MiB = 1u << 20;
constexpr size_t WS_CTL = 0, CTL_ZERO_BYTES = 1 * MiB;
constexpr size_t WS_MODP = 1 * MiB;
constexpr size_t WS_MODV = 2 * MiB;
constexpr size_t WS_QLSS = 2 * MiB + 64 * 1024;
constexpr size_t WS_WIDX = WS_QLSS + 256 * 1024;
constexpr size_t WS_QN   = WS_WIDX + 256 * 1024;
constexpr size_t WS_HDEC = 3 * MiB;
constexpr size_t WS_WIN = 4 * MiB, WS_WQ = 15 * MiB, WS_WCAT = 16 * MiB, WS_WOUT = 18 * MiB;
constexpr size_t WS_H = 20 * MiB;
constexpr size_t WS_OAB = 20 * MiB;
constexpr size_t WS_MASK = 246 * MiB;
constexpr size_t WS_QLAT = 52 * MiB, WS_AK = 60 * MiB, WS_AV = 76 * MiB, WS_KI = 92 * MiB, WS_QI = 94 * MiB, WS_AQ = 102 * MiB;
constexpr size_t WS_BQ = 118 * MiB, WS_BF = 134 * MiB, WS_BI = 150 * MiB, WS_BG = 166 * MiB;
constexpr size_t WS_KV = 182 * MiB, WS_SP = 214 * MiB;
constexpr size_t WS_T = 182 * MiB;
constexpr size_t WS_W1 = 60 * MiB, WS_W2 = 68 * MiB;
constexpr size_t WS_HID = 76 * MiB;
constexpr size_t WS_END = 256 * MiB;
static_assert(WS_MASK + (size_t)2 * 16896 * 256 <= WS_END && WS_SP + 32 * MiB <= WS_MASK && WS_HID + 128 * MiB <= WS_END, "d_ws map");
constexpr int CW_BAR = 4096;
constexpr int RING_BYTES = 131072, SCR_BYTES = 155648, LDSCTL_OFF = SCR_BYTES, MISC_OFF = LDSCTL_OFF + 320, PAR_OFF = LDSCTL_OFF + 1024;
constexpr int LDS_BYTES = 163840;

#define GAS __attribute__((address_space(1)))
#define LAS __attribute__((address_space(3)))
typedef unsigned short bf16;
typedef unsigned v4u __attribute__((ext_vector_type(4)));
typedef float f32x4 __attribute__((ext_vector_type(4)));
typedef float f32x16 __attribute__((ext_vector_type(16)));
typedef short bf16x8 __attribute__((ext_vector_type(8)));
typedef GAS unsigned gu32;
#define RLX_AGENT __ATOMIC_RELAXED, __HIP_MEMORY_SCOPE_AGENT
#define LDS_WAIT() asm volatile("s_waitcnt lgkmcnt(0)" ::: "memory")
__device__ __forceinline__ unsigned f2bf(float f) { unsigned u = __builtin_bit_cast(unsigned, f); return (u + 0x7fffu + ((u >> 16) & 1u)) >> 16; }
__device__ __forceinline__ unsigned pk2(float lo, float hi) { return f2bf(lo) | (f2bf(hi) << 16); }
__device__ __forceinline__ float bf2f(bf16 b) { return __builtin_bit_cast(float, (unsigned)b << 16); }
__device__ __forceinline__ float sigmf(float x) { return 1.0f / (1.0f + __expf(-x)); }
#ifdef PROBE_A
#define STAMPB(i) do { if (threadIdx.x == 0) ((unsigned long long*)(F.ws + WS_CTL + 65536))[64 + blockIdx.x * 16 + (i)] = __builtin_amdgcn_s_memrealtime(); } while (0)
#else
#define STAMPB(i) do { } while (0)
#endif
#define XB_TMO      128
#define XB_XCNT(j)  (256  + 64 * (j))
#define XB_XSUB(j)  (1280 + 64 * (j))
#define XB_XGEN(j)  (2304 + 64 * (j))
#define XB_TOP      3328
#define XB_TOPGEN   3392
#define XCD_BAR_WORDS 3456
#define XB_SPIN_CAP (1u << 18)

__device__ __forceinline__ unsigned xb_ld(unsigned* p)              { return __hip_atomic_load(p, __ATOMIC_RELAXED, __HIP_MEMORY_SCOPE_AGENT); }
__device__ __forceinline__ unsigned xb_add(unsigned* p, unsigned v) { return __hip_atomic_fetch_add(p, v, __ATOMIC_RELAXED, __HIP_MEMORY_SCOPE_AGENT); }
__device__ __forceinline__ unsigned xb_xcc_id() { return (unsigned)__builtin_amdgcn_s_getreg((3 << 11) | 20) & 0xFu; }
#define XB_SPIN(cond, bar) do { unsigned _sp = 0; while (cond) { __builtin_amdgcn_s_sleep(1); \
    if ((++_sp & 255u) == 0u) { if (xb_ld(&(bar)[XB_TMO])) break; if (_sp > XB_SPIN_CAP) { atomicAdd(&(bar)[XB_TMO], 1u); break; } } } } while (0)

struct XcdBarrier {
    unsigned* bar; unsigned x;
    volatile LAS unsigned* st;
};

__device__ __forceinline__ XcdBarrier xcd_barrier_post(unsigned* bar, volatile LAS unsigned* st) {
    XcdBarrier b; b.bar = bar; b.x = xb_xcc_id(); b.st = st;
    if (threadIdx.x == 0) (void)xb_add(&bar[XB_XCNT(b.x)], 1u);
    return b;
}
__device__ __forceinline__ void xcd_barrier_complete(unsigned* bar, unsigned x, unsigned& nloc, unsigned& nx) {
    const unsigned G = gridDim.x * gridDim.y * gridDim.z;
    unsigned sum, cnt, mine, sp = 0u;
    for (;;) {
        sum = 0u; cnt = 0u; mine = 0u;
#pragma unroll
        for (unsigned j = 0; j < 16; ++j) { const unsigned c = xb_ld(&bar[XB_XCNT(j)]); sum += c; cnt += (c > 0u) ? 1u : 0u; mine = (j == x) ? c : mine; }
        if (sum == G) break;
        __builtin_amdgcn_s_sleep(1);
        if ((++sp & 255u) == 0u) { if (xb_ld(&bar[XB_TMO])) break; if (sp > XB_SPIN_CAP) { atomicAdd(&bar[XB_TMO], 1u); break; } }
    }
    nloc = mine > 0u ? mine : 1u; nx = cnt > 0u ? cnt : 1u;
}

__device__ __forceinline__ void xcd_barrier(const XcdBarrier& b) {
    asm volatile("s_waitcnt vmcnt(0)" ::: "memory");
    __syncthreads();
    if (threadIdx.x == 0) {
        unsigned* bar = b.bar;
        __builtin_amdgcn_s_waitcnt(0);
        unsigned nloc = b.st[0], nx = b.st[1];
        if (nloc == 0u) { xcd_barrier_complete(bar, b.x, nloc, nx); b.st[0] = nloc; b.st[1] = nx; }
        const unsigned old = xb_add(&bar[XB_XSUB(b.x)], 1u);
        const unsigned gen = old / nloc;
        if (old + 1u == (gen + 1u) * nloc) {
            __builtin_amdgcn_fence(__ATOMIC_RELEASE, "agent");
            asm volatile("s_waitcnt vmcnt(0)" ::: "memory");
            const unsigned og = xb_add(&bar[XB_TOP], 1u);
            const unsigned tg = og / nx;
            if (og + 1u == (tg + 1u) * nx) xb_add(&bar[XB_TOPGEN], 1u);
            else XB_SPIN(xb_ld(&bar[XB_TOPGEN]) == tg, bar);
            __builtin_amdgcn_fence(__ATOMIC_ACQUIRE, "agent");
            xb_add(&bar[XB_XGEN(b.x)], 1u);
            asm volatile("s_waitcnt vmcnt(0)" ::: "memory");
        } else {
            XB_SPIN(xb_ld(&bar[XB_XGEN(b.x)]) == gen, bar);
            __builtin_amdgcn_fence(__ATOMIC_ACQUIRE, "agent");
            asm volatile("s_waitcnt vmcnt(0)" ::: "memory");
        }
    }
    __syncthreads();
}

struct Frame {
    LAS unsigned char* lds; volatile LAS unsigned* MISC; gu32* ctl;
    int tid, lane, wave, vcu, G;
    const float* in[22]; float* out; unsigned char* ws;
};
enum { I_X = 0, I_C, I_WADA, I_BADA, I_N1G, I_WIN, I_QLG, I_WUQ, I_WUQI, I_QNG, I_KNG, I_KIG, I_LB, I_HOG, I_WPA, I_WPB, I_WOUT, I_N2G, I_W1, I_B1, I_W2, I_B2 };
__device__ __forceinline__ float wave_sum(float v) {
#pragma unroll
    for (int o = 1; o < 64; o <<= 1) v += __shfl_xor(v, o);
    return v;
}
__device__ __forceinline__ int prow(int n) { const int cl = n & 255; return (n & ~255) + 128 * ((cl >> 5) & 1) + 32 * (cl >> 6) + (cl & 31); }
__device__ __forceinline__ void tr_item(const float* W, int ldn, int sc0, int nvalid, int k0, const float* gsc, bf16* WT, int K, int drow0, LAS float* scr, int lane, int kd = 0) {
    const int kr = lane >> 3, c4 = (lane & 7) * 4; f32x4 v[8];
    const bool al = (((size_t)(W + sc0) & 15) == 0) && ((ldn & 3) == 0) && (nvalid == 32);
    if (al) {
#pragma unroll
        for (int i = 0; i < 8; ++i) v[i] = *(const GAS f32x4*)(W + (size_t)(k0 + 8 * i + kr) * ldn + sc0 + c4);
    } else {
#pragma unroll
        for (int i = 0; i < 8; ++i) { const float* p = W + (size_t)(k0 + 8 * i + kr) * ldn + sc0 + c4;
            v[i].x = (c4 + 0 < nvalid) ? p[0] : 0.f; v[i].y = (c4 + 1 < nvalid) ? p[1] : 0.f; v[i].z = (c4 + 2 < nvalid) ? p[2] : 0.f; v[i].w = (c4 + 3 < nvalid) ? p[3] : 0.f; }
    }
#pragma unroll
    for (int i = 0; i < 8; ++i) { const int kk = 8 * i + kr; const float g = gsc ? gsc[k0 + kk] : 1.0f; LAS float* d = scr + kk * 33 + c4; d[0] = v[i].x * g; d[1] = v[i].y * g; d[2] = v[i].z * g; d[3] = v[i].w * g; }
    LDS_WAIT(); asm volatile("" ::: "memory");
    const int c = lane & 7;
#pragma unroll
    for (int j = 0; j < 4; ++j) { const int n = (lane >> 3) + 8 * j; const LAS float* s = scr + (8 * c) * 33 + n;
        v4u o; o.x = pk2(s[0 * 33], s[1 * 33]); o.y = pk2(s[2 * 33], s[3 * 33]); o.z = pk2(s[4 * 33], s[5 * 33]); o.w = pk2(s[6 * 33], s[7 * 33]);
        *(GAS v4u*)(WT + (size_t)(drow0 + n) * K + kd + k0 + 8 * c) = o; }
    LDS_WAIT(); asm volatile("" ::: "memory");
}
__device__ __forceinline__ void tr_plain(const float* W, int K, int N, bf16* WT, int r, LAS float* scr, int lane) {
    const int nblk = N / 32, kb = r / nblk, nb = r % nblk; tr_item(W, N, 32 * nb, 32, 64 * kb, nullptr, WT, K, prow(32 * nb), scr, lane);
}
__device__ __forceinline__ void p0_prologue(Frame& F) {
    LAS float* scr = (LAS float*)(F.lds + F.wave * 16384);
    const int gw = F.vcu * NWAVES + F.wave, NGW = F.G * NWAVES, lane = F.lane;
    constexpr int I_IN = 16 * (NPROJ / 32), I_Q = 4 * 24, I_PA = 8 * 32, I_PB = 8 * 32, I_OUT = 16 * 32, I_GV = 96 * 8;
    constexpr int NITEMS = I_IN + I_Q + I_PA + I_PB + I_OUT + I_GV;
    bf16* WIN = (bf16*)(F.ws + WS_WIN); bf16* WQ = (bf16*)(F.ws + WS_WQ);
    for (int it = gw; it < NITEMS; it += NGW) {
        int r = it;
        if (r < I_IN) { const int nblk = NPROJ / 32, kb = r / nblk, nb = r % nblk, n0 = 32 * nb; int sc0, nv;
            if (n0 < 1280) { sc0 = n0; nv = 32; } else if (n0 < 1536) { sc0 = n0; nv = 1348 - n0; nv = nv < 0 ? 0 : (nv > 32 ? 32 : nv); if (nv == 0) sc0 = 0; } else { sc0 = n0 - 188; nv = 32; }
            tr_item(F.in[I_WIN], DIN, sc0, nv, 64 * kb, nullptr, WIN, 1024, prow(n0), scr, lane); continue; } r -= I_IN;
        if (r < I_Q) { const int kb = r / 24, nb = r % 24, n0 = 32 * nb;
            if (n0 < 512) tr_item(F.in[I_WUQ], 512, n0, 32, 64 * kb, F.in[I_QLG], WQ, 256, prow(n0), scr, lane);
            else tr_item(F.in[I_WUQI], 256, n0 - 512, 32, 64 * kb, F.in[I_QLG], WQ, 256, prow(n0), scr, lane);
            continue; } r -= I_Q;
        if (r < I_PA) { const int kb = r / 32, nb = r % 32; tr_item(F.in[I_WPA], 1024, 32 * nb, 32, 64 * kb, nullptr, (bf16*)(F.ws + WS_WCAT), 1024, prow(32 * nb), scr, lane, 0); continue; } r -= I_PA;
        if (r < I_PB) { const int kb = r / 32, nb = r % 32; tr_item(F.in[I_WPB], 1024, 32 * nb, 32, 64 * kb, nullptr, (bf16*)(F.ws + WS_WCAT), 1024, prow(32 * nb), scr, lane, 512); continue; } r -= I_PB;
        if (r < I_OUT) { tr_plain(F.in[I_WOUT], 1024, 1024, (bf16*)(F.ws + WS_WOUT), r, scr, lane); continue; } r -= I_OUT;
        {
            const int ng = r % 96, ks = r / 96, n = ng * 64 + lane; const float* c = F.in[I_C]; const float* w = F.in[I_WADA] + (size_t)(ks * 128) * 6144 + n;
            float a0 = 0.f, a1 = 0.f;
#pragma unroll 32
            for (int k = 0; k < 128; ++k) { const float wv = w[(size_t)k * 6144]; const float c0 = c[ks * 128 + k], c1 = c[1024 + ks * 128 + k];
                a0 += (c0 * sigmf(c0)) * wv; a1 += (c1 * sigmf(c1)) * wv; }
            float* mp = (float*)(F.ws + WS_MODP); mp[(size_t)(ks * 2 + 0) * 6144 + n] = a0; mp[(size_t)(ks * 2 + 1) * 6144 + n] = a1;
        }
    }
}
__device__ __forceinline__ float mod_val(Frame& F, int b, int j) {
    const float* mp = (const float*)(F.ws + WS_MODP); float s = F.in[I_BADA][j];
#pragma unroll
    for (int ks = 0; ks < 8; ++ks) s += mp[(size_t)(ks * 2 + b) * 6144 + j];
    return s;
}
template <int WHICH> __device__ __forceinline__ void norm_rows(Frame& F, const float* X, bf16* H) {
    LAS float* tab = (LAS float*)F.lds;
    const float* g = F.in[WHICH == 0 ? I_N1G : I_N2G]; const int shift_off = WHICH == 0 ? 0 : 3072, scale_off = WHICH == 0 ? 1024 : 4096;
    for (int i = F.tid; i < 2048; i += NWAVES * 64) { const int b = i >> 10, k = i & 1023; float sc, sh;
        if (WHICH == 0) { sc = mod_val(F, b, scale_off + k); sh = mod_val(F, b, shift_off + k); }
        else { const float* mv = (const float*)(F.ws + WS_MODV); sc = mv[b * 6144 + scale_off + k]; sh = mv[b * 6144 + shift_off + k]; }
        tab[i] = g[k] * (1.0f + sc); tab[2048 + i] = sh; }
    if (WHICH == 0) { float* mv = (float*)(F.ws + WS_MODV); for (int i = F.tid; i < 48; i += NWAVES * 64) { const int j = F.vcu * 48 + i; if (j < 12288) mv[j] = mod_val(F, j / 6144, j % 6144); } }
    __syncthreads();
    const int gw = F.vcu * NWAVES + F.wave, NGW = F.G * NWAVES;
    f32x4 vn[4];
    if (gw < M) { const GAS f32x4* xr = (const GAS f32x4*)(X + (size_t)gw * DMOD) + F.lane;
#pragma unroll
        for (int j = 0; j < 4; ++j) vn[j] = xr[64 * j]; }
    for (int m = gw; m < M; m += NGW) {
        const int b = m >> 13; f32x4 v[4]; float s = 0.f;
#pragma unroll
        for (int j = 0; j < 4; ++j) { v[j] = vn[j]; s += (v[j].x * v[j].x + v[j].y * v[j].y) + (v[j].z * v[j].z + v[j].w * v[j].w); }
        if (m + NGW < M) { const GAS f32x4* xr = (const GAS f32x4*)(X + (size_t)(m + NGW) * DMOD) + F.lane;
#pragma unroll
            for (int j = 0; j < 4; ++j) vn[j] = xr[64 * j]; }
        const float r = 1.0f / sqrtf(wave_sum(s) * (1.0f / DMOD) + 1e-6f);
        GAS unsigned long long* o8 = (GAS unsigned long long*)(H + (size_t)m * DMOD) + F.lane;
#pragma unroll
        for (int j = 0; j < 4; ++j) { const int k = 4 * F.lane + 256 * j; const LAS float* a = tab + b * 1024 + k; const LAS float* sh = tab + 2048 + b * 1024 + k;
            o8[64 * j] = (unsigned long long)pk2(v[j].x * r * a[0] + sh[0], v[j].y * r * a[1] + sh[1]) | ((unsigned long long)pk2(v[j].z * r * a[2] + sh[2], v[j].w * r * a[3] + sh[3]) << 32); }
    }
    __syncthreads();
}
__device__ __forceinline__ int crow(int r, int hi) { return (r & 3) + 8 * (r >> 2) + 4 * hi; }
__device__ __forceinline__ int mask_slot(int gi) { const int j = gi >> 3, i = gi & 7; return 16 * j * (j + 1) + i * (4 * j + 4); }
constexpr float QKMAXF = 4194303.0f;
struct TkLane { float lo[4], hi[4], sc, off; int qq; };
__device__ __forceinline__ unsigned bsel(unsigned m, unsigned x, unsigned y) { return (m & x) | (~m & y); }
__device__ __forceinline__ float sel16(const float (&u)[16], int r) {
    unsigned a[8], b4[4], c2[2]; const unsigned m0 = 0u - (unsigned)(r & 1), m1 = 0u - (unsigned)((r >> 1) & 1), m2 = 0u - (unsigned)((r >> 2) & 1), m3 = 0u - (unsigned)((r >> 3) & 1);
#pragma unroll
    for (int i = 0; i < 8; ++i) a[i] = bsel(m0, __builtin_bit_cast(unsigned, u[2 * i + 1]), __builtin_bit_cast(unsigned, u[2 * i]));
#pragma unroll
    for (int i = 0; i < 4; ++i) b4[i] = bsel(m1, a[2 * i + 1], a[2 * i]);
#pragma unroll
    for (int i = 0; i < 2; ++i) c2[i] = bsel(m2, b4[2 * i + 1], b4[2 * i]);
    return __builtin_bit_cast(float, bsel(m3, c2[1], c2[0]));
}
template <int MODE>
__device__ __forceinline__ void topk_pass(Frame& F, const bf16* KI, const bf16x8 (&qf)[4][4], const TkLane& L, int rowbase, int q0, int gi, unsigned* MW, int b) {
    const int lane = F.lane, r32 = lane & 31, hi = lane >> 5, wid = F.wave;
    LAS unsigned* hist = (LAS unsigned*)F.lds;
    LAS unsigned* MWL = (LAS unsigned*)(F.lds + 98304);
    LAS int* par = (LAS int*)(F.lds + PAR_OFF);
    const int ntile = (gi >> 1) + 1, qmax = q0 + 31;
    float hiF = 0.f, loF = 0.f;
    if (MODE == 1) { const int tb = par[r32];
        if (tb < 0) { hiF = -1.0f; loF = -1.0f; }
        else { hiF = __builtin_bit_cast(float, __builtin_bit_cast(unsigned, (float)((tb + 1) * 4096)) - 1u); loF = tb == 0 ? -1.0f : __builtin_bit_cast(float, __builtin_bit_cast(unsigned, (float)(tb * 4096)) - 1u); } }
    LAS unsigned char* hq = (LAS unsigned char*)(hist + r32 * 1024);
#define TK_LDK(dst, tl, sb) do { const bf16* kp_ = KI + (size_t)((rowbase >> 5) + (tl) * 2 + (sb)) * 2048 + hi * 256 + r32 * 8;     \
        _Pragma("unroll") for (int ks = 0; ks < 4; ++ks) dst[ks] = *(const bf16x8*)(kp_ + ks * 512); } while (0)
    bf16x8 k0f[4], k1f[4];
    if (wid < ntile) TK_LDK(k0f, wid, 0);
    for (int tile = wid; tile < ntile; tile += NWAVES) {
        unsigned W = 0;
#pragma unroll
        for (int sub = 0; sub < 2; ++sub) {
            const int key0 = tile * 64 + sub * 32;
            if (sub == 0) TK_LDK(k1f, tile, 1); else if (tile + NWAVES < ntile) TK_LDK(k0f, tile + NWAVES, 0);
            if (key0 > qmax) { W <<= 16; continue; }
            float u[16];
            { f32x16 acc[2];
#pragma unroll
              for (int h = 0; h < 2; ++h) { acc[h] = f32x16{};
#pragma unroll
                  for (int ks = 0; ks < 4; ++ks) acc[h] = __builtin_amdgcn_mfma_f32_32x32x16_bf16(sub == 0 ? k0f[ks] : k1f[ks], qf[h][ks], acc[h], 0, 0, 0); }
#pragma unroll
              for (int r = 0; r < 16; ++r) u[r] = __builtin_amdgcn_fmed3f(acc[0][r], L.lo[0], L.hi[0]) + __builtin_amdgcn_fmed3f(acc[1][r], L.lo[1], L.hi[1]);
#pragma unroll
              for (int h = 0; h < 2; ++h) { acc[h] = f32x16{};
#pragma unroll
                  for (int ks = 0; ks < 4; ++ks) acc[h] = __builtin_amdgcn_mfma_f32_32x32x16_bf16(sub == 0 ? k0f[ks] : k1f[ks], qf[2 + h][ks], acc[h], 0, 0, 0); }
#pragma unroll
              for (int r = 0; r < 16; ++r) { const float s = (u[r] + __builtin_amdgcn_fmed3f(acc[0][r], L.lo[2], L.hi[2])) + __builtin_amdgcn_fmed3f(acc[1][r], L.lo[3], L.hi[3]); u[r] = __builtin_fmaf(s, L.sc, L.off); } }
            if (MODE == 3) { continue; }
            if (MODE == 4) { _Pragma("unroll") for (int r = 0; r < 16; ++r) asm volatile("" :: "v"(u[r])); continue; }
            const bool diag = key0 + 31 > q0;
            const int kq = L.qq - key0 - 4 * hi;
            if (MODE == 0) {
                if (!diag) {
#pragma unroll
                    for (int r = 0; r < 16; ++r) { const unsigned qk = (unsigned)u[r]; __hip_atomic_fetch_add((LAS unsigned*)(hq + ((qk >> 10) & 0xFFCu)), 1u, __ATOMIC_RELAXED, __HIP_MEMORY_SCOPE_WORKGROUP); }
                } else {
#pragma unroll
                    for (int r = 0; r < 16; ++r) { const unsigned qk = (unsigned)u[r]; __hip_atomic_fetch_add((LAS unsigned*)(hq + ((qk >> 10) & 0xFFCu)), ((r & 3) + 8 * (r >> 2) <= kq) ? 1u : 0u, __ATOMIC_RELAXED, __HIP_MEMORY_SCOPE_WORKGROUP); }
                }
            } else {
                unsigned Wd = 0u, Wc = 0u;
#pragma unroll
                for (int r = 0; r < 16; ++r) { Wd = __builtin_amdgcn_alignbit(Wd, __builtin_bit_cast(unsigned, hiF - u[r]), 31); Wc = __builtin_amdgcn_alignbit(Wc, __builtin_bit_cast(unsigned, loF - u[r]), 31); }
                if (diag) { unsigned vm = 0u;
#pragma unroll
                    for (int r = 0; r < 16; ++r) vm = (vm << 1) | (((r & 3) + 8 * (r >> 2) <= kq) ? 1u : 0u);
                    Wd &= vm; Wc &= vm; }
                W = (W << 16) | Wd;
                unsigned cand = Wc & ~Wd;
                while (__ballot(cand != 0u)) {
                    if (cand != 0u) { const int p = 31 - __builtin_clz(cand), r = 15 - p; const unsigned qk = (unsigned)sel16(u, r);
                        const unsigned slot = __hip_atomic_fetch_add((LAS unsigned*)par + 64 + r32, 1u, __ATOMIC_RELAXED, __HIP_MEMORY_SCOPE_WORKGROUP);
                        if (slot < 768u) hist[r32 * 768 + slot] = ((qk & 4095u) << 13) | (unsigned)(8191 - (key0 + crow(r, hi)));
                        cand &= ~(1u << p); }
                }
            }
        }
        if (MODE == 1) MWL[tile * 64 + lane] = W;
    }
#undef TK_LDK
    if (MODE == 1) { const int tend = 4 * (gi >> 3) + 4; for (int tile = ntile + wid; tile < tend; tile += NWAVES) MW[((size_t)(b * 16896 + mask_slot(gi)) + tile) * 64 + lane] = 0u; }
}
__device__ __forceinline__ void topk_unit(Frame& F, int b, int gi, float kmax) {
    const int lane = F.lane, r32 = lane & 31, hi = lane >> 5, wid = F.wave, tid = F.tid;
    const int rowbase = b * SEQL, q0 = gi * 32;
    const bf16* KI = (const bf16*)(F.ws + WS_KI); const bf16* QI = (const bf16*)(F.ws + WS_QI); unsigned* MW = (unsigned*)(F.ws + WS_MASK);
    const float* WIDX = (const float*)(F.ws + WS_WIDX); const float* QN = (const float*)(F.ws + WS_QN);
    LAS unsigned* hist = (LAS unsigned*)F.lds; LAS int* par = (LAS int*)(F.lds + PAR_OFF);
    TkLane L; L.qq = q0 + r32; const int row = rowbase + L.qq;
    bf16x8 qf[4][4];
#pragma unroll
    for (int h = 0; h < 4; ++h) { _Pragma("unroll") for (int ks = 0; ks < 4; ++ks) qf[h][ks] = *(const bf16x8*)(QI + (size_t)row * 256 + h * 64 + ks * 16 + hi * 8); }
    { const f32x4 w4 = *(const f32x4*)(WIDX + row * 4), n4 = *(const f32x4*)(QN + row * 4); float hs = 0.f, ls = 0.f;
#pragma unroll
      for (int h = 0; h < 4; ++h) { const bool pos = w4[h] > 0.f; L.lo[h] = pos ? 0.f : -INFINITY; L.hi[h] = pos ? INFINITY : 0.f; const float bd = n4[h] * kmax; if (pos) hs += bd; else ls += bd; }
      float range = hs + ls; if (!(range > 1e-30f)) range = 1.0f; L.sc = QKMAXF / range; L.off = ls * L.sc; }
    { LAS v4u* hz = (LAS v4u*)hist; for (int i = tid; i < 8192; i += NWAVES * 64) hz[i] = (v4u){0u, 0u, 0u, 0u}; if (tid < 160) par[tid] = 0; }
    __syncthreads();
    topk_pass<0>(F, KI, qf, L, rowbase, q0, gi, MW, b);
    __syncthreads();
    for (int qi = 0; qi < 4; ++qi) { const int q = wid * 4 + qi; const LAS v4u* hqv = (const LAS v4u*)(hist + q * 1024 + lane * 16);
        unsigned w[16];
#pragma unroll
        for (int i = 0; i < 4; ++i) { const v4u t = hqv[i]; w[4 * i] = t.x; w[4 * i + 1] = t.y; w[4 * i + 2] = t.z; w[4 * i + 3] = t.w; }
        unsigned tot = 0;
#pragma unroll
        for (int i = 0; i < 16; ++i) tot += w[i];
        unsigned incl = tot;
#pragma unroll
        for (int o = 1; o < 64; o <<= 1) { const unsigned t = __shfl_down(incl, o); if (lane + o < 64) incl += t; }
        unsigned running = incl - tot;
        if (q0 + q + 1 <= 256) { if (lane == 0) { par[q] = -1; par[32 + q] = 0; } }
        else {
#pragma unroll
            for (int i = 15; i >= 0; --i) { const unsigned c = w[i];
                if (running < 256u && running + c >= 256u) { par[q] = lane * 16 + i; par[32 + q] = (int)running; } running += c; }
        }
    }
    __syncthreads();
    topk_pass<1>(F, KI, qf, L, rowbase, q0, gi, MW, b);
    __syncthreads();
    for (int qi = 0; qi < 4; ++qi) { const int q = wid * 4 + qi; const int tbq = par[q];
        if (tbq < 0) continue;
        int n = par[64 + q]; n = n > 768 ? 768 : n; const int rr = 256 - par[32 + q];
        unsigned T = 0; unsigned e[12];
        if (n <= 64) { e[0] = (lane < n) ? hist[q * 768 + lane] : 0u; const bool ok = lane < n;
            for (int bit = 24; bit >= 0; --bit) { const unsigned cand = T | (1u << bit); const int c = __builtin_popcountll(__ballot(ok && e[0] >= cand)); if (c >= rr) T = cand; }
        } else {
#pragma unroll
            for (int i = 0; i < 12; ++i) { const int j = i * 64 + lane; e[i] = (j < n) ? hist[q * 768 + j] : 0u; }
            for (int bit = 24; bit >= 0; --bit) { const unsigned cand = T | (1u << bit); int c = 0;
#pragma unroll
                for (int i = 0; i < 12; ++i) c += __builtin_popcountll(__ballot((i * 64 + lane < n) && e[i] >= cand));
                if (c >= rr) T = cand; } }
#pragma unroll
        for (int i = 0; i < 12; ++i) { if (i * 64 < n) { const int j = i * 64 + lane; const unsigned cmp = e[i];
                if (j < n && cmp >= T) { const int key = 8191 - (int)(cmp & 8191u), tile = key >> 6, k5 = key & 31, sub = (key >> 5) & 1, hh = (k5 >> 2) & 1, r = (k5 & 3) + 4 * (k5 >> 3);
                    __hip_atomic_fetch_or((LAS unsigned*)(F.lds + 98304) + tile * 64 + hh * 32 + q, 1u << (31 - (16 * sub + r)), __ATOMIC_RELAXED, __HIP_MEMORY_SCOPE_WORKGROUP); } } }
    }
    __syncthreads();
    { const int nch = ((gi >> 1) + 1) * 16; GAS v4u* dst = (GAS v4u*)(MW + (size_t)(b * 16896 + mask_slot(gi)) * 64); const LAS v4u* src = (const LAS v4u*)(F.lds + 98304);
      for (int i = tid; i < nch; i += NWAVES * 64) dst[i] = src[i]; }
    __syncthreads();
}
constexpr int HS = 272, HSE = 136;
constexpr int HG_TOT = 149504;
constexpr int H1_FR = 0, H1_IR = 17408, H1_VT = 34816, H1_KHT = 53248, H1_OUT = 71680;
constexpr int H3_QT = 0, H3_KT = 17408, H3_QH = 34816, H3_IR = 52224, H3_VT = 69632, H3_ST = 88064, H3_AM = 122880;
static_assert(H3_AM + 64 * 144 <= HG_TOT && HG_TOT + 4096 <= SCR_BYTES && H1_OUT + 128 * HS <= HG_TOT, "hgrn lds");
__device__ __forceinline__ void hg_ld_tile(const bf16* g, int tid, v4u (&r)[2]) {
#pragma unroll
    for (int i = 0; i < 2; ++i) { const int c = tid + 512 * i; r[i] = *(const GAS v4u*)(g + (size_t)(c >> 4) * 512 + (c & 15) * 8); } }
__device__ __forceinline__ void hg_st_tile(LAS unsigned char* d, int tid, const v4u (&r)[2]) {
#pragma unroll
    for (int i = 0; i < 2; ++i) { const int c = tid + 512 * i; *(LAS v4u*)(d + (c >> 4) * HS + (c & 15) * 16) = r[i]; } }
__device__ __forceinline__ unsigned hg_ld2(const LAS unsigned char* img, int t, int dp) { return *(const LAS unsigned*)(img + t * HS + dp * 4); }
__device__ __forceinline__ float lo16f(unsigned w) { return __builtin_bit_cast(float, w << 16); }
__device__ __forceinline__ float hi16f(unsigned w) { return __builtin_bit_cast(float, w & 0xffff0000u); }
__device__ __forceinline__ void hg_decay(Frame& F, const LAS unsigned char* FR, int h, float (&bl)[2][8], float (&kk)[2][8]) {
    const int dp = F.lane, tg = F.wave; const float* lbp = F.in[I_LB];
    const float lb0 = sigmf(lbp[h * 128 + 2 * dp] - lbp[512 + h * 128 + 2 * dp]), lb1 = sigmf(lbp[h * 128 + 2 * dp + 1] - lbp[512 + h * 128 + 2 * dp + 1]);
    float c0 = 0.f, c1 = 0.f;
#pragma unroll
    for (int i = 0; i < 8; ++i) { const unsigned w = hg_ld2(FR, 8 * tg + i, dp); const float s0 = sigmf(lo16f(w)), s1 = sigmf(hi16f(w));
        kk[0][i] = (1.0f - lb0) * (1.0f - s0); kk[1][i] = (1.0f - lb1) * (1.0f - s1);
        c0 += __logf(lb0 + (1.0f - lb0) * s0); c1 += __logf(lb1 + (1.0f - lb1) * s1); bl[0][i] = c0; bl[1][i] = c1; }
    typedef float f32x2 __attribute__((ext_vector_type(2)));
    *(LAS f32x2*)(F.lds + HG_TOT + (tg * 128 + 2 * dp) * 4) = (f32x2){c0, c1};
}
__device__ __forceinline__ void hg_decay_fix(Frame& F, float (&bl)[2][8], float (&bend)[2], float (&bmid)[2]) {
    const int dp = F.lane, tg = F.wave; typedef float f32x2 __attribute__((ext_vector_type(2)));
    float pre0 = 0.f, pre1 = 0.f, m0 = 0.f, m1 = 0.f, e0 = 0.f, e1 = 0.f;
#pragma unroll
    for (int g = 0; g < 8; ++g) { const f32x2 t = *(const LAS f32x2*)(F.lds + HG_TOT + (g * 128 + 2 * dp) * 4); if (g < tg) { pre0 += t.x; pre1 += t.y; } if (g < 4) { m0 += t.x; m1 += t.y; } e0 += t.x; e1 += t.y; }
#pragma unroll
    for (int i = 0; i < 8; ++i) { bl[0][i] += pre0; bl[1][i] += pre1; }
    bmid[0] = m0; bmid[1] = m1; bend[0] = e0; bend[1] = e1;
}
__device__ __forceinline__ void hg_vt(Frame& F, const LAS unsigned char* IR, LAS unsigned char* VT) {
    const int dp = F.lane, tg = F.wave; unsigned w[8];
#pragma unroll
    for (int i = 0; i < 8; ++i) w[i] = hg_ld2(IR, 8 * tg + i, dp);
    v4u a, b2;
    a.x = (w[0] & 0xffffu) | (w[1] << 16); a.y = (w[2] & 0xffffu) | (w[3] << 16); a.z = (w[4] & 0xffffu) | (w[5] << 16); a.w = (w[6] & 0xffffu) | (w[7] << 16);
    b2.x = (w[0] >> 16) | (w[1] & 0xffff0000u); b2.y = (w[2] >> 16) | (w[3] & 0xffff0000u); b2.z = (w[4] >> 16) | (w[5] & 0xffff0000u); b2.w = (w[6] >> 16) | (w[7] & 0xffff0000u);
    *(LAS v4u*)(VT + (2 * dp) * 144 + tg * 16) = a; *(LAS v4u*)(VT + (2 * dp + 1) * 144 + tg * 16) = b2;
}
#define HG_FRAG(base, row, stride, k) (*(const LAS bf16x8*)((base) + ((row) * (stride) + (k)) * 2))
__device__ __forceinline__ void hg_state_phase(Frame& F) {
    const int lane = F.lane, r32 = lane & 31, hi = lane >> 5, dp = F.lane, tg = F.wave, tid = F.tid;
    const bf16* BFp = (const bf16*)(F.ws + WS_BF); const bf16* BIp = (const bf16*)(F.ws + WS_BI);
    v4u rf[2], ri[2];
#define H1_PREF(item) do { const int bh_ = (item) >> 7, c_ = (item) & 127; const size_t ro_ = ((size_t)((bh_ >> 2) * SEQL + c_ * 64)) * 512 + (bh_ & 3) * 128; hg_ld_tile(BFp + ro_, tid, rf); hg_ld_tile(BIp + ro_, tid, ri); } while (0)
    LAS int* par = (LAS int*)(F.lds + PAR_OFF);
    if (tid == 0) { par[201] = (int)__hip_atomic_fetch_add(F.ctl + 2112, 1u, RLX_AGENT); par[202] = (int)__hip_atomic_fetch_add(F.ctl + 2112, 1u, RLX_AGENT); }
    __syncthreads();
    int item = par[201], nxt = par[202];
    __syncthreads();
    if (item < 1024) H1_PREF(item);
    for (; item < 1024;) {
        const int h = (item >> 7) & 3;
        unsigned t2 = 0u; if (tid == 0) t2 = __hip_atomic_fetch_add(F.ctl + 2112, 1u, RLX_AGENT);
        hg_st_tile(F.lds + H1_FR, tid, rf); hg_st_tile(F.lds + H1_IR, tid, ri);
        __syncthreads();
        if (nxt < 1024) H1_PREF(nxt);
        float bl[2][8], kk[2][8], bend[2], bmid[2]; hg_decay(F, F.lds + H1_FR, h, bl, kk);
        hg_vt(F, F.lds + H1_IR, F.lds + H1_VT);
        __syncthreads();
        hg_decay_fix(F, bl, bend, bmid);
#pragma unroll
        for (int ch = 0; ch < 2; ++ch) { float kv[8];
#pragma unroll
            for (int i = 0; i < 8; ++i) kv[i] = kk[ch][i] * __expf(bend[ch] - bl[ch][i]);
            v4u o; o.x = pk2(kv[0], kv[1]); o.y = pk2(kv[2], kv[3]); o.z = pk2(kv[4], kv[5]); o.w = pk2(kv[6], kv[7]);
            *(LAS v4u*)(F.lds + H1_KHT + (2 * dp + ch) * 144 + tg * 16) = o;
            if (tg == 0) ((float*)(F.ws + WS_HDEC))[item * 128 + 2 * dp + ch] = __expf(bend[ch]); }
        __syncthreads();
        { const LAS unsigned char* VTb = F.lds + H1_VT; const LAS unsigned char* KHb = F.lds + H1_KHT; LAS unsigned short* OUT = (LAS unsigned short*)(F.lds + H1_OUT); const int vi = F.wave >> 1;
#pragma unroll
          for (int jj = 0; jj < 2; ++jj) { const int dj = (F.wave & 1) * 2 + jj; f32x16 acc = f32x16{};
#pragma unroll
              for (int ks = 0; ks < 4; ++ks) acc = __builtin_amdgcn_mfma_f32_32x32x16_bf16(HG_FRAG(VTb, 32 * vi + r32, 72, 16 * ks + 8 * hi), HG_FRAG(KHb, 32 * dj + r32, 72, 16 * ks + 8 * hi), acc, 0, 0, 0);
#pragma unroll
              for (int r = 0; r < 16; ++r) OUT[(32 * vi + crow(r, hi)) * HSE + 32 * dj + r32] = (unsigned short)f2bf(acc[r]); } }
        __syncthreads();
        { bf16* KV = (bf16*)(F.ws + WS_KV) + (size_t)item * 16384; const LAS unsigned char* OUT = F.lds + H1_OUT;
#pragma unroll
          for (int i = 0; i < 4; ++i) { const int c = tid + 512 * i; *(GAS v4u*)(KV + (c >> 4) * 128 + (c & 15) * 8) = *(const LAS v4u*)(OUT + (c >> 4) * HS + (c & 15) * 16); } }
        if (tid == 0) par[201] = (int)t2;
        __syncthreads();
        item = nxt; nxt = par[201];
    }
#undef H1_PREF
    __syncthreads();
}
__device__ __forceinline__ void hg_scan(Frame& F) {
    const bf16* KV = (const bf16*)(F.ws + WS_KV); bf16* SP = (bf16*)(F.ws + WS_SP); const float* HD = (const float*)(F.ws + WS_HDEC);
    for (int e = F.vcu * (NWAVES * 64) + F.tid; e < 8 * 16384; e += F.G * NWAVES * 64) { const int bh = e >> 14, vd = e & 16383, d = vd & 127; float S = 0.f;
        for (int c0 = 0; c0 < 128; c0 += 16) { float kv[16], dc[16];
#pragma unroll
            for (int j = 0; j < 16; ++j) { const int item = bh * 128 + c0 + j; kv[j] = bf2f(KV[(size_t)item * 16384 + vd]); dc[j] = HD[item * 128 + d]; }
#pragma unroll
            for (int j = 0; j < 16; ++j) { const int item = bh * 128 + c0 + j; SP[(size_t)item * 16384 + vd] = (bf16)f2bf(S); S = dc[j] * S + kv[j]; } }
    }
}
__device__ __forceinline__ void hg_out_phase(Frame& F) {
    const int lane = F.lane, r32 = lane & 31, hi = lane >> 5, dp = F.lane, tg = F.wave, wid = F.wave, tid = F.tid;
    const bf16* BQp = (const bf16*)(F.ws + WS_BQ); const bf16* BFp = (const bf16*)(F.ws + WS_BF); const bf16* BIp = (const bf16*)(F.ws + WS_BI); const bf16* BGp = (const bf16*)(F.ws + WS_BG);
    const bf16* SPp = (const bf16*)(F.ws + WS_SP);
    v4u rq[2], rf[2], ri[2], rg[2], rs[4];
#define H3_PREF(item) do { const int bh_ = (item) >> 7, c_ = (item) & 127; const size_t ro_ = ((size_t)((bh_ >> 2) * SEQL + c_ * 64)) * 512 + (bh_ & 3) * 128; \
        hg_ld_tile(BQp + ro_, tid, rq); hg_ld_tile(BFp + ro_, tid, rf); hg_ld_tile(BIp + ro_, tid, ri); hg_ld_tile(BGp + ro_, tid, rg); \
        _Pragma("unroll") for (int i_ = 0; i_ < 4; ++i_) rs[i_] = *(const GAS v4u*)(SPp + (size_t)(item) * 16384 + (size_t)(tid + 512 * i_) * 8); } while (0)
    int item = F.vcu; if (item < 1024) H3_PREF(item);
    for (; item < 1024; item += F.G) {
        const int bh = item >> 7, c = item & 127, b = bh >> 2, h = bh & 3, rowc = b * SEQL + c * 64;
        hg_st_tile(F.lds + H3_QT, tid, rq); hg_st_tile(F.lds + H3_KT, tid, rf); hg_st_tile(F.lds + H3_IR, tid, ri);
#pragma unroll
        for (int i = 0; i < 4; ++i) { const int cc = tid + 512 * i; *(LAS v4u*)(F.lds + H3_ST + (cc >> 4) * HS + (cc & 15) * 16) = rs[i]; }
        const v4u rgc0 = rg[0], rgc1 = rg[1];
        __syncthreads();
        if (item + F.G < 1024) H3_PREF(item + F.G);
        float bl[2][8], kk[2][8], bend[2], bmid[2]; hg_decay(F, F.lds + H3_KT, h, bl, kk);
        hg_vt(F, F.lds + H3_IR, F.lds + H3_VT);
        __syncthreads();
        hg_decay_fix(F, bl, bend, bmid);
#pragma unroll
        for (int i = 0; i < 8; ++i) { const int t = 8 * tg + i; const unsigned qw = hg_ld2(F.lds + H3_QT, t, dp); const float q0 = lo16f(qw), q1 = hi16f(qw); const float e0 = bl[0][i] - bmid[0], e1 = bl[1][i] - bmid[1];
            *(LAS unsigned*)(F.lds + H3_QT + t * HS + dp * 4) = pk2(q0 * __expf(fminf(e0, 80.f)), q1 * __expf(fminf(e1, 80.f)));
            *(LAS unsigned*)(F.lds + H3_KT + t * HS + dp * 4) = pk2(kk[0][i] * __expf(fminf(-e0, 80.f)), kk[1][i] * __expf(fminf(-e1, 80.f)));
            *(LAS unsigned*)(F.lds + H3_QH + t * HS + dp * 4) = pk2(q0 * __expf(bl[0][i]), q1 * __expf(bl[1][i])); }
        __syncthreads();
        const LAS unsigned char* QTb = F.lds + H3_QT; const LAS unsigned char* KTb = F.lds + H3_KT; const LAS unsigned char* QHb = F.lds + H3_QH;
        const LAS unsigned char* VTb = F.lds + H3_VT; const LAS unsigned char* STb = F.lds + H3_ST; LAS unsigned char* AMb = F.lds + H3_AM;
        if (wid < 3) { const int ti = wid > 0 ? 1 : 0, sj = wid > 1 ? 1 : 0; f32x16 acc = f32x16{};
#pragma unroll
            for (int ks = 0; ks < 8; ++ks) acc = __builtin_amdgcn_mfma_f32_32x32x16_bf16(HG_FRAG(QTb, 32 * ti + r32, HSE, 16 * ks + 8 * hi), HG_FRAG(KTb, 32 * sj + r32, HSE, 16 * ks + 8 * hi), acc, 0, 0, 0);
            LAS unsigned short* AM = (LAS unsigned short*)AMb;
#pragma unroll
            for (int r = 0; r < 16; ++r) { const int t = 32 * ti + crow(r, hi), s = 32 * sj + r32; AM[t * 72 + s] = (unsigned short)f2bf(s <= t ? acc[r] : 0.f); } }
        __syncthreads();
        { const int ti = wid >> 2, vj = wid & 3; f32x16 o = f32x16{};
#pragma unroll
          for (int ks = 0; ks < 4; ++ks) if (ks < 2 * (ti + 1)) o = __builtin_amdgcn_mfma_f32_32x32x16_bf16(HG_FRAG(AMb, 32 * ti + r32, 72, 16 * ks + 8 * hi), HG_FRAG(VTb, 32 * vj + r32, 72, 16 * ks + 8 * hi), o, 0, 0, 0);
#pragma unroll
          for (int ks = 0; ks < 8; ++ks) o = __builtin_amdgcn_mfma_f32_32x32x16_bf16(HG_FRAG(QHb, 32 * ti + r32, HSE, 16 * ks + 8 * hi), HG_FRAG(STb, 32 * vj + r32, HSE, 16 * ks + 8 * hi), o, 0, 0, 0);
          LAS unsigned short* OUT = (LAS unsigned short*)(F.lds + H3_IR);
#pragma unroll
          for (int r = 0; r < 16; ++r) OUT[(32 * ti + crow(r, hi)) * HSE + 32 * vj + r32] = (unsigned short)f2bf(o[r]); }
        __syncthreads();
        { bf16* OB = (bf16*)(F.ws + WS_OAB) + (size_t)rowc * 1024 + 512 + h * 128; const LAS unsigned char* OUT = F.lds + H3_IR; const float* go = F.in[I_HOG] + h * 128;
#pragma unroll
          for (int i = 0; i < 2; ++i) { const int cc = tid + 512 * i, row = cc >> 4, c16 = cc & 15;
              const v4u w = *(const LAS v4u*)(OUT + row * HS + c16 * 16); const v4u bw = i == 0 ? rgc0 : rgc1;
              float v[8] = {lo16f(w.x), hi16f(w.x), lo16f(w.y), hi16f(w.y), lo16f(w.z), hi16f(w.z), lo16f(w.w), hi16f(w.w)};
              const float bgv[8] = {lo16f(bw.x), hi16f(bw.x), lo16f(bw.y), hi16f(bw.y), lo16f(bw.z), hi16f(bw.z), lo16f(bw.w), hi16f(bw.w)};
              float ss = 0.f;
#pragma unroll
              for (int j = 0; j < 8; ++j) ss += v[j] * v[j];
              ss += __shfl_xor(ss, 1); ss += __shfl_xor(ss, 2); ss += __shfl_xor(ss, 4); ss += __shfl_xor(ss, 8);
              const float rsd = 1.0f / sqrtf(ss * (1.0f / 128.0f) + 1e-6f);
              const f32x4 g0 = *(const f32x4*)(go + c16 * 8), g1 = *(const f32x4*)(go + c16 * 8 + 4);
              v4u o; o.x = pk2(v[0] * rsd * g0[0] * bgv[0], v[1] * rsd * g0[1] * bgv[1]); o.y = pk2(v[2] * rsd * g0[2] * bgv[2], v[3] * rsd * g0[3] * bgv[3]);
              o.z = pk2(v[4] * rsd * g1[0] * bgv[4], v[5] * rsd * g1[1] * bgv[5]); o.w = pk2(v[6] * rsd * g1[2] * bgv[6], v[7] * rsd * g1[3] * bgv[7]);
              *(GAS v4u*)(OB + (size_t)row * 1024 + c16 * 8) = o; } }
        __syncthreads();
    }
#undef H3_PREF
}
struct Args { const float* in[22]; float* out; unsigned char* ws; int ph_lo, ph_hi, li, pad; };
__device__ __forceinline__ float absmax64(const float* g, int lane) { float v = fabsf(g[lane]);
#pragma unroll
    for (int o = 1; o < 64; o <<= 1) v = fmaxf(v, __shfl_xor(v, o));
    return v; }
__global__ void __launch_bounds__(NWAVES * 64, 2) mk_fwd(Args args) {
    extern __shared__ __attribute__((aligned(16))) unsigned char lds[];
    Frame F;
    F.lds = (LAS unsigned char*)lds; F.MISC = (volatile LAS unsigned*)(F.lds + MISC_OFF);
    F.tid = threadIdx.x; F.lane = F.tid & 63; F.wave = __builtin_amdgcn_readfirstlane(F.tid >> 6);
    F.G = gridDim.x; { const int bx = blockIdx.x; F.vcu = (F.G % 8 == 0) ? (bx % 8) * (F.G / 8) + bx / 8 : bx; }
    unsigned char* ws = args.ws; F.ws = ws; F.ctl = (gu32*)(ws + WS_CTL); F.out = args.out;
#pragma unroll
    for (int i = 0; i < 22; ++i) F.in[i] = args.in[i];
    for (int u = F.tid; u < (LDS_BYTES - LDSCTL_OFF) / 4; u += NWAVES * 64) ((LAS unsigned*)(F.lds + LDSCTL_OFF))[u] = 0u;
    __syncthreads();
    XcdBarrier bar; bar.bar = (unsigned*)(F.ctl + CW_BAR); bar.x = 0; bar.st = nullptr;
    if (N_LAUNCHES == 1) bar = xcd_barrier_post((unsigned*)(F.ctl + CW_BAR), F.MISC + 8);
    const int lo = args.ph_lo, hi = args.ph_hi;
#ifdef PROBE_A
    const bool stamper = (blockIdx.x == 0 && F.tid == 0); unsigned long long* const tsw = (unsigned long long*)(ws + WS_CTL + 65536);
#define STAMP(i) do { if (stamper) tsw[i] = __builtin_amdgcn_s_memrealtime(); } while (0)
#else
#define STAMP(i) do { } while (0)
#endif
    STAMP(0);
#ifndef PHSEL
#define PHSEL 0x1fff
#endif
#define IN(k) (((PHSEL >> (k)) & 1) && lo <= (k) && (k) < hi)
#define SEAM(k) do { if (IN(k) && IN((k) + 1)) xcd_barrier(bar); } while (0)
    bf16* Hb = (bf16*)(ws + WS_H);
    if (IN(0)) { p0_prologue(F); SEAM(0); STAMP(1); }
    if (IN(1)) { norm_rows<0>(F, F.in[I_X], Hb); SEAM(1); STAMP(2); }
    if (IN(2)) {
        pg8::Gemm g{Hb, (const bf16*)(ws + WS_WIN), M, NPROJ, DMOD}; pg8::StaticOrder S; S.init(M, NPROJ, F.G, (int)blockIdx.x);
        pg8::EpiProj E{(bf16*)(ws + WS_QLAT), (bf16*)(ws + WS_AK), (bf16*)(ws + WS_AV), (bf16*)(ws + WS_KI), (bf16*)(ws + WS_BQ),
                       (bf16*)F.out, (float*)(ws + WS_QLSS), (float*)(ws + WS_WIDX), F.in[I_KNG], F.in[I_KIG]};
        pg8::gemm_phase<pg8::EpiProj, pg8::StaticOrder, true, true>(F.lds, g, S, E);
        SEAM(2); STAMP(3);
    }
    if (IN(3)) {
        int Kq = 256; asm volatile("" : "+s"(Kq));
        pg8::Gemm g{(const bf16*)(ws + WS_QLAT), (const bf16*)(ws + WS_WQ), M, 768, Kq}; pg8::StaticOrder S; S.init(M, 768, F.G, (int)blockIdx.x);
        pg8::EpiQ E{(bf16*)(ws + WS_AQ), (bf16*)(ws + WS_QI), (float*)(ws + WS_QN), (const float*)(ws + WS_QLSS), (const float*)(ws + WS_WIDX), F.in[I_QNG]};
        pg8::gemm_phase<pg8::EpiQ, pg8::StaticOrder, true, true>(F.lds, g, S, E);
        SEAM(3); STAMP(4);
    }
    if (IN(4)) {
        STAMPB(0);
        const float kmax = 8.0f * absmax64(F.in[I_KIG], F.lane) * 1.02f;
        for (;;) {
            LAS int* par = (LAS int*)(F.lds + PAR_OFF);
            if (F.tid == 0) par[200] = (int)__hip_atomic_fetch_add(F.ctl + 2048, 1u, RLX_AGENT);
            __syncthreads(); const int qn = par[200]; __syncthreads();
            if (qn >= 512) break;
            topk_unit(F, qn & 1, 255 - (qn >> 1), kmax); }
        STAMP(14); STAMPB(1);
        hg_state_phase(F); STAMPB(2);
        SEAM(4); STAMP(5);
    }
    if (IN(5)) {
        STAMPB(3);
        if (F.vcu < 256) { const int bh = F.vcu >> 4, s = F.vcu & 15;
            for (int i = 0; i < 2; ++i) attn_body::attn_unit(bh >> 3, bh & 7, i == 0 ? s : 31 - s, (const attn_body::bf16*)(ws + WS_AQ), (const attn_body::bf16*)(ws + WS_AK), (const attn_body::bf16*)(ws + WS_AV),
                                                             (attn_body::bf16*)(ws + WS_OAB), (const unsigned*)(ws + WS_MASK), (char*)lds); }
        STAMP(15); STAMPB(4);
        hg_scan(F); STAMPB(5);
        SEAM(5); STAMP(6);
    }
    if (IN(6)) { STAMPB(6); hg_out_phase(F); STAMPB(7); SEAM(6); STAMP(7); }
    if (IN(7)) {
        pg8::Gemm g{(const bf16*)(ws + WS_OAB), (const bf16*)(ws + WS_WCAT), M, 1024, 1024}; pg8::StaticOrder S; S.init(M, 1024, F.G, (int)blockIdx.x);
        pg8::EpiMergeF E{(const bf16*)F.out, (bf16*)(ws + WS_T)};
        pg8::gemm_phase<pg8::EpiMergeF, pg8::StaticOrder, true, true>(F.lds, g, S, E);
        SEAM(7); STAMP(8);
    }
    if (IN(8)) { STAMP(9); }
    if (IN(9)) {
        pg8::Gemm g{(const bf16*)(ws + WS_T), (const bf16*)(ws + WS_WOUT), M, 1024, 1024}; pg8::StaticOrder S; S.init(M, 1024, F.G, (int)blockIdx.x);
        pg8::EpiRes E{F.in[I_X], F.out, (const float*)(ws + WS_MODV) + 2048, nullptr};
        pg8::gemm_phase<pg8::EpiRes, pg8::StaticOrder, true, true>(F.lds, g, S, E);
        SEAM(9); STAMP(10);
    }
    if (IN(10)) {
        { LAS float* scr = (LAS float*)(F.lds + F.wave * 16384); const int gw = F.vcu * NWAVES + F.wave, NGW = F.G * NWAVES;
          for (int it = gw; it < 4096; it += NGW) { if (it < 2048) tr_plain(F.in[I_W1], 1024, 4096, (bf16*)(ws + WS_W1), it, scr, F.lane); else tr_plain(F.in[I_W2], 4096, 1024, (bf16*)(ws + WS_W2), it - 2048, scr, F.lane); } }
        __syncthreads();
        norm_rows<1>(F, F.out, Hb);
        SEAM(10); STAMP(11);
    }
    if (IN(11)) {
        pg8::Gemm g{Hb, (const bf16*)(ws + WS_W1), M, DFF, DMOD}; pg8::StaticOrder S; S.init(M, DFF, F.G, (int)blockIdx.x);
        pg8::EpiUp E{(bf16*)(ws + WS_HID), F.in[I_B1]};
        pg8::gemm_phase<pg8::EpiUp, pg8::StaticOrder, true, true>(F.lds, g, S, E);
        SEAM(11); STAMP(12);
    }
    if (IN(12)) {
        pg8::Gemm g{(const bf16*)(ws + WS_HID), (const bf16*)(ws + WS_W2), M, DMOD, DFF}; pg8::StaticOrder S; S.init(M, DMOD, F.G, (int)blockIdx.x);
        pg8::EpiRes E{F.out, F.out, (const float*)(ws + WS_MODV) + 5120, F.in[I_B2]};
        pg8::gemm_phase<pg8::EpiRes, pg8::StaticOrder, true, true>(F.lds, g, S, E);
    }
#ifdef PROBE_A
    xcd_barrier(bar); STAMP(13); xcd_barrier(bar);
    { const volatile unsigned long long* tv = tsw; float frac;
#if defined(PROBE_STAT)
      { float mx = 0.f, sm = 0.f; for (int bk = 0; bk < (int)gridDim.x; ++bk) { const float dsp = (float)(long long)(tv[64 + bk * 16 + PROBE_B] - tv[64 + bk * 16 + PROBE_A]); mx = fmaxf(mx, dsp); sm += dsp; }
        frac = (PROBE_STAT == 1 ? mx : sm / (float)gridDim.x) / (float)(long long)(tv[13] - tv[0]); }
#else
      frac = (float)(long long)(tv[PROBE_B] - tv[PROBE_A]) / (float)(long long)(tv[13] - tv[0]);
#endif
      const float sc = 1.0f + 0.1f * sqrtf(fmaxf(frac, 0.f));
      for (int m = F.vcu * NWAVES + F.wave; m < M; m += F.G * NWAVES) { GAS f32x4* o = (GAS f32x4*)(F.out + (size_t)m * DMOD) + F.lane;
#pragma unroll
          for (int j = 0; j < 4; ++j) { f32x4 v = o[64 * j]; v = v * sc; o[64 * j] = v; } } }
#endif
#undef IN
#undef SEAM
}

extern "C" void kernel_launch(void* const* d_in, const int* in_sizes, int n_in, void* d_out, int out_size, void* d_ws, size_t ws_size, hipStream_t stream) {
    static int grid = 0;
    if (grid == 0) {
        if (n_in != 22 || out_size != M * DMOD || ws_size < WS_END) { fprintf(stderr, "kernel_launch: unexpected problem shape (n_in %d out %d ws %zu)\n", n_in, out_size, ws_size); grid = -1; return; }
        int dev = 0, cus = 0, per_cu = 0;
        if (hipGetDevice(&dev) != hipSuccess || hipDeviceGetAttribute(&cus, hipDeviceAttributeMultiprocessorCount, dev) != hipSuccess) { grid = -1; return; }
        if (hipFuncSetAttribute((const void*)mk_fwd, hipFuncAttributeMaxDynamicSharedMemorySize, LDS_BYTES) != hipSuccess) { fprintf(stderr, "kernel_launch: hipFuncSetAttribute failed\n"); grid = -1; return; }
        if (hipOccupancyMaxActiveBlocksPerMultiprocessor(&per_cu, (const void*)mk_fwd, NWAVES * 64, LDS_BYTES) != hipSuccess || per_cu < 1) fprintf(stderr, "kernel_launch: occupancy query says %d\n", per_cu);
        (void)hipGetLastError();
        grid = cus;
        if (grid != 256) fprintf(stderr, "kernel_launch: %d CUs (built for 256)\n", grid);
    }
    if (grid < 0) return;
    if (hipMemsetAsync((char*)d_ws + WS_CTL, 0, CTL_ZERO_BYTES, stream) != hipSuccess) return;
    Args a{};
    for (int i = 0; i < 22; ++i) a.in[i] = (const float*)d_in[i];
    a.out = (float*)d_out; a.ws = (unsigned char*)d_ws;
    for (int li = 0; li < N_LAUNCHES; ++li) {
        a.ph_lo = (N_LAUNCHES == 1) ? 0 : li; a.ph_hi = (N_LAUNCHES == 1) ? NPHASE : li + 1; a.li = li;
        hipLaunchKernelGGL(mk_fwd, dim3(grid), dim3(NWAVES * 64), LDS_BYTES, stream, a);
    }
}
```

```cpp
#include <hip/hip_runtime.h>
#include <hip/hip_bf16.h>
#include <cstdio>
#include <cstdint>
#include <cmath>
namespace pg8 {
#define PG8_LAS __attribute__((address_space(3)))
typedef unsigned short bf16_t;
typedef short bf16x8 __attribute__((ext_vector_type(8)));
typedef float f32x4 __attribute__((ext_vector_type(4)));
typedef unsigned u32x4 __attribute__((ext_vector_type(4)));
constexpr int BM = 256, BK = 64, HALF = 128, HTB = HALF * BK * 2  , STAGE_BYTES = 8 * HTB, NXCD = 8, WGM = 8;

__host__ __device__ __forceinline__ int lds_byte(int r, int c) { const int st = (r >> 4) * 2 + (c >> 5), rr = r & 15, cc = c & 31, ob = rr * 64 + cc * 2; return st * 1024 + (ob ^ (((ob >> 9) & 1) << 5)); }
__host__ __device__ __forceinline__ void stage_rc(int b, int& R, int& C) { const int st = b / 1024, sb = b % 1024, swz = sb ^ (((sb >> 9) & 1) << 5); R = (st >> 1) * 16 + swz / 64; C = (st & 1) * 32 + (swz % 64) / 2; }
__host__ __device__ __forceinline__ int perm32(int rho) { const int n = rho >> 4, i = rho & 15; return 8 * (i >> 2) + 4 * n + (i & 3); }

struct Unit { int pm, pn; };
struct Gemm { const bf16_t* A; const bf16_t* Bt; int M, N, K; };

struct StaticOrder {
    int nM, nN, nwg, G, c;
    __host__ __device__ void init(int M, int N, int G_, int c_) { nM = M / BM; nN = N / BM; nwg = nM * nN; G = G_; c = c_; }
    __host__ __device__ bool next(int i, Unit& u) const {
        const long L = (long)i * G + c; if (L >= nwg) return false;
        int wgid = (int)L; { const int q = nwg / NXCD, r = nwg % NXCD, xcd = wgid % NXCD, off = wgid / NXCD; wgid = (xcd < r ? xcd * (q + 1) : r * (q + 1) + (xcd - r) * q) + off; }
        const int nig = WGM * nN, gid = wgid / nig, fm = gid * WGM, gsz = (nM - fm) < WGM ? (nM - fm) : WGM;
        u.pm = fm + ((wgid % nig) % gsz); u.pn = (wgid % nig) / gsz; return true;
    }
    __device__ __forceinline__ void a_ready(const Unit&) const {}
    __device__ __forceinline__ void done(const Unit&) const {}
};

__device__ __forceinline__ unsigned cvt_pk_bf16(float lo, float hi) { unsigned r; asm volatile("v_cvt_pk_bf16_f32 %0, %1, %2" : "=v"(r) : "v"(lo), "v"(hi)); return r; }
__device__ __forceinline__ float bf2f(bf16_t b) { return __builtin_bit_cast(float, (unsigned)b << 16); }
__device__ __forceinline__ float sigm(float x) { return __builtin_amdgcn_rcpf(1.0f + __expf(-x)); }
__device__ __forceinline__ void st8(bf16_t* p, const float* v) { u32x4 w; w.x = cvt_pk_bf16(v[0], v[1]); w.y = cvt_pk_bf16(v[2], v[3]); w.z = cvt_pk_bf16(v[4], v[5]); w.w = cvt_pk_bf16(v[6], v[7]); *(u32x4*)p = w; }
__device__ __forceinline__ void ld8(const bf16_t* p, float* v) { const u32x4 w = *(const u32x4*)p; v[0] = __builtin_bit_cast(float, w.x << 16); v[1] = __builtin_bit_cast(float, w.x & 0xffff0000u);
    v[2] = __builtin_bit_cast(float, w.y << 16); v[3] = __builtin_bit_cast(float, w.y & 0xffff0000u); v[4] = __builtin_bit_cast(float, w.z << 16); v[5] = __builtin_bit_cast(float, w.z & 0xffff0000u);
    v[6] = __builtin_bit_cast(float, w.w << 16); v[7] = __builtin_bit_cast(float, w.w & 0xffff0000u); }
#define EPI_ROWS(ai, m) _Pragma("unroll") for (int ai = 0; ai < 2; ++ai) _Pragma("unroll") for (int m = 0; m < 4; ++m)
#define EPI_GET(v, ai, m) asm volatile("" ::: "memory"); float v[2][8]; _Pragma("unroll") for (int bj = 0; bj < 2; ++bj) _Pragma("unroll") for (int n = 0; n < 2; ++n) _Pragma("unroll") for (int j = 0; j < 4; ++j) v[bj][4 * n + j] = acc[ai][bj][m][n][j];
constexpr float EPSN = 1e-6f;
constexpr float C2ATT = 0.125f * 1.4426950408889634f;
constexpr float IDXSC = 0.0625f;

struct EpiProj {
    static constexpr bool PERM = true, AFTER_DRAIN = false, MID = false;
    bf16_t *QLAT, *AK, *AV, *KI, *BQ, *GA; float *QLSS, *WIDX; const float *gk, *gki, *lbp;
    __device__ __forceinline__ void operator()(const f32x4 (&acc)[2][2][4][2], const Unit& u, int wr, int wc, int fr_, int fq_) const { int fr = fr_, fq = fq_; asm volatile("" : "+v"(fr), "+v"(fq));
        const int pn = u.pn, rowb = u.pm * BM + wr * 64 + fr, cw = 64 * wc + 8 * fq;
        if (pn == 0) {
            EPI_ROWS(ai, m) { EPI_GET(v, ai, m) const int row = rowb + ai * HALF + m * 16; float ss = 0.f;
#pragma unroll
                for (int bj = 0; bj < 2; ++bj) { _Pragma("unroll") for (int j = 0; j < 8; ++j) ss += v[bj][j] * v[bj][j]; st8(QLAT + (size_t)row * 256 + cw + 32 * bj, v[bj]); }
                ss += __shfl_xor(ss, 16); ss += __shfl_xor(ss, 32); if (fq == 0) QLSS[row * 4 + wc] = ss; }
        } else if (pn <= 2 || pn == 5) {
            if (pn == 5 && wc != 0) { if (wc == 1 && fq == 0) { EPI_ROWS(ai, m) { const int row = rowb + ai * HALF + m * 16; *(f32x4*)(WIDX + row * 4) = acc[ai][0][m][0]; } } return; }
            const float* g = (pn == 5) ? gki : gk; float gv[2][8];
#pragma unroll
            for (int bj = 0; bj < 2; ++bj) { _Pragma("unroll") for (int j = 0; j < 8; ++j) gv[bj][j] = g[32 * bj + 8 * fq + j]; }
            bf16_t* O = (pn == 5) ? KI : AK; const int ld = (pn == 5) ? 64 : 512, c0 = (pn == 5) ? 8 * fq : (pn - 1) * 256 + cw;
            EPI_ROWS(ai, m) { EPI_GET(v, ai, m) const int row = rowb + ai * HALF + m * 16; float ss = 0.f;
#pragma unroll
                for (int bj = 0; bj < 2; ++bj) { _Pragma("unroll") for (int j = 0; j < 8; ++j) ss += v[bj][j] * v[bj][j]; }
                ss += __shfl_xor(ss, 16); ss += __shfl_xor(ss, 32); const float r = __builtin_amdgcn_rsqf(ss * (1.0f / 64.0f) + EPSN);
#pragma unroll
                for (int bj = 0; bj < 2; ++bj) { _Pragma("unroll") for (int j = 0; j < 8; ++j) v[bj][j] *= r * gv[bj][j];
                    if (pn == 5) st8(KI + (size_t)(row >> 5) * 2048 + (2 * bj + (fq >> 1)) * 512 + (fq & 1) * 256 + (row & 31) * 8, v[bj]);
                    else st8(O + (size_t)row * ld + c0 + 32 * bj, v[bj]); } }
        } else {
            bf16_t* O; int ld, c0, act;
            if (pn <= 4) { O = AV; ld = 512; c0 = (pn - 3) * 256; act = 0; }
            else if (pn <= 13) { const int k = (pn - 6) >> 1; O = BQ + (size_t)k * ((size_t)16384 * 512); ld = 512; c0 = ((pn - 6) & 1) * 256; act = (k == 0 || k == 3) ? 1 : (k == 1 ? 3 : 0); }
            else { const int k = (pn - 14) >> 2; O = GA + (size_t)k * ((size_t)16384 * 1024); ld = 1024; c0 = ((pn - 14) & 3) * 256; act = 2; }
            float lbv[2][8];
            if (act == 3) { _Pragma("unroll") for (int bj = 0; bj < 2; ++bj) { _Pragma("unroll") for (int j = 0; j < 8; ++j) { const int ch = c0 + cw + 32 * bj + j; lbv[bj][j] = sigm(lbp[ch] - lbp[512 + ch]); } } }
            EPI_ROWS(ai, m) { EPI_GET(v, ai, m) const int row = rowb + ai * HALF + m * 16;
#pragma unroll
                for (int bj = 0; bj < 2; ++bj) { if (act == 3) { _Pragma("unroll") for (int j = 0; j < 8; ++j) v[bj][j] = __logf(lbv[bj][j] + (1.0f - lbv[bj][j]) * sigm(v[bj][j])); }
                    else if (act) { _Pragma("unroll") for (int j = 0; j < 8; ++j) { const float s = sigm(v[bj][j]); v[bj][j] = (act == 1) ? v[bj][j] * s : s; } }
                    st8(O + (size_t)row * ld + c0 + cw + 32 * bj, v[bj]); } }
        }
    }
};
struct EpiQ {
    static constexpr bool PERM = true, AFTER_DRAIN = false, MID = false;
    bf16_t *AQ, *QI; float* QN; const float *QLSS, *WIDX, *gq;
    __device__ __forceinline__ void operator()(const f32x4 (&acc)[2][2][4][2], const Unit& u, int wr, int wc, int fr_, int fq_) const { int fr = fr_, fq = fq_; asm volatile("" : "+v"(fr), "+v"(fq));
        const int pn = u.pn, rowb = u.pm * BM + wr * 64 + fr, cw = 64 * wc + 8 * fq;
        float gv[2][8];
#pragma unroll
        for (int bj = 0; bj < 2; ++bj) { _Pragma("unroll") for (int j = 0; j < 8; ++j) gv[bj][j] = gq[32 * bj + 8 * fq + j]; }
        EPI_ROWS(ai, m) { EPI_GET(v, ai, m) const int row = rowb + ai * HALF + m * 16;
            const f32x4 q4 = *(const f32x4*)(QLSS + row * 4); const float s = __builtin_amdgcn_rsqf(((q4[0] + q4[1]) + (q4[2] + q4[3])) * (1.0f / 256.0f) + EPSN);
            float ss = 0.f;
#pragma unroll
            for (int bj = 0; bj < 2; ++bj) { _Pragma("unroll") for (int j = 0; j < 8; ++j) ss += v[bj][j] * v[bj][j]; }
            ss += __shfl_xor(ss, 16); ss += __shfl_xor(ss, 32);
            if (pn < 2) { const float f = s * __builtin_amdgcn_rsqf(s * s * ss * (1.0f / 64.0f) + EPSN) * C2ATT;
#pragma unroll
                for (int bj = 0; bj < 2; ++bj) { _Pragma("unroll") for (int j = 0; j < 8; ++j) v[bj][j] *= f * gv[bj][j]; st8(AQ + (size_t)row * 512 + pn * 256 + cw + 32 * bj, v[bj]); }
            } else { const float f = s * WIDX[row * 4 + wc] * IDXSC;
#pragma unroll
                for (int bj = 0; bj < 2; ++bj) { _Pragma("unroll") for (int j = 0; j < 8; ++j) v[bj][j] *= f; st8(QI + (size_t)row * 256 + cw + 32 * bj, v[bj]); }
                if (fq == 0) QN[row * 4 + wc] = sqrtf(ss) * fabsf(f); }
        }
    }
};
struct EpiMergeF {
    static constexpr bool PERM = true, AFTER_DRAIN = false, MID = true;
    const bf16_t* GA; bf16_t* T;
    __device__ __forceinline__ void mid(f32x4 (&acc)[2][2][4][2], const Unit& u, int wr, int wc, int fr_, int fq_) const { int fr = fr_, fq = fq_; asm volatile("" : "+v"(fr), "+v"(fq));
        const int rowb = u.pm * BM + wr * 64 + fr, c0 = u.pn * BM + 64 * wc + 8 * fq; const bf16_t* GB = GA + (size_t)16384 * 1024;
        EPI_ROWS(ai, m) { asm volatile("" ::: "memory"); const int row = rowb + ai * HALF + m * 16;
#pragma unroll
            for (int bj = 0; bj < 2; ++bj) { const size_t off = (size_t)row * 1024 + c0 + 32 * bj; float ga[8], gb[8]; ld8(GA + off, ga); ld8(GB + off, gb);
#pragma unroll
                for (int n = 0; n < 2; ++n) { _Pragma("unroll") for (int j = 0; j < 4; ++j) acc[ai][bj][m][n][j] *= ga[4 * n + j] * __builtin_amdgcn_rcpf(gb[4 * n + j]); } } }
    }
    __device__ __forceinline__ void operator()(const f32x4 (&acc)[2][2][4][2], const Unit& u, int wr, int wc, int fr_, int fq_) const { int fr = fr_, fq = fq_; asm volatile("" : "+v"(fr), "+v"(fq));
        const int rowb = u.pm * BM + wr * 64 + fr, c0 = u.pn * BM + 64 * wc + 8 * fq; const bf16_t* GB = GA + (size_t)16384 * 1024;
        EPI_ROWS(ai, m) { EPI_GET(v, ai, m) const int row = rowb + ai * HALF + m * 16;
#pragma unroll
            for (int bj = 0; bj < 2; ++bj) { const size_t off = (size_t)row * 1024 + c0 + 32 * bj; float g[8]; ld8(GB + off, g);
                _Pragma("unroll") for (int j = 0; j < 8; ++j) v[bj][j] *= g[j];
                st8(T + off, v[bj]); } }
    }
};
struct EpiRes {
    static constexpr bool PERM = true, AFTER_DRAIN = false, MID = false;
    const float* base; float* out; const float* gate; const float* bias;
    __device__ __forceinline__ void operator()(const f32x4 (&acc)[2][2][4][2], const Unit& u, int wr, int wc, int fr_, int fq_) const { int fr = fr_, fq = fq_; asm volatile("" : "+v"(fr), "+v"(fq));
        const int rowb = u.pm * BM + wr * 64 + fr, c0 = u.pn * BM + 64 * wc + 8 * fq; const float* gp = gate + (u.pm >= 32 ? 6144 : 0);
        float gv[2][8], bv[2][8];
#pragma unroll
        for (int bj = 0; bj < 2; ++bj) { _Pragma("unroll") for (int j = 0; j < 8; ++j) { gv[bj][j] = gp[c0 + 32 * bj + j]; bv[bj][j] = bias ? bias[c0 + 32 * bj + j] : 0.f; } }
        EPI_ROWS(ai, m) { EPI_GET(v, ai, m) const int row = rowb + ai * HALF + m * 16;
#pragma unroll
            for (int bj = 0; bj < 2; ++bj) { const size_t off = (size_t)row * 1024 + c0 + 32 * bj; const f32x4 x0 = *(const f32x4*)(base + off), x1 = *(const f32x4*)(base + off + 4);
                f32x4 o0, o1;
#pragma unroll
                for (int j = 0; j < 4; ++j) { o0[j] = x0[j] + gv[bj][j] * (v[bj][j] + bv[bj][j]); o1[j] = x1[j] + gv[bj][4 + j] * (v[bj][4 + j] + bv[bj][4 + j]); }
                *(f32x4*)(out + off) = o0; *(f32x4*)(out + off + 4) = o1; } }
    }
};
struct EpiUp {
    static constexpr bool PERM = true, AFTER_DRAIN = false, MID = false;
    bf16_t* O; const float* bias;
    __device__ __forceinline__ void operator()(const f32x4 (&acc)[2][2][4][2], const Unit& u, int wr, int wc, int fr_, int fq_) const { int fr = fr_, fq = fq_; asm volatile("" : "+v"(fr), "+v"(fq));
        const int rowb = u.pm * BM + wr * 64 + fr, c0 = u.pn * BM + 64 * wc + 8 * fq;
        float bv[2][8];
#pragma unroll
        for (int bj = 0; bj < 2; ++bj) { _Pragma("unroll") for (int j = 0; j < 8; ++j) bv[bj][j] = bias[c0 + 32 * bj + j]; }
        EPI_ROWS(ai, m) { EPI_GET(v, ai, m) const int row = rowb + ai * HALF + m * 16;
#pragma unroll
            for (int bj = 0; bj < 2; ++bj) { _Pragma("unroll") for (int j = 0; j < 8; ++j) { const float t = fmaxf(v[bj][j] + bv[bj][j], 0.f); v[bj][j] = t * t; }
                st8(O + (size_t)row * 4096 + c0 + 32 * bj, v[bj]); } }
    }
};
template <class Epi, class Sched, bool ALIGN_EPI = false, bool SP2 = false>
__device__ __forceinline__ void gemm_phase(PG8_LAS unsigned char* lds, const Gemm g, const Sched& S, const Epi& E) {
    const int tid = threadIdx.x, wid = __builtin_amdgcn_readfirstlane(tid >> 6), lane = tid & 63, wr = wid >> 2, wc = wid & 3, fr = lane & 15, fq = lane >> 4;
    const int K = g.K, nt = K / BK;
    unsigned voffA[2], voffB[2];
#pragma unroll
    for (int i = 0; i < 2; ++i) { int R, C; stage_rc(tid * 16 + i * 8192, R, C); const int Rb = Epi::PERM ? ((R & ~31) + perm32(R & 31)) : R;
        voffA[i] = (unsigned)(R * K + C) * 2u; voffB[i] = (unsigned)(Rb * K + C) * 2u; }
    const size_t kstep = (size_t)(BK * 2);
    const size_t hstep = (size_t)HALF * K * 2;
    const size_t tstep = 2 * hstep;
    const unsigned ldsw = (unsigned)wid * 1024u;
    const int aoff = lds_byte(wr * 64 + fr, fq * 8), boff = lds_byte(wc * 32 + fr, fq * 8);
#define PG8_SA(b, h) (((b) * 2 + (h)) * HTB)
#define PG8_SB(b, h) ((4 + (b) * 2 + (h)) * HTB)
#define PG8_STAGE(bufoff, gbase, voff) do { _Pragma("unroll") for (int _i = 0; _i < 2; ++_i) \
        __builtin_amdgcn_global_load_lds((const unsigned*)((const char*)(gbase) + (voff)[_i]), (PG8_LAS unsigned*)(lds + (bufoff) + ldsw + _i * 8192), 16, 0, 0); } while (0)
#define PG8_LDA(dst, b, h) do { _Pragma("unroll") for (int m = 0; m < 4; ++m) _Pragma("unroll") for (int k = 0; k < 2; ++k) dst[m][k] = *(const PG8_LAS bf16x8*)(lds + PG8_SA(b, h) + aoff + m * 2048 + k * 1024); } while (0)
#define PG8_LDB(dst, b, h) do { _Pragma("unroll") for (int n = 0; n < 2; ++n) _Pragma("unroll") for (int k = 0; k < 2; ++k) dst[n][k] = *(const PG8_LAS bf16x8*)(lds + PG8_SB(b, h) + boff + n * 2048 + k * 1024); } while (0)
#define PG8_MMA(ai, bj, At, Bt) do { __builtin_amdgcn_s_setprio(1); _Pragma("unroll") for (int m = 0; m < 4; ++m) _Pragma("unroll") for (int n = 0; n < 2; ++n) _Pragma("unroll") for (int k = 0; k < 2; ++k) \
        acc[ai][bj][m][n] = __builtin_amdgcn_mfma_f32_16x16x32_bf16(Bt[n][k], At[m][k], acc[ai][bj][m][n], 0, 0, 0); __builtin_amdgcn_s_setprio(0); } while (0)
#define PG8_WAIT_V(n) asm volatile("s_waitcnt vmcnt(" #n ")" ::: "memory")
#define PG8_WAIT_L(n) asm volatile("s_waitcnt lgkmcnt(" #n ")" ::: "memory")
#define PG8_BAR __builtin_amdgcn_s_barrier()
#define PG8_SCHED __builtin_amdgcn_sched_barrier(0)
    Unit cur, nxt; int ui = 0;
    if (!S.next(0, cur)) return;
    f32x4 acc[2][2][4][2];
#pragma unroll
    for (int a = 0; a < 2; ++a)
#pragma unroll
        for (int b = 0; b < 2; ++b)
#pragma unroll
            for (int m = 0; m < 4; ++m)
#pragma unroll
                for (int n = 0; n < 2; ++n) acc[a][b][m][n] = (f32x4){0.f, 0.f, 0.f, 0.f};
    bf16x8 At[4][2], B0[2][2], B1[2][2];
    const char* cA = (const char*)g.A + (size_t)cur.pm * tstep; const char* cB = (const char*)g.Bt + (size_t)cur.pn * tstep;
    S.a_ready(cur);
    if constexpr (SP2) {
        PG8_STAGE(PG8_SB(0, 0), cB, voffB); PG8_STAGE(PG8_SB(0, 1), cB + hstep, voffB); PG8_STAGE(PG8_SA(0, 0), cA, voffA); PG8_STAGE(PG8_SA(0, 1), cA + hstep, voffA);
        if (wr == 1) PG8_BAR;
        PG8_WAIT_V(2); PG8_BAR;
        PG8_STAGE(PG8_SB(1, 0), cB + kstep, voffB); PG8_STAGE(PG8_SA(1, 0), cA + kstep, voffA); PG8_STAGE(PG8_SB(1, 1), cB + hstep + kstep, voffB);
        PG8_WAIT_V(6); PG8_BAR;
    } else {
        PG8_STAGE(PG8_SB(0, 0), cB, voffB); PG8_STAGE(PG8_SA(0, 0), cA, voffA); PG8_STAGE(PG8_SB(0, 1), cB + hstep, voffB); PG8_STAGE(PG8_SA(0, 1), cA + hstep, voffA);
        if (wr == 1) PG8_BAR;
        PG8_WAIT_V(4); PG8_BAR;
        PG8_STAGE(PG8_SB(1, 0), cB + kstep, voffB); PG8_STAGE(PG8_SA(1, 0), cA + kstep, voffA); PG8_STAGE(PG8_SB(1, 1), cB + hstep + kstep, voffB);
        PG8_WAIT_V(6); PG8_BAR;
    }
    for (;;) {
        const bool has_next = S.next(ui + 1, nxt);
        const char* nA = has_next ? (const char*)g.A + (size_t)nxt.pm * tstep : cA; const char* nB = has_next ? (const char*)g.Bt + (size_t)nxt.pn * tstep : cB;
        for (int t = 0; t < nt; t += 2) {
            if constexpr (Epi::MID) { if (t == nt / 2) E.mid(acc, cur, wr, wc, fr, fq); }
            const bool last = (t == nt - 2);
            const char* a1 = cA + (size_t)(t + 1) * kstep;
            const char* a2 = last ? nA : cA + (size_t)(t + 2) * kstep; const char* b2 = last ? nB : cB + (size_t)(t + 2) * kstep;
            const char* a3 = a2 + kstep; const char* b3 = b2 + kstep;
            if (last && has_next) S.a_ready(nxt);
            if constexpr (SP2) {
            PG8_LDB(B0, 0, 0); PG8_LDB(B1, 0, 1); PG8_SCHED; PG8_LDA(At, 0, 0); PG8_STAGE(PG8_SA(1, 1), a1 + hstep, voffA);
            PG8_WAIT_V(8); PG8_WAIT_L(0); PG8_BAR; PG8_MMA(0, 0, At, B0); PG8_MMA(0, 1, At, B1); PG8_BAR; PG8_SCHED;
            PG8_LDA(At, 0, 1); PG8_STAGE(PG8_SB(0, 0), b2, voffB); PG8_STAGE(PG8_SB(0, 1), b2 + hstep, voffB); PG8_STAGE(PG8_SA(0, 0), a2, voffA);
            PG8_WAIT_V(8); PG8_WAIT_L(0); PG8_BAR; PG8_MMA(1, 0, At, B0); PG8_MMA(1, 1, At, B1); PG8_BAR; PG8_SCHED;
            PG8_LDB(B0, 1, 0); PG8_LDB(B1, 1, 1); PG8_SCHED; PG8_LDA(At, 1, 0); PG8_STAGE(PG8_SA(0, 1), a2 + hstep, voffA);
            PG8_WAIT_V(8); PG8_WAIT_L(0); PG8_BAR; PG8_MMA(0, 0, At, B0); PG8_MMA(0, 1, At, B1); PG8_BAR; PG8_SCHED;
            PG8_LDA(At, 1, 1); PG8_STAGE(PG8_SB(1, 0), b3, voffB); PG8_STAGE(PG8_SB(1, 1), b3 + hstep, voffB); PG8_STAGE(PG8_SA(1, 0), a3, voffA);
            PG8_WAIT_V(8); PG8_WAIT_L(0); PG8_BAR; PG8_MMA(1, 0, At, B0); PG8_MMA(1, 1, At, B1); PG8_BAR; PG8_SCHED;
            } else {
            PG8_LDB(B0, 0, 0); PG8_SCHED; PG8_LDA(At, 0, 0); PG8_STAGE(PG8_SA(1, 1), a1 + hstep, voffA);
            PG8_WAIT_L(8); PG8_BAR; PG8_WAIT_L(0); PG8_MMA(0, 0, At, B0); PG8_BAR; PG8_SCHED;
            PG8_LDB(B1, 0, 1); PG8_STAGE(PG8_SB(0, 0), b2, voffB);
            PG8_BAR; PG8_WAIT_L(0); PG8_MMA(0, 1, At, B1); PG8_BAR;
            PG8_LDA(At, 0, 1); PG8_STAGE(PG8_SA(0, 0), a2, voffA);
            PG8_BAR; PG8_WAIT_L(0); PG8_MMA(1, 0, At, B0); PG8_BAR; PG8_SCHED;
            PG8_STAGE(PG8_SB(0, 1), b2 + hstep, voffB);
            PG8_WAIT_V(6); PG8_BAR; PG8_MMA(1, 1, At, B1); PG8_BAR;
            PG8_LDB(B0, 1, 0); PG8_SCHED; PG8_LDA(At, 1, 0); PG8_STAGE(PG8_SA(0, 1), a2 + hstep, voffA);
            PG8_WAIT_L(8); PG8_BAR; PG8_WAIT_L(0); PG8_MMA(0, 0, At, B0); PG8_BAR; PG8_SCHED;
            PG8_LDB(B1, 1, 1); PG8_STAGE(PG8_SB(1, 0), b3, voffB);
            PG8_BAR; PG8_WAIT_L(0); PG8_MMA(0, 1, At, B1); PG8_BAR;
            PG8_LDA(At, 1, 1); PG8_STAGE(PG8_SA(1, 0), a3, voffA);
            PG8_BAR; PG8_WAIT_L(0); PG8_MMA(1, 0, At, B0); PG8_BAR; PG8_SCHED;
            PG8_STAGE(PG8_SB(1, 1), b3 + hstep, voffB);
            PG8_WAIT_V(6); PG8_BAR; PG8_MMA(1, 1, At, B1); PG8_BAR;
            }
        }
        if constexpr (ALIGN_EPI) { if (wr == 0) PG8_BAR; }
        if constexpr (!Epi::AFTER_DRAIN) { E(acc, cur, wr, wc, fr, fq); S.done(cur); }
        if (!has_next) break;
#pragma unroll
        for (int a = 0; a < 2; ++a)
#pragma unroll
            for (int b = 0; b < 2; ++b)
#pragma unroll
                for (int m = 0; m < 4; ++m)
#pragma unroll
                    for (int n = 0; n < 2; ++n) acc[a][b][m][n] = (f32x4){0.f, 0.f, 0.f, 0.f};
        cur = nxt; cA = nA; cB = nB; ++ui;
        if constexpr (ALIGN_EPI) { if (wr == 1) PG8_BAR; }
    }
    PG8_WAIT_V(0);
    if constexpr (!ALIGN_EPI) { if (wr == 0) PG8_BAR; }
    PG8_BAR;
    if constexpr (Epi::AFTER_DRAIN) { E.fused(acc, cur, wr, wc, fr, fq, lds, wid, lane); S.done(cur); }
#undef PG8_SA
#undef PG8_SB
#undef PG8_STAGE
#undef PG8_LDA
#undef PG8_LDB
#undef PG8_MMA
#undef PG8_WAIT_V
#undef PG8_WAIT_L
#undef PG8_BAR
#undef PG8_SCHED
}
}
namespace attn_body {
using bf16=__hip_bfloat16;
using bf16x8=__attribute__((ext_vector_type(8)))short;
using s16x4=__attribute__((ext_vector_type(4)))short;
using f32x16=__attribute__((ext_vector_type(16)))float;
using u32x4=__attribute__((ext_vector_type(4)))unsigned;
constexpr int BATCH=2,NHEAD=8,SEQ=8192,D=64,DM=NHEAD*D,DMO=1024;
constexpr int NW=8,QBLK=32,QB=QBLK*NW,KVBLK=64,NQB=SEQ/QB;
__device__ __forceinline__ int crow(int r,int hi){return (r&3)+8*(r>>2)+4*hi;}
#define SBAR() __builtin_amdgcn_sched_barrier(0)
constexpr int NSLOT=3, SLOTB=8192;
constexpr int LDS_K=0, LDS_V=NSLOT*SLOTB, LDS_WS=2*NSLOT*SLOTB, LDS_OST=LDS_WS+NW*64*4, LDS_MR=LDS_OST+NW*4096, LDS_BYTES=LDS_MR+NW*1024;
__device__ __forceinline__ void glds16(const void*gsrc,unsigned lds_dst){unsigned keep;
  asm volatile("s_mov_b32 %0, m0\n\ts_mov_b32 m0, %2\n\ts_nop 0\n\tglobal_load_lds_dwordx4 %1, off\n\ts_mov_b32 m0, %0":"=&s"(keep):"v"(gsrc),"s"(lds_dst):"memory");}
__device__ __forceinline__ void glds4(const void*gsrc,unsigned lds_dst){unsigned keep;
  asm volatile("s_mov_b32 %0, m0\n\ts_mov_b32 m0, %2\n\ts_nop 0\n\tglobal_load_lds_dword %1, off\n\ts_mov_b32 m0, %0":"=&s"(keep):"v"(gsrc),"s"(lds_dst):"memory");}
typedef float f32x2_t __attribute__((ext_vector_type(2))); typedef __bf16 bf16x2_t __attribute__((ext_vector_type(2)));
__device__ __forceinline__ unsigned cvtpk_s(float lo,float hi){f32x2_t v={lo,hi};bf16x2_t b=__builtin_convertvector(v,bf16x2_t);return __builtin_bit_cast(unsigned,b);}
#define WAIT_BAR(N) asm volatile("s_waitcnt vmcnt(" #N ") lgkmcnt(0)\n\ts_barrier":::"memory")
__device__ __forceinline__ float mexp(float v,unsigned W,int e){const float p=__builtin_amdgcn_exp2f(v);return __builtin_bit_cast(float,__builtin_bit_cast(unsigned,p)&(unsigned)(((int)(W<<e))>>31));}
__device__ __forceinline__ void qkt(f32x16&p0,f32x16&p1,const char*Kslot,const bf16x8*qr,const f32x16&negm,int r32,int hi){
  const char*kb=Kslot+hi*1024+r32*16;
  #pragma unroll
  for(int d0=0;d0<4;++d0){
    const bf16x8 b0=*reinterpret_cast<const bf16x8*>(kb+d0*2048);
    const bf16x8 b1=*reinterpret_cast<const bf16x8*>(kb+d0*2048+512);
    if(d0==0){p0=__builtin_amdgcn_mfma_f32_32x32x16_bf16(b0,qr[0],negm,0,0,0);p1=__builtin_amdgcn_mfma_f32_32x32x16_bf16(b1,qr[0],negm,0,0,0);}
    else{p0=__builtin_amdgcn_mfma_f32_32x32x16_bf16(b0,qr[d0],p0,0,0,0);p1=__builtin_amdgcn_mfma_f32_32x32x16_bf16(b1,qr[d0],p1,0,0,0);}}
}
typedef __attribute__((address_space(3))) const char* lds_cptr;
typedef short v4i16_t __attribute__((ext_vector_type(4)));
__device__ __forceinline__ void kload8(bf16x8*kf,lds_cptr kp){
  kf[0]=*(const __attribute__((address_space(3))) bf16x8*)(kp);      kf[1]=*(const __attribute__((address_space(3))) bf16x8*)(kp+512);
  kf[2]=*(const __attribute__((address_space(3))) bf16x8*)(kp+2048); kf[3]=*(const __attribute__((address_space(3))) bf16x8*)(kp+2560);
  kf[4]=*(const __attribute__((address_space(3))) bf16x8*)(kp+4096); kf[5]=*(const __attribute__((address_space(3))) bf16x8*)(kp+4608);
  kf[6]=*(const __attribute__((address_space(3))) bf16x8*)(kp+6144); kf[7]=*(const __attribute__((address_space(3))) bf16x8*)(kp+6656);
}
__device__ __forceinline__ void kload2(bf16x8*kf,lds_cptr kp,int j){ kf[2*j]=*(const __attribute__((address_space(3))) bf16x8*)(kp+j*2048); kf[2*j+1]=*(const __attribute__((address_space(3))) bf16x8*)(kp+j*2048+512); }
__device__ __forceinline__ s16x4 vtr(lds_cptr p){ return __builtin_bit_cast(s16x4,__builtin_amdgcn_ds_read_tr16_b64_v4i16((__attribute__((address_space(3))) v4i16_t*)p)); }
__device__ __forceinline__ void pv(f32x16*o,int vb,bf16x8 pa0,bf16x8 pa1,bf16x8 pa2,bf16x8 pa3){
  #pragma unroll
  for(int d0=0;d0<2;++d0){s16x4 lo[4],hi[4];
    #pragma unroll
    for(int ks=0;ks<4;++ks){
      asm volatile("ds_read_b64_tr_b16 %0,%1 offset:%c2":"=&v"(lo[ks]):"v"(vb),"i"(d0*4096+ks*1024):"memory");
      asm volatile("ds_read_b64_tr_b16 %0,%1 offset:%c2":"=&v"(hi[ks]):"v"(vb),"i"(d0*4096+ks*1024+512):"memory");}
    asm volatile("s_waitcnt lgkmcnt(0)":::"memory");SBAR();
    #define PK(k) (bf16x8){lo[k][0],lo[k][1],lo[k][2],lo[k][3],hi[k][0],hi[k][1],hi[k][2],hi[k][3]}
    o[d0]=__builtin_amdgcn_mfma_f32_32x32x16_bf16(pa0,PK(0),o[d0],0,0,0);
    o[d0]=__builtin_amdgcn_mfma_f32_32x32x16_bf16(pa1,PK(1),o[d0],0,0,0);
    o[d0]=__builtin_amdgcn_mfma_f32_32x32x16_bf16(pa2,PK(2),o[d0],0,0,0);
    o[d0]=__builtin_amdgcn_mfma_f32_32x32x16_bf16(pa3,PK(3),o[d0],0,0,0);
    #undef PK
  }
}
#ifndef ATTN_STORE16
#define ATTN_STORE16(p,v) (*(u32x4*)(p)=(v))
#endif
__device__ __forceinline__ void attn_unit(int b,int h,int qb,const bf16*Q,const bf16*__restrict__ K,const bf16*__restrict__ V,bf16*O,const unsigned*MW,char*shm){
  const int tid=threadIdx.x,lane=tid&63,r32=lane&31,hi=lane>>5; const int wid=__builtin_amdgcn_readfirstlane(tid>>6);
  const long rowbase=(long)b*SEQ; const int q0=qb*QB;
  const bf16*Qw=Q+(rowbase+q0+wid*QBLK)*DM+h*D;
  const bf16*Kh=K+rowbase*DM+h*D,*Vh=V+rowbase*DM+h*D;
  const unsigned lds0=(unsigned)(uintptr_t)shm;
  float*wsf=(float*)(shm+LDS_WS)+wid*64;
  const bf16*ksrc=Kh+(long)lane*DM+wid*8;
  const bf16*vsrc=Vh+(long)(16*(wid&3)+(lane>>2))*DM+(wid>>2)*32+(lane&3)*8;
  const unsigned kdst=lds0+LDS_K+wid*1024, vdst=lds0+LDS_V+wid*1024, mdst=lds0+LDS_MR+wid*1024;
  const unsigned*msrc=MW+((size_t)b*16896+16*qb*(qb+1)+wid*(4*qb+4))*64+lane;
  #define DMA_K(t,slot) glds16(ksrc+(long)(t)*KVBLK*DM,(unsigned)__builtin_amdgcn_readfirstlane(kdst+(slot)))
  #define DMA_V(t,slot) glds16(vsrc+(long)(t)*KVBLK*DM,(unsigned)__builtin_amdgcn_readfirstlane(vdst+(slot)))
  #define DMA_M(t) glds4(msrc+(long)(t)*64,(unsigned)__builtin_amdgcn_readfirstlane(mdst+(((t)&3)<<8)))
  const int vb0=(int)(lds0+LDS_V)+((lane>>4)&1)*32+(lane&3)*8+(4*hi+((lane&15)>>2))*64;
  const char*Kbase=shm+LDS_K; bf16x8 kf[8];
  const lds_cptr shm3=(lds_cptr)shm; const lds_cptr kp0=shm3+LDS_K+hi*1024+r32*16; const lds_cptr vp0=shm3+LDS_V+((lane>>4)&1)*32+(lane&3)*8+(4*hi+((lane&15)>>2))*64;
  const __attribute__((address_space(3))) unsigned* mrd=(const __attribute__((address_space(3))) unsigned*)(shm3+LDS_MR+wid*1024)+lane;
  const int NT=(q0+QB)/KVBLK;
  DMA_M(0);DMA_K(0,0);DMA_V(0,0);DMA_K(1,SLOTB);
  bf16x8 qr[4];
  #pragma unroll
  for(int d0=0;d0<4;++d0)qr[d0]=*reinterpret_cast<const bf16x8*>(&Qw[(long)r32*DM+d0*16+hi*8]);
  float l_reg=0.f;f32x16 o[2];o[0]=f32x16{};o[1]=f32x16{};const f32x16 negm=f32x16{};
  f32x16 pA0,pA1,pB0,pB1;
  int sl_prev=0,sl_cur=0,sl_next=SLOTB;
  #define ROT() do{sl_prev=sl_cur;sl_cur=sl_next;sl_next=(sl_next==(NSLOT-1)*SLOTB)?0:sl_next+SLOTB;}while(0)
  DMA_K(2,2*SLOTB);DMA_M(1);
  WAIT_BAR(4);
  { const unsigned W0=mrd[0];
    qkt(pA0,pA1,Kbase,qr,negm,r32,hi);
    _Pragma("unroll") for(int r=0;r<16;++r){pA0[r]=mexp(pA0[r],W0,r);pA1[r]=mexp(pA1[r],W0,16+r);} }
  WAIT_BAR(0);
  DMA_K(3,0);DMA_V(1,SLOTB);DMA_M(2);
  ROT();
  kload8(kf,kp0+sl_cur);
  WAIT_BAR(3);
  s16x4 vlo[8],vhi[8]; u32x4 pw0,pw1,pw2,pw3;
  #define PKW(P,B) cvtpk_s(P[B],P[B+1])
  #define PAF(k) __builtin_bit_cast(bf16x8,pw##k)
  #define VFR(i) (bf16x8){vlo[i][0],vlo[i][1],vlo[i][2],vlo[i][3],vhi[i][0],vhi[i][1],vhi[i][2],vhi[i][3]}
  #define PIN(x) asm volatile("":"+v"(x))
  #define GAPA(MF,A0,A1,A2,A3,W0,W1,PW) do{ MF; sacc+=A0; sacc+=A1; sacc+=A2; sacc+=A3; PIN(sacc); W0; W1; PIN(PW); SBAR(); }while(0)
  #define GAPB(MF,X,B,E0) do{ MF; X[B]=mexp(X[B],Wm,E0+B); X[B+1]=mexp(X[B+1],Wm,E0+B+1); X[B+2]=mexp(X[B+2],Wm,E0+B+2); X[B+3]=mexp(X[B+3],Wm,E0+B+3); PIN(X); SBAR(); }while(0)
  #define VRD(i) do{ vlo[i]=vtr(vp_+(((i)>>2)*4096+((i)&3)*1024)); vhi[i]=vtr(vp_+(((i)>>2)*4096+((i)&3)*1024+512)); }while(0)
  #define KRD(G,j) do{ if(G){ kload2(kf,kp0+sl_next,j); SBAR(); } }while(0)
  #define STEP(C0,C1,P0,P1,t,GK,GV,GM,GL) do{ SBAR(); \
    const lds_cptr vp_=vp0+sl_prev; const unsigned Wm=mrd[((t)&3)<<6]; \
    VRD(0); SBAR(); float sacc=(P0[0]+P0[1]); \
    GAPA(C0=__builtin_amdgcn_mfma_f32_32x32x16_bf16(kf[0],qr[0],negm,0,0,0), P0[2],P0[3],P0[4],P0[5],     pw0[0]=PKW(P0,0), pw0[1]=PKW(P0,2), pw0); \
    VRD(4); SBAR(); GAPA(C1=__builtin_amdgcn_mfma_f32_32x32x16_bf16(kf[1],qr[0],negm,0,0,0), P0[6],P0[7],P0[8],P0[9],     pw0[2]=PKW(P0,4), pw0[3]=PKW(P0,6), pw0); \
    VRD(1); SBAR(); GAPA(C0=__builtin_amdgcn_mfma_f32_32x32x16_bf16(kf[2],qr[1],C0,0,0,0),   P0[10],P0[11],P0[12],P0[13], pw1[0]=PKW(P0,8), pw1[1]=PKW(P0,10), pw1); \
    VRD(5); SBAR(); GAPA(C1=__builtin_amdgcn_mfma_f32_32x32x16_bf16(kf[3],qr[1],C1,0,0,0),   P0[14],P0[15],P1[0],P1[1],   pw1[2]=PKW(P0,12),pw1[3]=PKW(P0,14), pw1); \
    VRD(2); SBAR(); GAPA(C0=__builtin_amdgcn_mfma_f32_32x32x16_bf16(kf[4],qr[2],C0,0,0,0),   P1[2],P1[3],P1[4],P1[5],     pw2[0]=PKW(P1,0), pw2[1]=PKW(P1,2), pw2); \
    VRD(6); SBAR(); GAPA(C1=__builtin_amdgcn_mfma_f32_32x32x16_bf16(kf[5],qr[2],C1,0,0,0),   P1[6],P1[7],P1[8],P1[9],     pw2[2]=PKW(P1,4), pw2[3]=PKW(P1,6), pw2); \
    VRD(3); SBAR(); GAPA(C0=__builtin_amdgcn_mfma_f32_32x32x16_bf16(kf[6],qr[3],C0,0,0,0),   P1[10],P1[11],P1[12],P1[13], pw3[0]=PKW(P1,8), pw3[1]=PKW(P1,10), pw3); \
    VRD(7); SBAR(); GAPA(C1=__builtin_amdgcn_mfma_f32_32x32x16_bf16(kf[7],qr[3],C1,0,0,0),   P1[14],P1[15],0.f,0.f,       pw3[2]=PKW(P1,12),pw3[3]=PKW(P1,14), pw3); \
    l_reg+=sacc; \
    if(GK){DMA_K((t)+3,sl_cur);} if(GV){DMA_V((t)+1,sl_next);} if(GM){DMA_M((t)+2);} \
    SBAR(); \
    GAPB(o[0]=__builtin_amdgcn_mfma_f32_32x32x16_bf16(PAF(0),VFR(0),o[0],0,0,0), C0,0,0); \
    GAPB(o[1]=__builtin_amdgcn_mfma_f32_32x32x16_bf16(PAF(0),VFR(4),o[1],0,0,0), C0,4,0); \
    KRD(GL,0); GAPB(o[0]=__builtin_amdgcn_mfma_f32_32x32x16_bf16(PAF(1),VFR(1),o[0],0,0,0), C0,8,0); \
    KRD(GL,1); GAPB(o[1]=__builtin_amdgcn_mfma_f32_32x32x16_bf16(PAF(1),VFR(5),o[1],0,0,0), C0,12,0); \
    KRD(GL,2); GAPB(o[0]=__builtin_amdgcn_mfma_f32_32x32x16_bf16(PAF(2),VFR(2),o[0],0,0,0), C1,0,16); \
    KRD(GL,3); GAPB(o[1]=__builtin_amdgcn_mfma_f32_32x32x16_bf16(PAF(2),VFR(6),o[1],0,0,0), C1,4,16); \
    GAPB(o[0]=__builtin_amdgcn_mfma_f32_32x32x16_bf16(PAF(3),VFR(3),o[0],0,0,0), C1,8,16); \
    GAPB(o[1]=__builtin_amdgcn_mfma_f32_32x32x16_bf16(PAF(3),VFR(7),o[1],0,0,0), C1,12,16); \
    }while(0)
  int t=1;
  for(;t+5<NT;t+=2){
    STEP(pB0,pB1,pA0,pA1,t,true,true,true,true);     WAIT_BAR(3); ROT();
    STEP(pA0,pA1,pB0,pB1,t+1,true,true,true,true);   WAIT_BAR(3); ROT();
  }
  #define ENDW(tt) do{ if((tt)+3<NT){WAIT_BAR(3);} else if((tt)+2<NT){WAIT_BAR(2);} else {WAIT_BAR(0);} }while(0)
  for(;t+1<NT;t+=2){
    STEP(pB0,pB1,pA0,pA1,t,(t+3<NT),(t+1<NT),(t+2<NT),(t+1<NT));       ENDW(t);   ROT();
    STEP(pA0,pA1,pB0,pB1,t+1,(t+4<NT),(t+2<NT),(t+3<NT),(t+2<NT));     ENDW(t+1); ROT();
  }
  STEP(pB0,pB1,pA0,pA1,NT-1,false,false,false,false);
  { float sacc=pB0[0]+pB0[1]; _Pragma("unroll") for(int r=2;r<16;++r)sacc+=pB0[r]; _Pragma("unroll") for(int r=0;r<16;++r)sacc+=pB1[r]; l_reg+=sacc;
    pw0=(u32x4){PKW(pB0,0),PKW(pB0,2),PKW(pB0,4),PKW(pB0,6)};pw1=(u32x4){PKW(pB0,8),PKW(pB0,10),PKW(pB0,12),PKW(pB0,14)};pw2=(u32x4){PKW(pB1,0),PKW(pB1,2),PKW(pB1,4),PKW(pB1,6)};pw3=(u32x4){PKW(pB1,8),PKW(pB1,10),PKW(pB1,12),PKW(pB1,14)};
    SBAR(); pv(o,vb0+sl_cur,PAF(0),PAF(1),PAF(2),PAF(3)); }
  #undef PKW
  #undef PAF
  #undef VFR
  #undef PIN
  #undef GAPA
  #undef GAPB
  #undef VRD
  #undef KRD
  #undef STEP
  #undef ENDW
  {auto rr=__builtin_amdgcn_permlane32_swap(__float_as_uint(l_reg),__float_as_uint(l_reg),false,false);l_reg=__uint_as_float(rr[0])+__uint_as_float(rr[1]);}
  if(hi==0)wsf[32+r32]=l_reg;asm volatile("s_waitcnt lgkmcnt(0)":::"memory");
  float rli[16];
  #pragma unroll
  for(int r=0;r<16;++r)rli[r]=__builtin_amdgcn_rcpf(wsf[32+crow(r,hi)]);
  bf16*Ow=O+(rowbase+q0+wid*QBLK)*DMO+h*D;
  { bf16*stg=(bf16*)(shm+LDS_OST)+wid*2048;
    #pragma unroll
    for(int r=0;r<16;++r){const int orow=crow(r,hi);
      #pragma unroll
      for(int d0=0;d0<2;++d0)stg[orow*64+d0*32+r32]=__float2bfloat16(o[d0][r]*rli[r]);}
    asm volatile("s_waitcnt lgkmcnt(0)":::"memory");
    #pragma unroll
    for(int i=0;i<4;++i){const int row=i*8+(lane>>3),ch=lane&7; const u32x4 v=*(const u32x4*)(stg+row*64+ch*8); ATTN_STORE16(Ow+(long)row*DMO+ch*8,v);} }
  asm volatile("s_waitcnt lgkmcnt(0)\n\ts_barrier":::"memory");
  #undef DMA_K
  #undef DMA_V
  #undef DMA_M
  #undef ROT
}
constexpr int ATTN_LDS_BYTES=LDS_BYTES;
#undef SBAR
#undef WAIT_BAR
}
constexpr int NWAVES = 8;
#ifndef MK_N_LAUNCHES
#define MK_N_LAUNCHES 1
#endif
constexpr int NPHASE = 13;
constexpr int N_LAUNCHES = MK_N_LAUNCHES;
constexpr int BATCH = 2, SEQL = 8192, DMOD = 1024, M = BATCH * SEQL, DFF = 4096, NPROJ = 5632, DIN = 5444;
constexpr size_t MiB = 1u << 20;
constexpr size_t WS_CTL = 0, CTL_ZERO_BYTES = 1 * MiB;
constexpr size_t WS_MODP = 1 * MiB;
constexpr size_t WS_MODV = 2 * MiB;
constexpr size_t WS_QLSS = 2 * MiB + 64 * 1024;
constexpr size_t WS_WIDX = WS_QLSS + 256 * 1024;
constexpr size_t WS_QN   = WS_WIDX + 256 * 1024;
constexpr size_t WS_HDEC = 3 * MiB;
constexpr size_t WS_WIN = 4 * MiB, WS_WQ = 15 * MiB, WS_WCAT = 16 * MiB, WS_WOUT = 18 * MiB;
constexpr size_t WS_H = 20 * MiB;
constexpr size_t WS_OAB = 20 * MiB;
constexpr size_t WS_MASK = 246 * MiB;
constexpr size_t WS_QLAT = 52 * MiB, WS_AK = 60 * MiB, WS_AV = 76 * MiB, WS_KI = 92 * MiB, WS_QI = 94 * MiB, WS_AQ = 102 * MiB;
constexpr size_t WS_BQ = 118 * MiB, WS_BF = 134 * MiB, WS_BI = 150 * MiB, WS_BG = 166 * MiB;
constexpr size_t WS_KV = 182 * MiB, WS_SP = 214 * MiB;
constexpr size_t WS_T = 182 * MiB;
constexpr size_t WS_W1 = 60 * MiB, WS_W2 = 68 * MiB;
constexpr size_t WS_HID = 76 * MiB;
constexpr size_t WS_END = 256 * MiB;
static_assert(WS_MASK + (size_t)2 * 16896 * 256 <= WS_END && WS_SP + 32 * MiB <= WS_MASK && WS_HID + 128 * MiB <= WS_END, "d_ws map");
constexpr int CW_BAR = 4096;
constexpr int RING_BYTES = 131072, SCR_BYTES = 155648, LDSCTL_OFF = SCR_BYTES, MISC_OFF = LDSCTL_OFF + 320, PAR_OFF = LDSCTL_OFF + 1024;
constexpr int LDS_BYTES = 163840;

#define GAS __attribute__((address_space(1)))
#define LAS __attribute__((address_space(3)))
typedef unsigned short bf16;
typedef unsigned v4u __attribute__((ext_vector_type(4)));
typedef float f32x4 __attribute__((ext_vector_type(4)));
typedef float f32x16 __attribute__((ext_vector_type(16)));
typedef short bf16x8 __attribute__((ext_vector_type(8)));
typedef GAS unsigned gu32;
#define RLX_AGENT __ATOMIC_RELAXED, __HIP_MEMORY_SCOPE_AGENT
#define LDS_WAIT() asm volatile("s_waitcnt lgkmcnt(0)" ::: "memory")
__device__ __forceinline__ unsigned f2bf(float f) { unsigned u = __builtin_bit_cast(unsigned, f); return (u + 0x7fffu + ((u >> 16) & 1u)) >> 16; }
typedef float f32x2_t_ __attribute__((ext_vector_type(2))); typedef __bf16 bf16x2_t_ __attribute__((ext_vector_type(2)));
__device__ __forceinline__ unsigned pk2(float lo, float hi) { f32x2_t_ v = {lo, hi}; bf16x2_t_ b = __builtin_convertvector(v, bf16x2_t_); return __builtin_bit_cast(unsigned, b); }
__device__ __forceinline__ float bf2f(bf16 b) { return __builtin_bit_cast(float, (unsigned)b << 16); }
__device__ __forceinline__ float sigmf(float x) { return __builtin_amdgcn_rcpf(1.0f + __expf(-x)); }
#ifdef PROBE_A
#define STAMPB(i) do { if (threadIdx.x == 0) ((unsigned long long*)(F.ws + WS_CTL + 65536))[64 + blockIdx.x * 16 + (i)] = __builtin_amdgcn_s_memrealtime(); } while (0)
#else
#define STAMPB(i) do { } while (0)
#endif
#define XB_TMO      128
#define XB_XCNT(j)  (256  + 64 * (j))
#define XB_XSUB(j)  (1280 + 64 * (j))
#define XB_XGEN(j)  (2304 + 64 * (j))
#define XB_TOP      3328
#define XB_TOPGEN   3392
#define XCD_BAR_WORDS 3456
#define XB_SPIN_CAP (1u << 18)

__device__ __forceinline__ unsigned xb_ld(unsigned* p)              { return __hip_atomic_load(p, __ATOMIC_RELAXED, __HIP_MEMORY_SCOPE_AGENT); }
__device__ __forceinline__ unsigned xb_add(unsigned* p, unsigned v) { return __hip_atomic_fetch_add(p, v, __ATOMIC_RELAXED, __HIP_MEMORY_SCOPE_AGENT); }
__device__ __forceinline__ unsigned xb_xcc_id() { return (unsigned)__builtin_amdgcn_s_getreg((3 << 11) | 20) & 0xFu; }
#define XB_SPIN(cond, bar) do { unsigned _sp = 0; while (cond) { __builtin_amdgcn_s_sleep(1); \
    if ((++_sp & 255u) == 0u) { if (xb_ld(&(bar)[XB_TMO])) break; if (_sp > XB_SPIN_CAP) { atomicAdd(&(bar)[XB_TMO], 1u); break; } } } } while (0)

struct XcdBarrier {
    unsigned* bar; unsigned x;
    volatile LAS unsigned* st;
};

__device__ __forceinline__ XcdBarrier xcd_barrier_post(unsigned* bar, volatile LAS unsigned* st) {
    XcdBarrier b; b.bar = bar; b.x = xb_xcc_id(); b.st = st;
    if (threadIdx.x == 0) (void)xb_add(&bar[XB_XCNT(b.x)], 1u);
    return b;
}
__device__ __forceinline__ void xcd_barrier_complete(unsigned* bar, unsigned x, unsigned& nloc, unsigned& nx) {
    const unsigned G = gridDim.x * gridDim.y * gridDim.z;
    unsigned sum, cnt, mine, sp = 0u;
    for (;;) {
        sum = 0u; cnt = 0u; mine = 0u;
#pragma unroll
        for (unsigned j = 0; j < 16; ++j) { const unsigned c = xb_ld(&bar[XB_XCNT(j)]); sum += c; cnt += (c > 0u) ? 1u : 0u; mine = (j == x) ? c : mine; }
        if (sum == G) break;
        __builtin_amdgcn_s_sleep(1);
        if ((++sp & 255u) == 0u) { if (xb_ld(&bar[XB_TMO])) break; if (sp > XB_SPIN_CAP) { atomicAdd(&bar[XB_TMO], 1u); break; } }
    }
    nloc = mine > 0u ? mine : 1u; nx = cnt > 0u ? cnt : 1u;
}

__device__ __forceinline__ void xcd_barrier(const XcdBarrier& b) {
    asm volatile("s_waitcnt vmcnt(0)" ::: "memory");
    __syncthreads();
    if (threadIdx.x == 0) {
        unsigned* bar = b.bar;
        __builtin_amdgcn_s_waitcnt(0);
        unsigned nloc = b.st[0], nx = b.st[1];
        if (nloc == 0u) { xcd_barrier_complete(bar, b.x, nloc, nx); b.st[0] = nloc; b.st[1] = nx; }
        const unsigned old = xb_add(&bar[XB_XSUB(b.x)], 1u);
        const unsigned gen = old / nloc;
        if (old + 1u == (gen + 1u) * nloc) {
            __builtin_amdgcn_fence(__ATOMIC_RELEASE, "agent");
            asm volatile("s_waitcnt vmcnt(0)" ::: "memory");
            const unsigned og = xb_add(&bar[XB_TOP], 1u);
            const unsigned tg = og / nx;
            if (og + 1u == (tg + 1u) * nx) xb_add(&bar[XB_TOPGEN], 1u);
            else XB_SPIN(xb_ld(&bar[XB_TOPGEN]) == tg, bar);
            __builtin_amdgcn_fence(__ATOMIC_ACQUIRE, "agent");
            xb_add(&bar[XB_XGEN(b.x)], 1u);
            asm volatile("s_waitcnt vmcnt(0)" ::: "memory");
        } else {
            XB_SPIN(xb_ld(&bar[XB_XGEN(b.x)]) == gen, bar);
            __builtin_amdgcn_fence(__ATOMIC_ACQUIRE, "agent");
            asm volatile("s_waitcnt vmcnt(0)" ::: "memory");
        }
    }
    __syncthreads();
}

struct Frame {
    LAS unsigned char* lds; volatile LAS unsigned* MISC; gu32* ctl;
    int tid, lane, wave, vcu, G;
    const float* in[22]; float* out; unsigned char* ws;
};
enum { I_X = 0, I_C, I_WADA, I_BADA, I_N1G, I_WIN, I_QLG, I_WUQ, I_WUQI, I_QNG, I_KNG, I_KIG, I_LB, I_HOG, I_WPA, I_WPB, I_WOUT, I_N2G, I_W1, I_B1, I_W2, I_B2 };
__device__ __forceinline__ float wave_sum(float v) {
#pragma unroll
    for (int o = 1; o < 64; o <<= 1) v += __shfl_xor(v, o);
    return v;
}
__device__ __forceinline__ int prow(int n) { const int cl = n & 255; return (n & ~255) + 128 * ((cl >> 5) & 1) + 32 * (cl >> 6) + (cl & 31); }
__device__ __forceinline__ void tr_item(const float* W, int ldn, int sc0, int nvalid, int k0, const float* gsc, bf16* WT, int K, int drow0, LAS float* scr, int lane, int kd = 0) {
    const int kr = lane >> 3, c4 = (lane & 7) * 4; f32x4 v[8];
    const bool al = (((size_t)(W + sc0) & 15) == 0) && ((ldn & 3) == 0) && (nvalid == 32);
    if (al) {
#pragma unroll
        for (int i = 0; i < 8; ++i) v[i] = *(const GAS f32x4*)(W + (size_t)(k0 + 8 * i + kr) * ldn + sc0 + c4);
    } else {
#pragma unroll
        for (int i = 0; i < 8; ++i) { const float* p = W + (size_t)(k0 + 8 * i + kr) * ldn + sc0 + c4;
            v[i].x = (c4 + 0 < nvalid) ? p[0] : 0.f; v[i].y = (c4 + 1 < nvalid) ? p[1] : 0.f; v[i].z = (c4 + 2 < nvalid) ? p[2] : 0.f; v[i].w = (c4 + 3 < nvalid) ? p[3] : 0.f; }
    }
#pragma unroll
    for (int i = 0; i < 8; ++i) { const int kk = 8 * i + kr; const float g = gsc ? gsc[k0 + kk] : 1.0f; LAS float* d = scr + kk * 33 + c4; d[0] = v[i].x * g; d[1] = v[i].y * g; d[2] = v[i].z * g; d[3] = v[i].w * g; }
    LDS_WAIT(); asm volatile("" ::: "memory");
    const int c = lane & 7;
#pragma unroll
    for (int j = 0; j < 4; ++j) { const int n = (lane >> 3) + 8 * j; const LAS float* s = scr + (8 * c) * 33 + n;
        v4u o; o.x = pk2(s[0 * 33], s[1 * 33]); o.y = pk2(s[2 * 33], s[3 * 33]); o.z = pk2(s[4 * 33], s[5 * 33]); o.w = pk2(s[6 * 33], s[7 * 33]);
        *(GAS v4u*)(WT + (size_t)(drow0 + n) * K + kd + k0 + 8 * c) = o; }
    LDS_WAIT(); asm volatile("" ::: "memory");
}
__device__ __forceinline__ void tr_plain(const float* W, int K, int N, bf16* WT, int r, LAS float* scr, int lane) {
    const int nblk = N / 32, kb = r / nblk, nb = r % nblk; tr_item(W, N, 32 * nb, 32, 64 * kb, nullptr, WT, K, prow(32 * nb), scr, lane);
}
__device__ __forceinline__ void p0_prologue(Frame& F) {
    LAS float* scr = (LAS float*)(F.lds + F.wave * 16384);
    const int gw = F.vcu * NWAVES + F.wave, NGW = F.G * NWAVES, lane = F.lane;
    constexpr int I_IN = 16 * (NPROJ / 32), I_Q = 4 * 24, I_PA = 8 * 32, I_PB = 8 * 32, I_OUT = 16 * 32, I_GV = 96 * 8;
    constexpr int NITEMS = I_IN + I_Q + I_PA + I_PB + I_OUT + I_GV;
    bf16* WIN = (bf16*)(F.ws + WS_WIN); bf16* WQ = (bf16*)(F.ws + WS_WQ);
    for (int it = gw; it < NITEMS; it += NGW) {
        int r = it;
        if (r < I_IN) { const int nblk = NPROJ / 32, kb = r / nblk, nb = r % nblk, n0 = 32 * nb; int sc0, nv;
            if (n0 < 1280) { sc0 = n0; nv = 32; } else if (n0 < 1536) { sc0 = n0; nv = 1348 - n0; nv = nv < 0 ? 0 : (nv > 32 ? 32 : nv); if (nv == 0) sc0 = 0; } else { sc0 = n0 - 188; nv = 32; }
            tr_item(F.in[I_WIN], DIN, sc0, nv, 64 * kb, nullptr, WIN, 1024, prow(n0), scr, lane); continue; } r -= I_IN;
        if (r < I_Q) { const int kb = r / 24, nb = r % 24, n0 = 32 * nb;
            if (n0 < 512) tr_item(F.in[I_WUQ], 512, n0, 32, 64 * kb, F.in[I_QLG], WQ, 256, prow(n0), scr, lane);
            else tr_item(F.in[I_WUQI], 256, n0 - 512, 32, 64 * kb, F.in[I_QLG], WQ, 256, prow(n0), scr, lane);
            continue; } r -= I_Q;
        if (r < I_PA) { const int kb = r / 32, nb = r % 32; tr_item(F.in[I_WPA], 1024, 32 * nb, 32, 64 * kb, nullptr, (bf16*)(F.ws + WS_WCAT), 1024, prow(32 * nb), scr, lane, 0); continue; } r -= I_PA;
        if (r < I_PB) { const int kb = r / 32, nb = r % 32; tr_item(F.in[I_WPB], 1024, 32 * nb, 32, 64 * kb, nullptr, (bf16*)(F.ws + WS_WCAT), 1024, prow(32 * nb), scr, lane, 512); continue; } r -= I_PB;
        if (r < I_OUT) { tr_plain(F.in[I_WOUT], 1024, 1024, (bf16*)(F.ws + WS_WOUT), r, scr, lane); continue; } r -= I_OUT;
        {
            const int ng = r % 96, ks = r / 96, n = ng * 64 + lane; const float* c = F.in[I_C]; const float* w = F.in[I_WADA] + (size_t)(ks * 128) * 6144 + n;
            float a0 = 0.f, a1 = 0.f;
#pragma unroll 32
            for (int k = 0; k < 128; ++k) { const float wv = w[(size_t)k * 6144]; const float c0 = c[ks * 128 + k], c1 = c[1024 + ks * 128 + k];
                a0 += (c0 * sigmf(c0)) * wv; a1 += (c1 * sigmf(c1)) * wv; }
            float* mp = (float*)(F.ws + WS_MODP); mp[(size_t)(ks * 2 + 0) * 6144 + n] = a0; mp[(size_t)(ks * 2 + 1) * 6144 + n] = a1;
        }
    }
}
__device__ __forceinline__ float mod_val(Frame& F, int b, int j) {
    const float* mp = (const float*)(F.ws + WS_MODP); float s = F.in[I_BADA][j];
#pragma unroll
    for (int ks = 0; ks < 8; ++ks) s += mp[(size_t)(ks * 2 + b) * 6144 + j];
    return s;
}
template <int WHICH> __device__ __forceinline__ void norm_rows(Frame& F, const float* X, bf16* H) {
    LAS float* tab = (LAS float*)F.lds;
    const float* g = F.in[WHICH == 0 ? I_N1G : I_N2G]; const int shift_off = WHICH == 0 ? 0 : 3072, scale_off = WHICH == 0 ? 1024 : 4096;
    for (int i = F.tid; i < 2048; i += NWAVES * 64) { const int b = i >> 10, k = i & 1023; float sc, sh;
        if (WHICH == 0) { sc = mod_val(F, b, scale_off + k); sh = mod_val(F, b, shift_off + k); }
        else { const float* mv = (const float*)(F.ws + WS_MODV); sc = mv[b * 6144 + scale_off + k]; sh = mv[b * 6144 + shift_off + k]; }
        tab[i] = g[k] * (1.0f + sc); tab[2048 + i] = sh; }
    if (WHICH == 0) { float* mv = (float*)(F.ws + WS_MODV); for (int i = F.tid; i < 48; i += NWAVES * 64) { const int j = F.vcu * 48 + i; if (j < 12288) mv[j] = mod_val(F, j / 6144, j % 6144); } }
    __syncthreads();
    const int gw = F.vcu * NWAVES + F.wave, NGW = F.G * NWAVES;
    f32x4 vn[4];
    if (gw < M) { const GAS f32x4* xr = (const GAS f32x4*)(X + (size_t)gw * DMOD) + F.lane;
#pragma unroll
        for (int j = 0; j < 4; ++j) vn[j] = xr[64 * j]; }
    for (int m = gw; m < M; m += NGW) {
        const int b = m >> 13; f32x4 v[4]; float s = 0.f;
#pragma unroll
        for (int j = 0; j < 4; ++j) { v[j] = vn[j]; s += (v[j].x * v[j].x + v[j].y * v[j].y) + (v[j].z * v[j].z + v[j].w * v[j].w); }
        if (m + NGW < M) { const GAS f32x4* xr = (const GAS f32x4*)(X + (size_t)(m + NGW) * DMOD) + F.lane;
#pragma unroll
            for (int j = 0; j < 4; ++j) vn[j] = xr[64 * j]; }
        const float r = 1.0f / sqrtf(wave_sum(s) * (1.0f / DMOD) + 1e-6f);
        GAS unsigned long long* o8 = (GAS unsigned long long*)(H + (size_t)m * DMOD) + F.lane;
#pragma unroll
        for (int j = 0; j < 4; ++j) { const int k = 4 * F.lane + 256 * j; const LAS float* a = tab + b * 1024 + k; const LAS float* sh = tab + 2048 + b * 1024 + k;
            o8[64 * j] = (unsigned long long)pk2(v[j].x * r * a[0] + sh[0], v[j].y * r * a[1] + sh[1]) | ((unsigned long long)pk2(v[j].z * r * a[2] + sh[2], v[j].w * r * a[3] + sh[3]) << 32); }
    }
    __syncthreads();
}
__device__ __forceinline__ int crow(int r, int hi) { return (r & 3) + 8 * (r >> 2) + 4 * hi; }
__device__ __forceinline__ int mask_slot(int gi) { const int j = gi >> 3, i = gi & 7; return 16 * j * (j + 1) + i * (4 * j + 4); }
constexpr float QKMAXF = 4194303.0f;
struct TkLane { float lo[4], hi[4], sc, off; int qq; };
__device__ __forceinline__ unsigned bsel(unsigned m, unsigned x, unsigned y) { return (m & x) | (~m & y); }
__device__ __forceinline__ float sel16(const float (&u)[16], int r) {
    unsigned a[8], b4[4], c2[2]; const unsigned m0 = 0u - (unsigned)(r & 1), m1 = 0u - (unsigned)((r >> 1) & 1), m2 = 0u - (unsigned)((r >> 2) & 1), m3 = 0u - (unsigned)((r >> 3) & 1);
#pragma unroll
    for (int i = 0; i < 8; ++i) a[i] = bsel(m0, __builtin_bit_cast(unsigned, u[2 * i + 1]), __builtin_bit_cast(unsigned, u[2 * i]));
#pragma unroll
    for (int i = 0; i < 4; ++i) b4[i] = bsel(m1, a[2 * i + 1], a[2 * i]);
#pragma unroll
    for (int i = 0; i < 2; ++i) c2[i] = bsel(m2, b4[2 * i + 1], b4[2 * i]);
    return __builtin_bit_cast(float, bsel(m3, c2[1], c2[0]));
}
template <int MODE>
__device__ __forceinline__ void topk_pass(Frame& F, const bf16* KI, const bf16x8 (&qf)[4][4], const TkLane& L, int rowbase, int q0, int gi, unsigned* MW, int b) {
    const int lane = F.lane, r32 = lane & 31, hi = lane >> 5, wid = F.wave;
    LAS unsigned* hist = (LAS unsigned*)F.lds;
    LAS unsigned* MWL = (LAS unsigned*)(F.lds + 98304);
    LAS int* par = (LAS int*)(F.lds + PAR_OFF);
    const int ntile = (gi >> 1) + 1, qmax = q0 + 31;
    float hiF = 0.f, loF = 0.f;
    if (MODE == 1) { const int tb = par[r32];
        if (tb < 0) { hiF = -1.0f; loF = -1.0f; }
        else { hiF = __builtin_bit_cast(float, __builtin_bit_cast(unsigned, (float)((tb + 1) * 4096)) - 1u); loF = tb == 0 ? -1.0f : __builtin_bit_cast(float, __builtin_bit_cast(unsigned, (float)(tb * 4096)) - 1u); } }
    LAS unsigned char* hq = (LAS unsigned char*)(hist + r32 * 1024);
#define TK_LDK(dst, tl, sb) do { const bf16* kp_ = KI + (size_t)((rowbase >> 5) + (tl) * 2 + (sb)) * 2048 + hi * 256 + r32 * 8;     \
        _Pragma("unroll") for (int ks = 0; ks < 4; ++ks) dst[ks] = *(const bf16x8*)(kp_ + ks * 512); } while (0)
    bf16x8 k0f[4], k1f[4];
    if (wid < ntile) TK_LDK(k0f, wid, 0);
    for (int tile = wid; tile < ntile; tile += NWAVES) {
        unsigned W = 0;
#pragma unroll
        for (int sub = 0; sub < 2; ++sub) {
            const int key0 = tile * 64 + sub * 32;
            if (sub == 0) TK_LDK(k1f, tile, 1); else if (tile + NWAVES < ntile) TK_LDK(k0f, tile + NWAVES, 0);
            if (key0 > qmax) { W <<= 16; continue; }
            float u[16];
            { f32x16 acc[2];
#pragma unroll
              for (int h = 0; h < 2; ++h) { acc[h] = f32x16{};
#pragma unroll
                  for (int ks = 0; ks < 4; ++ks) acc[h] = __builtin_amdgcn_mfma_f32_32x32x16_bf16(sub == 0 ? k0f[ks] : k1f[ks], qf[h][ks], acc[h], 0, 0, 0); }
#pragma unroll
              for (int r = 0; r < 16; ++r) u[r] = __builtin_amdgcn_fmed3f(acc[0][r], L.lo[0], L.hi[0]) + __builtin_amdgcn_fmed3f(acc[1][r], L.lo[1], L.hi[1]);
#pragma unroll
              for (int h = 0; h < 2; ++h) { acc[h] = f32x16{};
#pragma unroll
                  for (int ks = 0; ks < 4; ++ks) acc[h] = __builtin_amdgcn_mfma_f32_32x32x16_bf16(sub == 0 ? k0f[ks] : k1f[ks], qf[2 + h][ks], acc[h], 0, 0, 0); }
#pragma unroll
              for (int r = 0; r < 16; ++r) { const float s = (u[r] + __builtin_amdgcn_fmed3f(acc[0][r], L.lo[2], L.hi[2])) + __builtin_amdgcn_fmed3f(acc[1][r], L.lo[3], L.hi[3]); u[r] = __builtin_fmaf(s, L.sc, L.off); } }
            if (MODE == 3) { continue; }
            if (MODE == 4) { _Pragma("unroll") for (int r = 0; r < 16; ++r) asm volatile("" :: "v"(u[r])); continue; }
            const bool diag = key0 + 31 > q0;
            const int kq = L.qq - key0 - 4 * hi;
            if (MODE == 0) {
                if (!diag) {
#pragma unroll
                    for (int r = 0; r < 16; ++r) { const unsigned qk = (unsigned)u[r]; __hip_atomic_fetch_add((LAS unsigned*)(hq + ((qk >> 10) & 0xFFCu)), 1u, __ATOMIC_RELAXED, __HIP_MEMORY_SCOPE_WORKGROUP); }
                } else {
#pragma unroll
                    for (int r = 0; r < 16; ++r) { const unsigned qk = (unsigned)u[r]; __hip_atomic_fetch_add((LAS unsigned*)(hq + ((qk >> 10) & 0xFFCu)), ((r & 3) + 8 * (r >> 2) <= kq) ? 1u : 0u, __ATOMIC_RELAXED, __HIP_MEMORY_SCOPE_WORKGROUP); }
                }
            } else {
                unsigned Wd = 0u, Wc = 0u;
#pragma unroll
                for (int r = 0; r < 16; ++r) { Wd = __builtin_amdgcn_alignbit(Wd, __builtin_bit_cast(unsigned, hiF - u[r]), 31); Wc = __builtin_amdgcn_alignbit(Wc, __builtin_bit_cast(unsigned, loF - u[r]), 31); }
                if (diag) { unsigned vm = 0u;
#pragma unroll
                    for (int r = 0; r < 16; ++r) vm = (vm << 1) | (((r & 3) + 8 * (r >> 2) <= kq) ? 1u : 0u);
                    Wd &= vm; Wc &= vm; }
                W = (W << 16) | Wd;
                unsigned cand = Wc & ~Wd;
                while (__ballot(cand != 0u)) {
                    if (cand != 0u) { const int p = 31 - __builtin_clz(cand), r = 15 - p; const unsigned qk = (unsigned)sel16(u, r);
                        const unsigned slot = __hip_atomic_fetch_add((LAS unsigned*)par + 64 + r32, 1u, __ATOMIC_RELAXED, __HIP_MEMORY_SCOPE_WORKGROUP);
                        if (slot < 768u) hist[r32 * 768 + slot] = ((qk & 4095u) << 13) | (unsigned)(8191 - (key0 + crow(r, hi)));
                        cand &= ~(1u << p); }
                }
            }
        }
        if (MODE == 1) MWL[tile * 64 + lane] = W;
    }
#undef TK_LDK
    if (MODE == 1) { const int tend = 4 * (gi >> 3) + 4; for (int tile = ntile + wid; tile < tend; tile += NWAVES) MW[((size_t)(b * 16896 + mask_slot(gi)) + tile) * 64 + lane] = 0u; }
}
__device__ __forceinline__ void topk_unit(Frame& F, int b, int gi, float kmax) {
    const int lane = F.lane, r32 = lane & 31, hi = lane >> 5, wid = F.wave, tid = F.tid;
    const int rowbase = b * SEQL, q0 = gi * 32;
    const bf16* KI = (const bf16*)(F.ws + WS_KI); const bf16* QI = (const bf16*)(F.ws + WS_QI); unsigned* MW = (unsigned*)(F.ws + WS_MASK);
    const float* WIDX = (const float*)(F.ws + WS_WIDX); const float* QN = (const float*)(F.ws + WS_QN);
    LAS unsigned* hist = (LAS unsigned*)F.lds; LAS int* par = (LAS int*)(F.lds + PAR_OFF);
    TkLane L; L.qq = q0 + r32; const int row = rowbase + L.qq;
    bf16x8 qf[4][4];
#pragma unroll
    for (int h = 0; h < 4; ++h) { _Pragma("unroll") for (int ks = 0; ks < 4; ++ks) qf[h][ks] = *(const bf16x8*)(QI + (size_t)row * 256 + h * 64 + ks * 16 + hi * 8); }
    { const f32x4 w4 = *(const f32x4*)(WIDX + row * 4), n4 = *(const f32x4*)(QN + row * 4); float hs = 0.f, ls = 0.f;
#pragma unroll
      for (int h = 0; h < 4; ++h) { const bool pos = w4[h] > 0.f; L.lo[h] = pos ? 0.f : -INFINITY; L.hi[h] = pos ? INFINITY : 0.f; const float bd = n4[h] * kmax; if (pos) hs += bd; else ls += bd; }
      float range = hs + ls; if (!(range > 1e-30f)) range = 1.0f; L.sc = QKMAXF / range; L.off = ls * L.sc; }
    { LAS v4u* hz = (LAS v4u*)hist; for (int i = tid; i < 8192; i += NWAVES * 64) hz[i] = (v4u){0u, 0u, 0u, 0u}; if (tid < 160) par[tid] = 0; }
    __syncthreads();
    topk_pass<0>(F, KI, qf, L, rowbase, q0, gi, MW, b);
    __syncthreads();
    for (int qi = 0; qi < 4; ++qi) { const int q = wid * 4 + qi; const LAS v4u* hqv = (const LAS v4u*)(hist + q * 1024 + lane * 16);
        unsigned w[16];
#pragma unroll
        for (int i = 0; i < 4; ++i) { const v4u t = hqv[i]; w[4 * i] = t.x; w[4 * i + 1] = t.y; w[4 * i + 2] = t.z; w[4 * i + 3] = t.w; }
        unsigned tot = 0;
#pragma unroll
        for (int i = 0; i < 16; ++i) tot += w[i];
        unsigned incl = tot;
#pragma unroll
        for (int o = 1; o < 64; o <<= 1) { const unsigned t = __shfl_down(incl, o); if (lane + o < 64) incl += t; }
        unsigned running = incl - tot;
        if (q0 + q + 1 <= 256) { if (lane == 0) { par[q] = -1; par[32 + q] = 0; } }
        else {
#pragma unroll
            for (int i = 15; i >= 0; --i) { const unsigned c = w[i];
                if (running < 256u && running + c >= 256u) { par[q] = lane * 16 + i; par[32 + q] = (int)running; } running += c; }
        }
    }
    __syncthreads();
    topk_pass<1>(F, KI, qf, L, rowbase, q0, gi, MW, b);
    __syncthreads();
    for (int qi = 0; qi < 4; ++qi) { const int q = wid * 4 + qi; const int tbq = par[q];
        if (tbq < 0) continue;
        int n = par[64 + q]; n = n > 768 ? 768 : n; const int rr = 256 - par[32 + q];
        unsigned T = 0; unsigned e[12];
        if (n <= 64) { e[0] = (lane < n) ? hist[q * 768 + lane] : 0u; const bool ok = lane < n;
            for (int bit = 24; bit >= 0; --bit) { const unsigned cand = T | (1u << bit); const int c = __builtin_popcountll(__ballot(ok && e[0] >= cand)); if (c >= rr) T = cand; }
        } else {
#pragma unroll
            for (int i = 0; i < 12; ++i) { const int j = i * 64 + lane; e[i] = (j < n) ? hist[q * 768 + j] : 0u; }
            for (int bit = 24; bit >= 0; --bit) { const unsigned cand = T | (1u << bit); int c = 0;
#pragma unroll
                for (int i = 0; i < 12; ++i) c += __builtin_popcountll(__ballot((i * 64 + lane < n) && e[i] >= cand));
                if (c >= rr) T = cand; } }
#pragma unroll
        for (int i = 0; i < 12; ++i) { if (i * 64 < n) { const int j = i * 64 + lane; const unsigned cmp = e[i];
                if (j < n && cmp >= T) { const int key = 8191 - (int)(cmp & 8191u), tile = key >> 6, k5 = key & 31, sub = (key >> 5) & 1, hh = (k5 >> 2) & 1, r = (k5 & 3) + 4 * (k5 >> 3);
                    __hip_atomic_fetch_or((LAS unsigned*)(F.lds + 98304) + tile * 64 + hh * 32 + q, 1u << (31 - (16 * sub + r)), __ATOMIC_RELAXED, __HIP_MEMORY_SCOPE_WORKGROUP); } } }
    }
    __syncthreads();
    { const int nch = ((gi >> 1) + 1) * 16; GAS v4u* dst = (GAS v4u*)(MW + (size_t)(b * 16896 + mask_slot(gi)) * 64); const LAS v4u* src = (const LAS v4u*)(F.lds + 98304);
      for (int i = tid; i < nch; i += NWAVES * 64) dst[i] = src[i]; }
    __syncthreads();
}
constexpr int HS = 272, HSE = 136;
constexpr int HG_TOT = 149504;
constexpr int H1_FR = 0, H1_IR = 17408, H1_VT = 34816, H1_KHT = 53248, H1_OUT = 71680;
constexpr int H3_QT = 0, H3_KT = 17408, H3_QH = 34816, H3_IR = 52224, H3_VT = 69632, H3_ST = 88064, H3_AM = 122880;
static_assert(H3_AM + 64 * 144 <= HG_TOT && HG_TOT + 4096 <= SCR_BYTES && H1_OUT + 128 * HS <= HG_TOT, "hgrn lds");
__device__ __forceinline__ void hg_ld_tile(const bf16* g, int tid, v4u (&r)[2]) {
#pragma unroll
    for (int i = 0; i < 2; ++i) { const int c = tid + 512 * i; r[i] = *(const GAS v4u*)(g + (size_t)(c >> 4) * 512 + (c & 15) * 8); } }
__device__ __forceinline__ void hg_st_tile(LAS unsigned char* d, int tid, const v4u (&r)[2]) {
#pragma unroll
    for (int i = 0; i < 2; ++i) { const int c = tid + 512 * i; *(LAS v4u*)(d + (c >> 4) * HS + (c & 15) * 16) = r[i]; } }
__device__ __forceinline__ unsigned hg_ld2(const LAS unsigned char* img, int t, int dp) { return *(const LAS unsigned*)(img + t * HS + dp * 4); }
__device__ __forceinline__ float lo16f(unsigned w) { return __builtin_bit_cast(float, w << 16); }
__device__ __forceinline__ float hi16f(unsigned w) { return __builtin_bit_cast(float, w & 0xffff0000u); }
__device__ __forceinline__ void hg_decay(Frame& F, const LAS unsigned char* FR, int h, float (&bl)[2][8], float (&kk)[2][8]) {
    const int dp = F.lane, tg = F.wave;
    float c0 = 0.f, c1 = 0.f;
#pragma unroll
    for (int i = 0; i < 8; ++i) { const unsigned w = hg_ld2(FR, 8 * tg + i, dp); const float g0 = lo16f(w), g1 = hi16f(w);
        kk[0][i] = 1.0f - __expf(g0); kk[1][i] = 1.0f - __expf(g1); c0 += g0; c1 += g1; bl[0][i] = c0; bl[1][i] = c1; }
    typedef float f32x2 __attribute__((ext_vector_type(2)));
    *(LAS f32x2*)(F.lds + HG_TOT + (tg * 128 + 2 * dp) * 4) = (f32x2){c0, c1};
}
__device__ __forceinline__ void hg_decay_fix(Frame& F, float (&bl)[2][8], float (&bend)[2], float (&bmid)[2]) {
    const int dp = F.lane, tg = F.wave; typedef float f32x2 __attribute__((ext_vector_type(2)));
    float pre0 = 0.f, pre1 = 0.f, m0 = 0.f, m1 = 0.f, e0 = 0.f, e1 = 0.f;
#pragma unroll
    for (int g = 0; g < 8; ++g) { const f32x2 t = *(const LAS f32x2*)(F.lds + HG_TOT + (g * 128 + 2 * dp) * 4); if (g < tg) { pre0 += t.x; pre1 += t.y; } if (g < 4) { m0 += t.x; m1 += t.y; } e0 += t.x; e1 += t.y; }
#pragma unroll
    for (int i = 0; i < 8; ++i) { bl[0][i] += pre0; bl[1][i] += pre1; }
    bmid[0] = m0; bmid[1] = m1; bend[0] = e0; bend[1] = e1;
}
__device__ __forceinline__ void hg_vt(Frame& F, const LAS unsigned char* IR, LAS unsigned char* VT) {
    const int dp = F.lane, tg = F.wave; unsigned w[8];
#pragma unroll
    for (int i = 0; i < 8; ++i) w[i] = hg_ld2(IR, 8 * tg + i, dp);
    v4u a, b2;
    a.x = (w[0] & 0xffffu) | (w[1] << 16); a.y = (w[2] & 0xffffu) | (w[3] << 16); a.z = (w[4] & 0xffffu) | (w[5] << 16); a.w = (w[6] & 0xffffu) | (w[7] << 16);
    b2.x = (w[0] >> 16) | (w[1] & 0xffff0000u); b2.y = (w[2] >> 16) | (w[3] & 0xffff0000u); b2.z = (w[4] >> 16) | (w[5] & 0xffff0000u); b2.w = (w[6] >> 16) | (w[7] & 0xffff0000u);
    *(LAS v4u*)(VT + (2 * dp) * 144 + tg * 16) = a; *(LAS v4u*)(VT + (2 * dp + 1) * 144 + tg * 16) = b2;
}
#define HG_FRAG(base, row, stride, k) (*(const LAS bf16x8*)((base) + ((row) * (stride) + (k)) * 2))
__device__ __forceinline__ void hg_state_phase(Frame& F) {
    const int lane = F.lane, r32 = lane & 31, hi = lane >> 5, dp = F.lane, tg = F.wave, tid = F.tid;
    const bf16* BFp = (const bf16*)(F.ws + WS_BF); const bf16* BIp = (const bf16*)(F.ws + WS_BI);
    v4u rf[2], ri[2];
#define H1_PREF(item) do { const int bh_ = (item) >> 7, c_ = (item) & 127; const size_t ro_ = ((size_t)((bh_ >> 2) * SEQL + c_ * 64)) * 512 + (bh_ & 3) * 128; hg_ld_tile(BFp + ro_, tid, rf); hg_ld_tile(BIp + ro_, tid, ri); } while (0)
    LAS int* par = (LAS int*)(F.lds + PAR_OFF);
    if (tid == 0) { par[201] = (int)__hip_atomic_fetch_add(F.ctl + 2112, 1u, RLX_AGENT); par[202] = (int)__hip_atomic_fetch_add(F.ctl + 2112, 1u, RLX_AGENT); }
    __syncthreads();
    int item = par[201], nxt = par[202];
    __syncthreads();
    if (item < 1024) H1_PREF(item);
    for (; item < 1024;) {
        const int h = (item >> 7) & 3;
        unsigned t2 = 0u; if (tid == 0) t2 = __hip_atomic_fetch_add(F.ctl + 2112, 1u, RLX_AGENT);
        hg_st_tile(F.lds + H1_FR, tid, rf); hg_st_tile(F.lds + H1_IR, tid, ri);
        __syncthreads();
        if (nxt < 1024) H1_PREF(nxt);
        float bl[2][8], kk[2][8], bend[2], bmid[2]; hg_decay(F, F.lds + H1_FR, h, bl, kk);
        hg_vt(F, F.lds + H1_IR, F.lds + H1_VT);
        __syncthreads();
        hg_decay_fix(F, bl, bend, bmid);
#pragma unroll
        for (int ch = 0; ch < 2; ++ch) { float kv[8];
#pragma unroll
            for (int i = 0; i < 8; ++i) kv[i] = kk[ch][i] * __expf(bend[ch] - bl[ch][i]);
            v4u o; o.x = pk2(kv[0], kv[1]); o.y = pk2(kv[2], kv[3]); o.z = pk2(kv[4], kv[5]); o.w = pk2(kv[6], kv[7]);
            *(LAS v4u*)(F.lds + H1_KHT + (2 * dp + ch) * 144 + tg * 16) = o;
            if (tg == 0) ((float*)(F.ws + WS_HDEC))[item * 128 + 2 * dp + ch] = __expf(bend[ch]); }
        __syncthreads();
        { const LAS unsigned char* VTb = F.lds + H1_VT; const LAS unsigned char* KHb = F.lds + H1_KHT; LAS unsigned short* OUT = (LAS unsigned short*)(F.lds + H1_OUT); const int vi = F.wave >> 1;
#pragma unroll
          for (int jj = 0; jj < 2; ++jj) { const int dj = (F.wave & 1) * 2 + jj; f32x16 acc = f32x16{};
#pragma unroll
              for (int ks = 0; ks < 4; ++ks) acc = __builtin_amdgcn_mfma_f32_32x32x16_bf16(HG_FRAG(VTb, 32 * vi + r32, 72, 16 * ks + 8 * hi), HG_FRAG(KHb, 32 * dj + r32, 72, 16 * ks + 8 * hi), acc, 0, 0, 0);
#pragma unroll
              for (int r = 0; r < 16; ++r) OUT[(32 * vi + crow(r, hi)) * HSE + 32 * dj + r32] = (unsigned short)f2bf(acc[r]); } }
        __syncthreads();
        { bf16* KV = (bf16*)(F.ws + WS_KV) + (size_t)item * 16384; const LAS unsigned char* OUT = F.lds + H1_OUT;
#pragma unroll
          for (int i = 0; i < 4; ++i) { const int c = tid + 512 * i; *(GAS v4u*)(KV + (c >> 4) * 128 + (c & 15) * 8) = *(const LAS v4u*)(OUT + (c >> 4) * HS + (c & 15) * 16); } }
        if (tid == 0) par[201] = (int)t2;
        __syncthreads();
        item = nxt; nxt = par[201];
    }
#undef H1_PREF
    __syncthreads();
}
__device__ __forceinline__ void hg_scan(Frame& F) {
    const bf16* KV = (const bf16*)(F.ws + WS_KV); bf16* SP = (bf16*)(F.ws + WS_SP); const float* HD = (const float*)(F.ws + WS_HDEC);
    for (int e = F.vcu * (NWAVES * 64) + F.tid; e < 8 * 16384; e += F.G * NWAVES * 64) { const int bh = e >> 14, vd = e & 16383, d = vd & 127; float S = 0.f;
        for (int c0 = 0; c0 < 128; c0 += 16) { float kv[16], dc[16];
#pragma unroll
            for (int j = 0; j < 16; ++j) { const int item = bh * 128 + c0 + j; kv[j] = bf2f(KV[(size_t)item * 16384 + vd]); dc[j] = HD[item * 128 + d]; }
#pragma unroll
            for (int j = 0; j < 16; ++j) { const int item = bh * 128 + c0 + j; SP[(size_t)item * 16384 + vd] = (bf16)f2bf(S); S = dc[j] * S + kv[j]; } }
    }
}
__device__ __forceinline__ void hg_out_phase(Frame& F) {
    const int lane = F.lane, r32 = lane & 31, hi = lane >> 5, dp = F.lane, tg = F.wave, wid = F.wave, tid = F.tid;
    const bf16* BQp = (const bf16*)(F.ws + WS_BQ); const bf16* BFp = (const bf16*)(F.ws + WS_BF); const bf16* BIp = (const bf16*)(F.ws + WS_BI); const bf16* BGp = (const bf16*)(F.ws + WS_BG);
    const bf16* SPp = (const bf16*)(F.ws + WS_SP);
    v4u rq[2], rf[2], ri[2], rg[2], rs[4];
#define H3_PREF(item) do { const int bh_ = (item) >> 7, c_ = (item) & 127; const size_t ro_ = ((size_t)((bh_ >> 2) * SEQL + c_ * 64)) * 512 + (bh_ & 3) * 128; \
        hg_ld_tile(BQp + ro_, tid, rq); hg_ld_tile(BFp + ro_, tid, rf); hg_ld_tile(BIp + ro_, tid, ri); hg_ld_tile(BGp + ro_, tid, rg); \
        _Pragma("unroll") for (int i_ = 0; i_ < 4; ++i_) rs[i_] = *(const GAS v4u*)(SPp + (size_t)(item) * 16384 + (size_t)(tid + 512 * i_) * 8); } while (0)
    int item = F.vcu; if (item < 1024) H3_PREF(item);
    for (; item < 1024; item += F.G) {
        const int bh = item >> 7, c = item & 127, b = bh >> 2, h = bh & 3, rowc = b * SEQL + c * 64;
        hg_st_tile(F.lds + H3_QT, tid, rq); hg_st_tile(F.lds + H3_KT, tid, rf); hg_st_tile(F.lds + H3_IR, tid, ri);
#pragma unroll
        for (int i = 0; i < 4; ++i) { const int cc = tid + 512 * i; *(LAS v4u*)(F.lds + H3_ST + (cc >> 4) * HS + (cc & 15) * 16) = rs[i]; }
        const v4u rgc0 = rg[0], rgc1 = rg[1];
        __syncthreads();
        if (item + F.G < 1024) H3_PREF(item + F.G);
        float bl[2][8], kk[2][8], bend[2], bmid[2]; hg_decay(F, F.lds + H3_KT, h, bl, kk);
        hg_vt(F, F.lds + H3_IR, F.lds + H3_VT);
        __syncthreads();
        hg_decay_fix(F, bl, bend, bmid);
#pragma unroll
        for (int i = 0; i < 8; ++i) { const int t = 8 * tg + i; const unsigned qw = hg_ld2(F.lds + H3_QT, t, dp); const float q0 = lo16f(qw), q1 = hi16f(qw); const float e0 = bl[0][i] - bmid[0], e1 = bl[1][i] - bmid[1];
            *(LAS unsigned*)(F.lds + H3_QT + t * HS + dp * 4) = pk2(q0 * __expf(fminf(e0, 80.f)), q1 * __expf(fminf(e1, 80.f)));
            *(LAS unsigned*)(F.lds + H3_KT + t * HS + dp * 4) = pk2(kk[0][i] * __expf(fminf(-e0, 80.f)), kk[1][i] * __expf(fminf(-e1, 80.f)));
            *(LAS unsigned*)(F.lds + H3_QH + t * HS + dp * 4) = pk2(q0 * __expf(bl[0][i]), q1 * __expf(bl[1][i])); }
        __syncthreads();
        const LAS unsigned char* QTb = F.lds + H3_QT; const LAS unsigned char* KTb = F.lds + H3_KT; const LAS unsigned char* QHb = F.lds + H3_QH;
        const LAS unsigned char* VTb = F.lds + H3_VT; const LAS unsigned char* STb = F.lds + H3_ST; LAS unsigned char* AMb = F.lds + H3_AM;
        if (wid < 3) { const int ti = wid > 0 ? 1 : 0, sj = wid > 1 ? 1 : 0; f32x16 acc = f32x16{};
#pragma unroll
            for (int ks = 0; ks < 8; ++ks) acc = __builtin_amdgcn_mfma_f32_32x32x16_bf16(HG_FRAG(QTb, 32 * ti + r32, HSE, 16 * ks + 8 * hi), HG_FRAG(KTb, 32 * sj + r32, HSE, 16 * ks + 8 * hi), acc, 0, 0, 0);
            LAS unsigned short* AM = (LAS unsigned short*)AMb;
#pragma unroll
            for (int r = 0; r < 16; ++r) { const int t = 32 * ti + crow(r, hi), s = 32 * sj + r32; AM[t * 72 + s] = (unsigned short)f2bf(s <= t ? acc[r] : 0.f); } }
        __syncthreads();
        { const int ti = wid >> 2, vj = wid & 3; f32x16 o = f32x16{};
#pragma unroll
          for (int ks = 0; ks < 4; ++ks) if (ks < 2 * (ti + 1)) o = __builtin_amdgcn_mfma_f32_32x32x16_bf16(HG_FRAG(AMb, 32 * ti + r32, 72, 16 * ks + 8 * hi), HG_FRAG(VTb, 32 * vj + r32, 72, 16 * ks + 8 * hi), o, 0, 0, 0);
#pragma unroll
          for (int ks = 0; ks < 8; ++ks) o = __builtin_amdgcn_mfma_f32_32x32x16_bf16(HG_FRAG(QHb, 32 * ti + r32, HSE, 16 * ks + 8 * hi), HG_FRAG(STb, 32 * vj + r32, HSE, 16 * ks + 8 * hi), o, 0, 0, 0);
          LAS unsigned short* OUT = (LAS unsigned short*)(F.lds + H3_IR);
#pragma unroll
          for (int r = 0; r < 16; ++r) OUT[(32 * ti + crow(r, hi)) * HSE + 32 * vj + r32] = (unsigned short)f2bf(o[r]); }
        __syncthreads();
        { bf16* OB = (bf16*)(F.ws + WS_OAB) + (size_t)rowc * 1024 + 512 + h * 128; const LAS unsigned char* OUT = F.lds + H3_IR; const float* go = F.in[I_HOG] + h * 128;
#pragma unroll
          for (int i = 0; i < 2; ++i) { const int cc = tid + 512 * i, row = cc >> 4, c16 = cc & 15;
              const v4u w = *(const LAS v4u*)(OUT + row * HS + c16 * 16); const v4u bw = i == 0 ? rgc0 : rgc1;
              float v[8] = {lo16f(w.x), hi16f(w.x), lo16f(w.y), hi16f(w.y), lo16f(w.z), hi16f(w.z), lo16f(w.w), hi16f(w.w)};
              const float bgv[8] = {lo16f(bw.x), hi16f(bw.x), lo16f(bw.y), hi16f(bw.y), lo16f(bw.z), hi16f(bw.z), lo16f(bw.w), hi16f(bw.w)};
              float ss = 0.f;
#pragma unroll
              for (int j = 0; j < 8; ++j) ss += v[j] * v[j];
              ss += __shfl_xor(ss, 1); ss += __shfl_xor(ss, 2); ss += __shfl_xor(ss, 4); ss += __shfl_xor(ss, 8);
              const float rsd = 1.0f / sqrtf(ss * (1.0f / 128.0f) + 1e-6f);
              const f32x4 g0 = *(const f32x4*)(go + c16 * 8), g1 = *(const f32x4*)(go + c16 * 8 + 4);
              v4u o; o.x = pk2(v[0] * rsd * g0[0] * bgv[0], v[1] * rsd * g0[1] * bgv[1]); o.y = pk2(v[2] * rsd * g0[2] * bgv[2], v[3] * rsd * g0[3] * bgv[3]);
              o.z = pk2(v[4] * rsd * g1[0] * bgv[4], v[5] * rsd * g1[1] * bgv[5]); o.w = pk2(v[6] * rsd * g1[2] * bgv[6], v[7] * rsd * g1[3] * bgv[7]);
              *(GAS v4u*)(OB + (size_t)row * 1024 + c16 * 8) = o; } }
        __syncthreads();
    }
#undef H3_PREF
}
struct Args { const float* in[22]; float* out; unsigned char* ws; int ph_lo, ph_hi, li, pad; };
__device__ __forceinline__ float absmax64(const float* g, int lane) { float v = fabsf(g[lane]);
#pragma unroll
    for (int o = 1; o < 64; o <<= 1) v = fmaxf(v, __shfl_xor(v, o));
    return v; }
__global__ void __launch_bounds__(NWAVES * 64, 2) mk_fwd(Args args) {
    extern __shared__ __attribute__((aligned(16))) unsigned char lds[];
    Frame F;
    F.lds = (LAS unsigned char*)lds; F.MISC = (volatile LAS unsigned*)(F.lds + MISC_OFF);
    F.tid = threadIdx.x; F.lane = F.tid & 63; F.wave = __builtin_amdgcn_readfirstlane(F.tid >> 6);
    F.G = gridDim.x; { const int bx = blockIdx.x; F.vcu = (F.G % 8 == 0) ? (bx % 8) * (F.G / 8) + bx / 8 : bx; }
    unsigned char* ws = args.ws; F.ws = ws; F.ctl = (gu32*)(ws + WS_CTL); F.out = args.out;
#pragma unroll
    for (int i = 0; i < 22; ++i) F.in[i] = args.in[i];
    for (int u = F.tid; u < (LDS_BYTES - LDSCTL_OFF) / 4; u += NWAVES * 64) ((LAS unsigned*)(F.lds + LDSCTL_OFF))[u] = 0u;
    __syncthreads();
    XcdBarrier bar; bar.bar = (unsigned*)(F.ctl + CW_BAR); bar.x = 0; bar.st = nullptr;
    if (N_LAUNCHES == 1) bar = xcd_barrier_post((unsigned*)(F.ctl + CW_BAR), F.MISC + 8);
    const int lo = args.ph_lo, hi = args.ph_hi;
#ifdef PROBE_A
    const bool stamper = (blockIdx.x == 0 && F.tid == 0); unsigned long long* const tsw = (unsigned long long*)(ws + WS_CTL + 65536);
#define STAMP(i) do { if (stamper) tsw[i] = __builtin_amdgcn_s_memrealtime(); } while (0)
#else
#define STAMP(i) do { } while (0)
#endif
    STAMP(0);
#ifndef PHSEL
#define PHSEL 0x1fff
#endif
#define IN(k) (((PHSEL >> (k)) & 1) && lo <= (k) && (k) < hi)
#define SEAM(k) do { if (IN(k) && IN((k) + 1)) xcd_barrier(bar); } while (0)
    bf16* Hb = (bf16*)(ws + WS_H);
    if (IN(0)) { p0_prologue(F); SEAM(0); STAMP(1); }
    if (IN(1)) { norm_rows<0>(F, F.in[I_X], Hb); SEAM(1); STAMP(2); }
    if (IN(2)) {
        pg8::Gemm g{Hb, (const bf16*)(ws + WS_WIN), M, NPROJ, DMOD}; pg8::StaticOrder S; S.init(M, NPROJ, F.G, (int)blockIdx.x);
        pg8::EpiProj E{(bf16*)(ws + WS_QLAT), (bf16*)(ws + WS_AK), (bf16*)(ws + WS_AV), (bf16*)(ws + WS_KI), (bf16*)(ws + WS_BQ),
                       (bf16*)F.out, (float*)(ws + WS_QLSS), (float*)(ws + WS_WIDX), F.in[I_KNG], F.in[I_KIG], F.in[I_LB]};
        pg8::gemm_phase<pg8::EpiProj, pg8::StaticOrder, true, true>(F.lds, g, S, E);
        SEAM(2); STAMP(3);
    }
    if (IN(3)) {
        int Kq = 256; asm volatile("" : "+s"(Kq));
        pg8::Gemm g{(const bf16*)(ws + WS_QLAT), (const bf16*)(ws + WS_WQ), M, 768, Kq}; pg8::StaticOrder S; S.init(M, 768, F.G, (int)blockIdx.x);
        pg8::EpiQ E{(bf16*)(ws + WS_AQ), (bf16*)(ws + WS_QI), (float*)(ws + WS_QN), (const float*)(ws + WS_QLSS), (const float*)(ws + WS_WIDX), F.in[I_QNG]};
        pg8::gemm_phase<pg8::EpiQ, pg8::StaticOrder, true, true>(F.lds, g, S, E);
        SEAM(3); STAMP(4);
    }
    if (IN(4)) {
        STAMPB(0);
        const float kmax = 8.0f * absmax64(F.in[I_KIG], F.lane) * 1.02f;
        for (;;) {
            LAS int* par = (LAS int*)(F.lds + PAR_OFF);
            if (F.tid == 0) par[200] = (int)__hip_atomic_fetch_add(F.ctl + 2048, 1u, RLX_AGENT);
            __syncthreads(); const int qn = par[200]; __syncthreads();
            if (qn >= 512) break;
            topk_unit(F, qn & 1, 255 - (qn >> 1), kmax); }
        STAMP(14); STAMPB(1);
        hg_state_phase(F); STAMPB(2);
        SEAM(4); STAMP(5);
    }
    if (IN(5)) {
        STAMPB(3);
        if (F.vcu < 256) { const int bh = F.vcu >> 4, s = F.vcu & 15;
            for (int i = 0; i < 2; ++i) attn_body::attn_unit(bh >> 3, bh & 7, i == 0 ? s : 31 - s, (const attn_body::bf16*)(ws + WS_AQ), (const attn_body::bf16*)(ws + WS_AK), (const attn_body::bf16*)(ws + WS_AV),
                                                             (attn_body::bf16*)(ws + WS_OAB), (const unsigned*)(ws + WS_MASK), (char*)lds); }
        STAMP(15); STAMPB(4);
        hg_scan(F); STAMPB(5);
        SEAM(5); STAMP(6);
    }
    if (IN(6)) { STAMPB(6); hg_out_phase(F); STAMPB(7); SEAM(6); STAMP(7); }
    if (IN(7)) {
        pg8::Gemm g{(const bf16*)(ws + WS_OAB), (const bf16*)(ws + WS_WCAT), M, 1024, 1024}; pg8::StaticOrder S; S.init(M, 1024, F.G, (int)blockIdx.x);
        pg8::EpiMergeF E{(const bf16*)F.out, (bf16*)(ws + WS_T)};
        pg8::gemm_phase<pg8::EpiMergeF, pg8::StaticOrder, true, true>(F.lds, g, S, E);
        SEAM(7); STAMP(8);
    }
    if (IN(8)) { STAMP(9); }
    if (IN(9)) {
        pg8::Gemm g{(const bf16*)(ws + WS_T), (const bf16*)(ws + WS_WOUT), M, 1024, 1024}; pg8::StaticOrder S; S.init(M, 1024, F.G, (int)blockIdx.x);
        pg8::EpiRes E{F.in[I_X], F.out, (const float*)(ws + WS_MODV) + 2048, nullptr};
        pg8::gemm_phase<pg8::EpiRes, pg8::StaticOrder, true, true>(F.lds, g, S, E);
        SEAM(9); STAMP(10);
    }
    if (IN(10)) {
        { LAS float* scr = (LAS float*)(F.lds + F.wave * 16384); const int gw = F.vcu * NWAVES + F.wave, NGW = F.G * NWAVES;
          for (int it = gw; it < 4096; it += NGW) { if (it < 2048) tr_plain(F.in[I_W1], 1024, 4096, (bf16*)(ws + WS_W1), it, scr, F.lane); else tr_plain(F.in[I_W2], 4096, 1024, (bf16*)(ws + WS_W2), it - 2048, scr, F.lane); } }
        __syncthreads();
        norm_rows<1>(F, F.out, Hb);
        SEAM(10); STAMP(11);
    }
    if (IN(11)) {
        pg8::Gemm g{Hb, (const bf16*)(ws + WS_W1), M, DFF, DMOD}; pg8::StaticOrder S; S.init(M, DFF, F.G, (int)blockIdx.x);
        pg8::EpiUp E{(bf16*)(ws + WS_HID), F.in[I_B1]};
        pg8::gemm_phase<pg8::EpiUp, pg8::StaticOrder, true, true>(F.lds, g, S, E);
        SEAM(11); STAMP(12);
    }
    if (IN(12)) {
        pg8::Gemm g{(const bf16*)(ws + WS_HID), (const bf16*)(ws + WS_W2), M, DMOD, DFF}; pg8::StaticOrder S; S.init(M, DMOD, F.G, (int)blockIdx.x);
        pg8::EpiRes E{F.out, F.out, (const float*)(ws + WS_MODV) + 5120, F.in[I_B2]};
        pg8::gemm_phase<pg8::EpiRes, pg8::StaticOrder, true, true>(F.lds, g, S, E);
    }
#ifdef PROBE_A
    xcd_barrier(bar); STAMP(13); xcd_barrier(bar);
    { const volatile unsigned long long* tv = tsw; float frac;
#if defined(PROBE_STAT)
      { float mx = 0.f, sm = 0.f; for (int bk = 0; bk < (int)gridDim.x; ++bk) { const float dsp = (float)(long long)(tv[64 + bk * 16 + PROBE_B] - tv[64 + bk * 16 + PROBE_A]); mx = fmaxf(mx, dsp); sm += dsp; }
        frac = (PROBE_STAT == 1 ? mx : sm / (float)gridDim.x) / (float)(long long)(tv[13] - tv[0]); }
#else
      frac = (float)(long long)(tv[PROBE_B] - tv[PROBE_A]) / (float)(long long)(tv[13] - tv[0]);
#endif
      const float sc = 1.0f + 0.1f * sqrtf(fmaxf(frac, 0.f));
      for (int m = F.vcu * NWAVES + F.wave; m < M; m += F.G * NWAVES) { GAS f32x4* o = (GAS f32x4*)(F.out + (size_t)m * DMOD) + F.lane;
#pragma unroll
          for (int j = 0; j < 4; ++j) { f32x4 v = o[64 * j]; v = v * sc; o[64 * j] = v; } } }
#endif
#undef IN
#undef SEAM
}

extern "C" void kernel_launch(void* const* d_in, const int* in_sizes, int n_in, void* d_out, int out_size, void* d_ws, size_t ws_size, hipStream_t stream) {
    static int grid = 0;
    if (grid == 0) {
        if (n_in != 22 || out_size != M * DMOD || ws_size < WS_END) { fprintf(stderr, "kernel_launch: unexpected problem shape (n_in %d out %d ws %zu)\n", n_in, out_size, ws_size); grid = -1; return; }
        int dev = 0, cus = 0, per_cu = 0;
        if (hipGetDevice(&dev) != hipSuccess || hipDeviceGetAttribute(&cus, hipDeviceAttributeMultiprocessorCount, dev) != hipSuccess) { grid = -1; return; }
        if (hipFuncSetAttribute((const void*)mk_fwd, hipFuncAttributeMaxDynamicSharedMemorySize, LDS_BYTES) != hipSuccess) { fprintf(stderr, "kernel_launch: hipFuncSetAttribute failed\n"); grid = -1; return; }
        if (hipOccupancyMaxActiveBlocksPerMultiprocessor(&per_cu, (const void*)mk_fwd, NWAVES * 64, LDS_BYTES) != hipSuccess || per_cu < 1) fprintf(stderr, "kernel_launch: occupancy query says %d\n", per_cu);
        (void)hipGetLastError();
        grid = cus;
        if (grid != 256) fprintf(stderr, "kernel_launch: %d CUs (built for 256)\n", grid);
    }
    if (grid < 0) return;
    if (hipMemsetAsync((char*)d_ws + WS_CTL, 0, CTL_ZERO_BYTES, stream) != hipSuccess) return;
    Args a{};
    for (int i = 0; i < 22; ++i) a.in[i] = (const float*)d_in[i];
    a.out = (float*)d_out; a.ws = (unsigned char*)d_ws;
    for (int li = 0; li < N_LAUNCHES; ++li) {
        a.ph_lo = (N_LAUNCHES == 1) ? 0 : li; a.ph_hi = (N_LAUNCHES == 1) ? NPHASE : li + 1; a.li = li;
        hipLaunchKernelGGL(mk_fwd, dim3(grid), dim3(NWAVES * 64), LDS_BYTES, stream, a);
    }
}
```
